# Optimizing an MI355X kernel written in HIP

```python
import jax
import jax.numpy as jnp
from jax import lax
import numpy as np

D_MODEL = 1024
BATCH = 16
SEQ = 2048
DEPTH = 2

CTX_LEN = 256
GRID_W = 64
HEAD_DIM = 128
N_HEADS = 8
N_KV_HEADS = 2
WINDOW = 128
BLOCK = 128
ROPE_THETA = 10000.0
LRU_W = 1024
LRU_BLOCKS = 8
LRU_BW = LRU_W // LRU_BLOCKS
LRU_C = 8.0
CONV_W = 4
CONV_LEFT = 2
N_EXPERTS = 16
EC_FACTOR = 2
D_EXPERT = 2048
N_MOD = 6
EPS = 1e-6
Q_W = N_HEADS * HEAD_DIM
KV_W = N_KV_HEADS * HEAD_DIM
IN_SPLITS = (Q_W, KV_W, KV_W, LRU_W, LRU_W, D_MODEL, D_MODEL)
IN_W = Q_W + 2 * KV_W + 2 * LRU_W + 2 * D_MODEL

kernel_name = 'hybrid_dit_swa_rglru_ecmoe'


def rmsnorm(x, g):
    xf = x.astype(jnp.float32)
    y = xf * lax.rsqrt(jnp.mean(xf * xf, axis=-1, keepdims=True) + EPS)
    return (y * g.astype(jnp.float32)).astype(x.dtype)


def modulate(h, shift, scale):
    return h * (1 + scale) + shift


def split_in(proj):
    bounds = np.cumsum(IN_SPLITS)[:-1].tolist()
    return jnp.split(proj, bounds, axis=-1)


def to_heads(t, n):
    return t.reshape(t.shape[:-1] + (n, HEAD_DIM))


def rope_1d(v, pos):
    half = v.shape[-1] // 2
    freqs = ROPE_THETA ** (-jnp.arange(half, dtype=jnp.float32) / half)
    ang = pos.astype(jnp.float32)[:, None] * freqs[None, :]
    cos = jnp.cos(ang)[:, None, :].astype(v.dtype)
    sin = jnp.sin(ang)[:, None, :].astype(v.dtype)
    v1, v2 = v[..., :half], v[..., half:]
    return jnp.concatenate([v1 * cos - v2 * sin, v1 * sin + v2 * cos], axis=-1)


def axial_rope(v, rows, cols):
    h = v.shape[-1] // 2
    return jnp.concatenate([rope_1d(v[..., :h], rows), rope_1d(v[..., h:], cols)], axis=-1)


def sink_softmax(scores, sink):
    m = sink
    for s in scores:
        m = jnp.maximum(m, jnp.max(s, axis=-1))
    ps = [jnp.exp(s - m[..., None]) for s in scores]
    denom = jnp.exp(sink - m)
    for p in ps:
        denom = denom + jnp.sum(p, axis=-1)
    return [p / denom[..., None] for p in ps]


def _band(t, nb):
    B, S, KV, d = t.shape
    tp = jnp.pad(t, ((0, 0), (BLOCK, BLOCK), (0, 0), (0, 0))).reshape(B, nb + 2, BLOCK, KV, d)
    return jnp.concatenate([tp[:, :-2], tp[:, 1:-1], tp[:, 2:]], axis=2)


def banded_attention(q, k, v, k_ctx, v_ctx, sink):
    B, S, H, d = q.shape
    G = H // N_KV_HEADS
    nb = S // BLOCK
    scale = HEAD_DIM ** -0.5
    qb = q.reshape(B, nb, BLOCK, N_KV_HEADS, G, d)
    kb, vb = _band(k, nb), _band(v, nb)
    qpos = jnp.arange(S).reshape(nb, BLOCK)
    kpos = (jnp.arange(nb)[:, None] - 1) * BLOCK + jnp.arange(3 * BLOCK)[None, :]
    kp = kpos[:, None, :]
    valid = (kp >= 0) & (kp < S) & (jnp.abs(qpos[:, :, None] - kp) <= WINDOW)
    s_band = jnp.einsum('bnqkgd,bnskd->bnkgqs', qb, kb).astype(jnp.float32) * scale
    s_band = jnp.where(valid[None, :, None, None], s_band, -jnp.inf)
    s_ctx = jnp.einsum('bnqkgd,blkd->bnkgql', qb, k_ctx).astype(jnp.float32) * scale
    p_band, p_ctx = sink_softmax([s_band, s_ctx], sink.reshape(N_KV_HEADS, G, 1).astype(jnp.float32))
    o = (jnp.einsum('bnkgqs,bnskd->bnqkgd', p_band.astype(v.dtype), vb)
         + jnp.einsum('bnkgql,blkd->bnqkgd', p_ctx.astype(v.dtype), v_ctx))
    return o.reshape(B, S, H * d)


def context_attention(q, k, v, sink):
    B, L, H, d = q.shape
    G = H // N_KV_HEADS
    qg = q.reshape(B, L, N_KV_HEADS, G, d)
    s = jnp.einsum('blkgd,bmkd->bkglm', qg, k).astype(jnp.float32) * (HEAD_DIM ** -0.5)
    (p,) = sink_softmax([s], sink.reshape(N_KV_HEADS, G, 1).astype(jnp.float32))
    o = jnp.einsum('bkglm,bmkd->blkgd', p.astype(v.dtype), v)
    return o.reshape(B, L, H * d)


def short_conv(u, w, b):
    T = u.shape[1]
    up = jnp.pad(u, ((0, 0), (CONV_LEFT, CONV_W - 1 - CONV_LEFT), (0, 0)))
    out = b
    for kk in range(CONV_W):
        out = out + w[kk] * up[:, kk:kk + T]
    return out


def _combine(e1, e2):
    a1, b1 = e1
    a2, b2 = e2
    return a1 * a2, a2 * b1 + b2


def linear_scan(a, b, h0, reverse):
    edge = -1 if reverse else 0
    b = b.at[:, edge].add(a[:, edge] * h0)
    _, h = lax.associative_scan(_combine, (a, b), reverse=reverse, axis=1)
    return h


def rg_lru(u, wa, ba, wx, bx, lam, h0, reverse):
    B, T, W = u.shape
    ub = u.reshape(B, T, LRU_BLOCKS, LRU_BW)
    gate_r = jax.nn.sigmoid(jnp.einsum('btni,nij->btnj', ub, wa).reshape(B, T, W) + ba)
    gate_i = jax.nn.sigmoid(jnp.einsum('btni,nij->btnj', ub, wx).reshape(B, T, W) + bx)
    log_a = (-LRU_C * gate_r.astype(jnp.float32)) * jax.nn.softplus(-lam.astype(jnp.float32))
    a = jnp.exp(log_a)
    b = jnp.sqrt(-jnp.expm1(2.0 * log_a)) * (gate_i * u).astype(jnp.float32)
    return linear_scan(a, b, h0, reverse)


def recurrent_mixer(u_ctx, u_lat, conv_w, conv_b, lru_wa, lru_ba, lru_wx, lru_bx, lru_lambda, need_ctx_out):
    uc = short_conv(u_ctx, conv_w, conv_b)
    ul = short_conv(u_lat, conv_w, conv_b)
    h0 = jnp.zeros((u_ctx.shape[0], LRU_W), jnp.float32)
    hc_f = rg_lru(uc, lru_wa[0], lru_ba[0], lru_wx[0], lru_bx[0], lru_lambda[0], h0, False)
    hc_b = rg_lru(uc, lru_wa[1], lru_ba[1], lru_wx[1], lru_bx[1], lru_lambda[1], h0, True)
    hl_f = rg_lru(ul, lru_wa[0], lru_ba[0], lru_wx[0], lru_bx[0], lru_lambda[0], hc_f[:, -1], False)
    hl_b = rg_lru(ul, lru_wa[1], lru_ba[1], lru_wx[1], lru_bx[1], lru_lambda[1], hc_b[:, 0], True)
    y_lat = (hl_f + hl_b).astype(u_lat.dtype)
    y_ctx = (hc_f + hc_b).astype(u_ctx.dtype) if need_ctx_out else None
    return y_lat, y_ctx


def merge_branches(att, rec, z, m_att, m_rec, w_attn_br, w_rec_br, w_out):
    att_d = att @ w_attn_br
    rec_d = (rec * jax.nn.gelu(z)) @ w_rec_br
    return (jax.nn.sigmoid(m_att) * att_d + jax.nn.sigmoid(m_rec) * rec_d) @ w_out


def expert_choice_moe(h, w_router, w_gate, w_up, w_down):
    B, n, D = h.shape
    cap = EC_FACTOR * n // N_EXPERTS
    aff = jax.nn.softmax((h @ w_router).astype(jnp.float32), axis=-1)
    g, idx = lax.top_k(jnp.swapaxes(aff, 1, 2), cap)
    xe = jax.vmap(lambda hb, ib: hb[ib])(h, idx)
    hid = jax.nn.silu(jnp.einsum('becd,edf->becf', xe, w_gate)) * jnp.einsum('becd,edf->becf', xe, w_up)
    ye = jnp.einsum('becf,efd->becd', hid, w_down) * g[..., None].astype(h.dtype)
    return jax.vmap(lambda ib, yb: jnp.zeros((n, D), yb.dtype).at[ib.reshape(-1)].add(yb.reshape(-1, D)))(idx, ye)


def hybrid_layer(x, ctx, mod_lat, mod_ctx, rows, cols, norm_mix_g, w_in, attn_sink, conv_w, conv_b,
                 lru_wa, lru_ba, lru_wx, lru_bx, lru_lambda, w_attn_br, w_rec_br, w_out,
                 norm_ffn_g, w_router, w_gate, w_up, w_down, last):
    sh1, sc1, g1, sh2, sc2, g2 = jnp.split(mod_lat, N_MOD, axis=-1)
    csh1, csc1, cg1, csh2, csc2, cg2 = jnp.split(mod_ctx, N_MOD, axis=-1)
    hl = modulate(rmsnorm(x, norm_mix_g), sh1, sc1)
    hc = modulate(rmsnorm(ctx, norm_mix_g), csh1, csc1)
    ql, kl, vl, ul, zl, mal, mrl = split_in(hl @ w_in)
    qc, kc, vc, uc, zc, mac, mrc = split_in(hc @ w_in)
    kc_h, vc_h = to_heads(kc, N_KV_HEADS), to_heads(vc, N_KV_HEADS)
    att_lat = banded_attention(axial_rope(to_heads(ql, N_HEADS), rows, cols),
                               axial_rope(to_heads(kl, N_KV_HEADS), rows, cols),
                               to_heads(vl, N_KV_HEADS), kc_h, vc_h, attn_sink)
    rec_lat, rec_ctx = recurrent_mixer(uc, ul, conv_w, conv_b, lru_wa, lru_ba, lru_wx, lru_bx, lru_lambda, not last)
    x = x + g1 * merge_branches(att_lat, rec_lat, zl, mal, mrl, w_attn_br, w_rec_br, w_out)
    x = x + g2 * expert_choice_moe(modulate(rmsnorm(x, norm_ffn_g), sh2, sc2), w_router, w_gate, w_up, w_down)
    if not last:
        att_ctx = context_attention(to_heads(qc, N_HEADS), kc_h, vc_h, attn_sink)
        ctx = ctx + cg1 * merge_branches(att_ctx, rec_ctx, zc, mac, mrc, w_attn_br, w_rec_br, w_out)
        ctx = ctx + cg2 * expert_choice_moe(modulate(rmsnorm(ctx, norm_ffn_g), csh2, csc2), w_router, w_gate, w_up, w_down)
    return x, ctx


def setup_inputs(seed: int = 0) -> dict:
    key = jax.random.key(seed)
    ks = jax.random.split(key, 26)
    f32 = jnp.float32
    D = D_MODEL

    def nrm(k, shape, scale):
        return jax.random.normal(k, shape, f32) * scale

    a0 = jax.random.uniform(ks[12], (DEPTH, 2, LRU_W), f32, 0.9, 0.999) ** (1.0 / LRU_C)
    return {
        'x': nrm(ks[0], (BATCH, SEQ, D), 1.0),
        'c': nrm(ks[1], (BATCH, D), 1.0),
        'ctx': nrm(ks[2], (BATCH, CTX_LEN, D), 1.0),
        'c_ctx': nrm(ks[3], (D,), 1.0),
        'ada_w': nrm(ks[4], (DEPTH, D, N_MOD * D), 0.5 * D ** -0.5),
        'ada_b': nrm(ks[5], (DEPTH, N_MOD * D), 0.02),
        'norm_mix_g': 1.0 + nrm(ks[6], (DEPTH, D), 0.02),
        'w_in': nrm(ks[7], (DEPTH, D, IN_W), D ** -0.5),
        'attn_sink': nrm(ks[8], (DEPTH, N_HEADS), 0.5),
        'conv_w': nrm(ks[9], (DEPTH, CONV_W, LRU_W), CONV_W ** -0.5),
        'conv_b': nrm(ks[10], (DEPTH, LRU_W), 0.02),
        'lru_wa': nrm(ks[11], (DEPTH, 2, LRU_BLOCKS, LRU_BW, LRU_BW), LRU_BW ** -0.5),
        'lru_ba': nrm(ks[13], (DEPTH, 2, LRU_W), 0.02),
        'lru_wx': nrm(ks[14], (DEPTH, 2, LRU_BLOCKS, LRU_BW, LRU_BW), LRU_BW ** -0.5),
        'lru_bx': nrm(ks[15], (DEPTH, 2, LRU_W), 0.02),
        'lru_lambda': jnp.log(a0) - jnp.log1p(-a0),
        'w_attn_br': nrm(ks[16], (DEPTH, Q_W, D), Q_W ** -0.5),
        'w_rec_br': nrm(ks[17], (DEPTH, LRU_W, D), LRU_W ** -0.5),
        'w_out': nrm(ks[18], (DEPTH, D, D), D ** -0.5),
        'norm_ffn_g': 1.0 + nrm(ks[19], (DEPTH, D), 0.02),
        'w_router': nrm(ks[20], (DEPTH, D, N_EXPERTS), D ** -0.5),
        'w_gate': nrm(ks[21], (DEPTH, N_EXPERTS, D, D_EXPERT), D ** -0.5),
        'w_up': nrm(ks[22], (DEPTH, N_EXPERTS, D, D_EXPERT), D ** -0.5),
        'w_down': nrm(ks[23], (DEPTH, N_EXPERTS, D_EXPERT, D), D_EXPERT ** -0.5),
        'final_norm_g': 1.0 + nrm(ks[24], (D,), 0.02),
    }


def reference(x, c, ctx, c_ctx, ada_w, ada_b, norm_mix_g, w_in, attn_sink, conv_w, conv_b,
              lru_wa, lru_ba, lru_wx, lru_bx, lru_lambda, w_attn_br, w_rec_br, w_out,
              norm_ffn_g, w_router, w_gate, w_up, w_down, final_norm_g):
    S = x.shape[1]
    ROWS = S // GRID_W
    rows = jnp.repeat(jnp.arange(ROWS, dtype=jnp.int32), GRID_W)
    cols = jnp.tile(jnp.arange(GRID_W, dtype=jnp.int32), ROWS)
    c_act = jax.nn.silu(c)
    cctx_act = jax.nn.silu(c_ctx)
    for l in range(DEPTH):
        mod_lat = (c_act @ ada_w[l] + ada_b[l])[:, None, :]
        mod_ctx = cctx_act @ ada_w[l] + ada_b[l]
        x, ctx = hybrid_layer(x, ctx, mod_lat, mod_ctx, rows, cols, norm_mix_g[l], w_in[l], attn_sink[l],
                              conv_w[l], conv_b[l], lru_wa[l], lru_ba[l], lru_wx[l], lru_bx[l], lru_lambda[l],
                              w_attn_br[l], w_rec_br[l], w_out[l], norm_ffn_g[l], w_router[l],
                              w_gate[l], w_up[l], w_down[l], l == DEPTH - 1)
    return rmsnorm(x, final_norm_g)
```

```cpp
#include <hip/hip_runtime.h>
#include <cstdio>
#include <cstdint>

#ifndef MK_PER_PHASE
#define MK_PER_PHASE 0
#endif

#define LAS __attribute__((address_space(3)))
#define GAS __attribute__((address_space(1)))
typedef unsigned short bf16;
typedef short bf16x8 __attribute__((ext_vector_type(8)));
typedef float f32x4 __attribute__((ext_vector_type(4)));
typedef float f32x2 __attribute__((ext_vector_type(2)));
typedef unsigned u32x4 __attribute__((ext_vector_type(4)));
typedef unsigned u32x2 __attribute__((ext_vector_type(2)));

constexpr int D = 1024, NB = 16, SEQ = 2048, CTXL = 256, DEPTH = 2;
constexpr int NLAT = NB * SEQ, NCTX = NB * CTXL, NROW = NLAT + NCTX;
constexpr int INW = 5632, NE = 16, DE = 2048, CAPL = 256, CAPC = 32, NMOD = 6;
constexpr float EPS = 1e-6f;
constexpr int NWAVES = 8, NTHR = 512;

constexpr size_t MiB = 1u << 20;
constexpr size_t WS_CTL = 0, CTL_ZERO_BYTES = 64 * 1024;
constexpr size_t WS_MOD = 1 * MiB;
constexpr size_t WS_COS = 2 * MiB;
constexpr size_t WS_SIN = 2 * MiB + 16384;
constexpr size_t WS_ROWIDX = 3 * MiB;
constexpr size_t WS_GVAL = 4 * MiB;
constexpr size_t WS_SLOT = 5 * MiB;
constexpr size_t WS_AFF = 8 * MiB;
constexpr size_t WS_WIN8 = 12 * MiB;
constexpr size_t WS_WIN = 16 * MiB;
constexpr size_t WS_WA = 27 * MiB, WS_WR = 29 * MiB, WS_WO = 31 * MiB;
__host__ __device__ constexpr size_t ws_wgu(int l) { return (33 + 64 * l) * MiB; }
__host__ __device__ constexpr size_t ws_wdn(int l) { return (161 + 32 * l) * MiB; }
constexpr size_t WS_LW = 225 * MiB;
constexpr size_t WS_X = 226 * MiB;
constexpr size_t WS_H8 = 298 * MiB;
constexpr size_t WS_H = 370 * MiB;
constexpr size_t WS_Q = 442 * MiB;
constexpr size_t WS_U = 514 * MiB;
constexpr size_t WS_T1 = 442 * MiB;
constexpr size_t WS_K = 586 * MiB;
constexpr size_t WS_VT = 604 * MiB;
constexpr size_t WS_GZ = 622 * MiB;
constexpr size_t WS_SMA = 694 * MiB, WS_SMR = 766 * MiB, WS_REC = 838 * MiB;
constexpr size_t WS_HID = 442 * MiB;
constexpr size_t WS_YE = 730 * MiB;
constexpr size_t WS_END = 910 * MiB;

constexpr int LDS_BYTES = 147456;
constexpr int RING_BYTES = 131072;
constexpr int MISC_OFF = LDS_BYTES - 16;

__device__ __forceinline__ unsigned f2bf(float f) { unsigned u = __builtin_bit_cast(unsigned, f); return (u + 0x7fffu + ((u >> 16) & 1u)) >> 16; }
__device__ __forceinline__ unsigned pk2(float lo, float hi) { unsigned r; asm volatile("v_cvt_pk_bf16_f32 %0, %1, %2" : "=v"(r) : "v"(lo), "v"(hi)); return r; }
__device__ __forceinline__ float bf_lo(unsigned w) { return __builtin_bit_cast(float, w << 16); }
__device__ __forceinline__ float bf_hi(unsigned w) { return __builtin_bit_cast(float, w & 0xffff0000u); }
__device__ __forceinline__ float bf2f(bf16 b) { return __builtin_bit_cast(float, ((unsigned)b) << 16); }
__device__ __forceinline__ u32x2 pk4(f32x4 v) { u32x2 w; w.x = pk2(v[0], v[1]); w.y = pk2(v[2], v[3]); return w; }
__device__ __forceinline__ f32x4 unpk4(u32x2 w) { return (f32x4){bf_lo(w.x), bf_hi(w.x), bf_lo(w.y), bf_hi(w.y)}; }
__device__ __forceinline__ unsigned f8x4(f32x4 v) { int w = 0; w = __builtin_amdgcn_cvt_pk_fp8_f32(v[0], v[1], w, false); w = __builtin_amdgcn_cvt_pk_fp8_f32(v[2], v[3], w, true); return (unsigned)w; }
__device__ __forceinline__ float wave_sum(float v) {
#pragma unroll
    for (int o = 1; o < 64; o <<= 1) v += __shfl_xor(v, o);
    return v;
}
__device__ __forceinline__ float wave_max(float v) {
#pragma unroll
    for (int o = 1; o < 64; o <<= 1) v = fmaxf(v, __shfl_xor(v, o));
    return v;
}
__device__ __forceinline__ float bsel(unsigned m, float a0, float a1) { return __builtin_bit_cast(float, (__builtin_bit_cast(unsigned, a1) & m) | (__builtin_bit_cast(unsigned, a0) & ~m)); }
__device__ __forceinline__ float sigmoidf_(float x) { return __builtin_amdgcn_rcpf(1.0f + __expf(-x)); }
__device__ __forceinline__ f32x2 sigmoid2(f32x2 x) { const f32x2 t = x * (-1.4426950408889634f); const f32x2 e = (f32x2){__builtin_amdgcn_exp2f(t.x), __builtin_amdgcn_exp2f(t.y)} + 1.0f; return (f32x2){__builtin_amdgcn_rcpf(e.x), __builtin_amdgcn_rcpf(e.y)}; }
__device__ __forceinline__ f32x2 gelu2(f32x2 z) { const f32x2 y = (z * z * 0.044715f + 1.0f) * z * (-1.5957691216057308f * 1.4426950408889634f); const f32x2 e = (f32x2){__builtin_amdgcn_exp2f(y.x), __builtin_amdgcn_exp2f(y.y)} + 1.0f; return z * (f32x2){__builtin_amdgcn_rcpf(e.x), __builtin_amdgcn_rcpf(e.y)}; }
__device__ __forceinline__ float gelu_tanh(float z) { const float y = 1.5957691216057308f * (z + 0.044715f * z * z * z); return z * __builtin_amdgcn_rcpf(1.0f + __expf(-y)); }

#define XB_TMO      128
#define XB_XCNT(j)  (256  + 64 * (j))
#define XB_XSUB(j)  (1280 + 64 * (j))
#define XB_XGEN(j)  (2304 + 64 * (j))
#define XB_TOP      3328
#define XB_TOPGEN   3392
#define XCD_BAR_WORDS 3456
#define XB_SPIN_CAP (1u << 18)
__device__ __forceinline__ unsigned xb_ld(unsigned* p)              { return __hip_atomic_load(p, __ATOMIC_RELAXED, __HIP_MEMORY_SCOPE_AGENT); }
__device__ __forceinline__ unsigned xb_add(unsigned* p, unsigned v) { return __hip_atomic_fetch_add(p, v, __ATOMIC_RELAXED, __HIP_MEMORY_SCOPE_AGENT); }
__device__ __forceinline__ unsigned xb_xcc_id() { return (unsigned)__builtin_amdgcn_s_getreg((3 << 11) | 20) & 0xFu; }
#define XB_SPIN(cond, bar) do { unsigned _sp = 0; while (cond) { __builtin_amdgcn_s_sleep(1); \
    if ((++_sp & 255u) == 0u) { if (xb_ld(&(bar)[XB_TMO])) break; if (_sp > XB_SPIN_CAP) { atomicAdd(&(bar)[XB_TMO], 1u); break; } } } } while (0)
struct XcdBarrier { unsigned* bar; unsigned x; volatile LAS unsigned* st; };
__device__ __forceinline__ XcdBarrier xcd_barrier_post(unsigned* bar, volatile LAS unsigned* st) {
    XcdBarrier b; b.bar = bar; b.x = xb_xcc_id(); b.st = st;
    if (threadIdx.x == 0) (void)xb_add(&bar[XB_XCNT(b.x)], 1u);
    return b;
}
__device__ __forceinline__ void xcd_barrier_complete(unsigned* bar, unsigned x, unsigned& nloc, unsigned& nx) {
    const unsigned G = gridDim.x * gridDim.y * gridDim.z;
    unsigned sum, cnt, mine, sp = 0u;
    for (;;) {
        sum = 0u; cnt = 0u; mine = 0u;
#pragma unroll
        for (unsigned j = 0; j < 16; ++j) { const unsigned c = xb_ld(&bar[XB_XCNT(j)]); sum += c; cnt += (c > 0u) ? 1u : 0u; mine = (j == x) ? c : mine; }
        if (sum == G) break;
        __builtin_amdgcn_s_sleep(1);
        if ((++sp & 255u) == 0u) { if (xb_ld(&bar[XB_TMO])) break; if (sp > XB_SPIN_CAP) { atomicAdd(&bar[XB_TMO], 1u); break; } }
    }
    nloc = mine > 0u ? mine : 1u; nx = cnt > 0u ? cnt : 1u;
}
__device__ __forceinline__ void xcd_barrier(const XcdBarrier& b) {
    asm volatile("s_waitcnt vmcnt(0)" ::: "memory");
    __syncthreads();
    if (threadIdx.x == 0) {
        unsigned* bar = b.bar;
        __builtin_amdgcn_s_waitcnt(0);
        unsigned nloc = b.st[0], nx = b.st[1];
        if (nloc == 0u) { xcd_barrier_complete(bar, b.x, nloc, nx); b.st[0] = nloc; b.st[1] = nx; }
        const unsigned old = xb_add(&bar[XB_XSUB(b.x)], 1u);
        const unsigned gen = old / nloc;
        if (old + 1u == (gen + 1u) * nloc) {
            __builtin_amdgcn_fence(__ATOMIC_RELEASE, "agent");
            asm volatile("s_waitcnt vmcnt(0)" ::: "memory");
            const unsigned og = xb_add(&bar[XB_TOP], 1u);
            const unsigned tg = og / nx;
            if (og + 1u == (tg + 1u) * nx) xb_add(&bar[XB_TOPGEN], 1u);
            else XB_SPIN(xb_ld(&bar[XB_TOPGEN]) == tg, bar);
            __builtin_amdgcn_fence(__ATOMIC_ACQUIRE, "agent");
            xb_add(&bar[XB_XGEN(b.x)], 1u);
            asm volatile("s_waitcnt vmcnt(0)" ::: "memory");
        } else {
            XB_SPIN(xb_ld(&bar[XB_XGEN(b.x)]) == gen, bar);
            __builtin_amdgcn_fence(__ATOMIC_ACQUIRE, "agent");
            asm volatile("s_waitcnt vmcnt(0)" ::: "memory");
        }
    }
    __syncthreads();
}

namespace pg8 {
constexpr int BM = 256, BK = 64, HALF = 128, HTB = HALF * BK * 2, STAGE_BYTES = 8 * HTB, NXCD = 8, WGM = 8;
__host__ __device__ __forceinline__ int lds_byte(int r, int c) { const int st = (r >> 4) * 2 + (c >> 5), rr = r & 15, cc = c & 31, ob = rr * 64 + cc * 2; return st * 1024 + (ob ^ (((ob >> 9) & 1) << 5)); }
__host__ __device__ __forceinline__ void stage_rc(int b, int& R, int& C) { const int st = b / 1024, sb = b % 1024, swz = sb ^ (((sb >> 9) & 1) << 5); R = (st >> 1) * 16 + swz / 64; C = (st & 1) * 32 + (swz % 64) / 2; }
struct Unit { int pm, pn, e; };
typedef int v8i __attribute__((ext_vector_type(8)));
typedef int v4i __attribute__((ext_vector_type(4)));
#define HF_XSUB(j) (64 * (j))
#define HF_TOP     1024
__device__ __forceinline__ void handoff_signal(const XcdBarrier& b, unsigned* hw) {
    asm volatile("s_waitcnt vmcnt(0)" ::: "memory");
    __syncthreads();
    if (threadIdx.x == 0) {
        const unsigned nloc = b.st[0];
        const unsigned old = xb_add(&hw[HF_XSUB(b.x)], 1u);
        if (old + 1u == nloc) { __builtin_amdgcn_fence(__ATOMIC_RELEASE, "agent"); asm volatile("s_waitcnt vmcnt(0)" ::: "memory"); (void)xb_add(&hw[HF_TOP], 1u); }
    }
}
__device__ __forceinline__ void handoff_wait(const XcdBarrier& b, unsigned* hw) {
    if (threadIdx.x == 0) {
        const unsigned nx = b.st[1]; unsigned* bar = b.bar;
        XB_SPIN(xb_ld(&hw[HF_TOP]) < nx, bar);
        __builtin_amdgcn_fence(__ATOMIC_ACQUIRE, "agent");
        asm volatile("s_waitcnt vmcnt(0)" ::: "memory");
    }
    __syncthreads();
}
__device__ __forceinline__ void glds16_s(const char* gbase, unsigned voff, unsigned lds_dst) {
    unsigned keep;
    asm volatile("s_mov_b32 %0, m0\n\ts_mov_b32 m0, %3\n\ts_nop 0\n\tglobal_load_lds_dwordx4 %1, %2\n\ts_mov_b32 m0, %0" : "=&s"(keep) : "v"(voff), "s"(gbase), "s"(lds_dst) : "memory");
}
__device__ __forceinline__ void glds4_s(const void* gbase, unsigned voff, unsigned lds_dst) {
    unsigned keep;
    asm volatile("s_mov_b32 %0, m0\n\ts_mov_b32 m0, %3\n\ts_nop 0\n\tglobal_load_lds_dword %1, %2\n\ts_mov_b32 m0, %0" : "=&s"(keep) : "v"(voff), "s"(gbase), "s"(lds_dst) : "memory");
}
__device__ __forceinline__ v8i cat8(bf16x8 a, bf16x8 b) { const u32x4 x = __builtin_bit_cast(u32x4, a), y = __builtin_bit_cast(u32x4, b); return (v8i){(int)x.x, (int)x.y, (int)x.z, (int)x.w, (int)y.x, (int)y.y, (int)y.z, (int)y.w}; }
__device__ __forceinline__ void static_map(int L, int nM, int nN, int& pm, int& pn) {
    const int nwg = nM * nN; int wgid = L;
    { const int q = nwg / NXCD, r = nwg % NXCD, xcd = wgid % NXCD, off = wgid / NXCD; wgid = (xcd < r ? xcd * (q + 1) : r * (q + 1) + (xcd - r) * q) + off; }
    const int nig = WGM * nN, gid = wgid / nig, fm = gid * WGM, gsz = (nM - fm) < WGM ? (nM - fm) : WGM;
    pm = fm + ((wgid % nig) % gsz); pn = (wgid % nig) / gsz;
}
template <class Prob, bool ALIGN_EPI>
__device__ __forceinline__ void gemm_phase(LAS unsigned char* lds, const Prob& P) {
    constexpr int KB = Prob::KB, nt = KB / (BK * 2);
    int tid_ = threadIdx.x; asm volatile("" : "+v"(tid_));
    const int tid = tid_, wid = __builtin_amdgcn_readfirstlane(tid >> 6), lane = tid & 63, wr = wid >> 2, wc = wid & 3, fr = lane & 15, fq = lane >> 4;
    unsigned voffA[2];
#pragma unroll
    for (int i = 0; i < 2; ++i) { int R, C; stage_rc(tid * 16 + i * 8192, R, C); voffA[i] = (unsigned)(R * KB + C * 2); }
    unsigned gcur[2][2];
#define PG8_GLOAD(dst, u_) do { if constexpr (Prob::GATHER) { const int* ri_ = P.rowidx(u_); _Pragma("unroll") for (int h_ = 0; h_ < 2; ++h_) _Pragma("unroll") for (int i_ = 0; i_ < 2; ++i_) { int R_, C_; stage_rc(tid * 16 + i_ * 8192, R_, C_); \
        dst[h_][i_] = (unsigned)ri_[h_ * HALF + R_] * (unsigned)KB + (unsigned)(C_ * 2); } } } while (0)
    const size_t kstep = (size_t)(BK * 2);
    const size_t hstep = (size_t)HALF * KB;
    const unsigned gmail = (unsigned)(unsigned long long)lds + (unsigned)STAGE_BYTES + (unsigned)wid * 1024u;
    const unsigned ldsb = (unsigned)(unsigned long long)lds + (unsigned)wid * 1024u;
    const int aoff = lds_byte(wr * 64 + fr, fq * 8), boff = lds_byte(wc * 32 + fr, fq * 8);
#define PG8_SA(b, h) (((b) * 2 + (h)) * HTB)
#define PG8_SB(b, h) ((4 + (b) * 2 + (h)) * HTB)
#define PG8_STAGE(bufoff, gbase, voff) do { _Pragma("unroll") for (int _i = 0; _i < 2; ++_i) glds16_s((gbase), (voff)[_i], ldsb + (unsigned)((bufoff) + _i * 8192)); } while (0)
#define PG8_STAGE_A(bufoff, kbase_, h_, nx_) do { if constexpr (Prob::GATHER) { _Pragma("unroll") for (int _i = 0; _i < 2; ++_i) glds16_s((kbase_), gcur[h_][_i], ldsb + (unsigned)((bufoff) + _i * 8192)); } \
        else PG8_STAGE(bufoff, (kbase_) + (h_) * hstep, voffA); } while (0)
#define PG8_LD8(p_) __builtin_shufflevector(*(const LAS v4i*)(p_), *(const LAS v4i*)((p_) + 1024), 0, 1, 2, 3, 4, 5, 6, 7)
#define PG8_LDA(dst, b, h) do { _Pragma("unroll") for (int m = 0; m < 4; ++m) dst[m] = PG8_LD8(lds + PG8_SA(b, h) + aoff + m * 2048); } while (0)
#define PG8_LDB(dst, b, h) do { _Pragma("unroll") for (int n = 0; n < 2; ++n) dst[n] = PG8_LD8(lds + PG8_SB(b, h) + boff + n * 2048); } while (0)
#define PG8_LO(v_) __builtin_bit_cast(bf16x8, __builtin_shufflevector(v_, v_, 0, 1, 2, 3))
#define PG8_HI(v_) __builtin_bit_cast(bf16x8, __builtin_shufflevector(v_, v_, 4, 5, 6, 7))
#define PG8_MMA(ai, bj, At, Bt) do { __builtin_amdgcn_s_setprio(1); _Pragma("unroll") for (int m = 0; m < 4; ++m) _Pragma("unroll") for (int n = 0; n < 2; ++n) { \
        if constexpr (Prob::FP8) { acc[ai][bj][m][n] = __builtin_amdgcn_mfma_scale_f32_16x16x128_f8f6f4(Bt[n], At[m], acc[ai][bj][m][n], 0, 0, 0, 0x7F7F7F7F, 0, 0x7F7F7F7F); } \
        else { acc[ai][bj][m][n] = __builtin_amdgcn_mfma_f32_16x16x32_bf16(PG8_LO(Bt[n]), PG8_LO(At[m]), acc[ai][bj][m][n], 0, 0, 0); \
               acc[ai][bj][m][n] = __builtin_amdgcn_mfma_f32_16x16x32_bf16(PG8_HI(Bt[n]), PG8_HI(At[m]), acc[ai][bj][m][n], 0, 0, 0); } } __builtin_amdgcn_s_setprio(0); } while (0)
#define PG8_WAIT_V(n) asm volatile("s_waitcnt vmcnt(" #n ")" ::: "memory")
#define PG8_WAIT_L(n) asm volatile("s_waitcnt lgkmcnt(" #n ")" ::: "memory")
#define PG8_BAR __builtin_amdgcn_s_barrier()
#define PG8_SCHED __builtin_amdgcn_sched_barrier(0)
    Unit cur, nxt; int ui = 0;
    if (!P.next(0, cur)) return;
    f32x4 acc[2][2][4][2];
#pragma unroll
    for (int a = 0; a < 2; ++a)
#pragma unroll
        for (int b = 0; b < 2; ++b)
#pragma unroll
            for (int m = 0; m < 4; ++m)
#pragma unroll
                for (int n = 0; n < 2; ++n) acc[a][b][m][n] = (f32x4){0.f, 0.f, 0.f, 0.f};
    v8i At[4], B0[2], B1[2];
    const char* cA = P.aptr(cur); const char* cB = P.bptr(cur);
    PG8_GLOAD(gcur, cur);
    PG8_STAGE(PG8_SB(0, 0), cB, voffA); PG8_STAGE(PG8_SB(0, 1), cB + hstep, voffA); PG8_STAGE_A(PG8_SA(0, 0), cA, 0, false); PG8_STAGE_A(PG8_SA(0, 1), cA, 1, false);
    if (wr == 1) PG8_BAR;
    PG8_WAIT_V(2); PG8_BAR;
    PG8_STAGE(PG8_SB(1, 0), cB + kstep, voffA); PG8_STAGE_A(PG8_SA(1, 0), cA + kstep, 0, false); PG8_STAGE(PG8_SB(1, 1), cB + hstep + kstep, voffA);
    PG8_WAIT_V(6); PG8_BAR;
    for (;;) {
        const bool has_next = P.next(ui + 1, nxt);
        const char* nA = has_next ? P.aptr(nxt) : cA; const char* nB = has_next ? P.bptr(nxt) : cB;
        if constexpr (Prob::GATHER) { if (has_next) {
            const int* ri_ = P.rowidx(nxt);
#pragma unroll
            for (int h_ = 0; h_ < 2; ++h_)
#pragma unroll
                for (int i_ = 0; i_ < 2; ++i_) { int R_, C_; stage_rc(tid * 16 + i_ * 8192, R_, C_); glds4_s(ri_, (unsigned)((h_ * HALF + R_) * 4), gmail + (unsigned)((2 * h_ + i_) * 256)); } } }
#pragma nounroll
        for (int t = 0; t < nt; t += 2) {
            const bool last = (t == nt - 2);
            const char* a1 = cA + (size_t)(t + 1) * kstep;
            const char* a2 = last ? nA : cA + (size_t)(t + 2) * kstep; const char* b2 = last ? nB : cB + (size_t)(t + 2) * kstep;
            const char* a3 = a2 + kstep; const char* b3 = b2 + kstep;
            const bool nx = last && has_next;
            PG8_LDB(B0, 0, 0); PG8_LDB(B1, 0, 1); PG8_SCHED; PG8_LDA(At, 0, 0); PG8_STAGE_A(PG8_SA(1, 1), a1, 1, false);
            if constexpr (Prob::GATHER) { if (nx) {
#pragma unroll
                for (int h_ = 0; h_ < 2; ++h_)
#pragma unroll
                    for (int i_ = 0; i_ < 2; ++i_) { int R_, C_; stage_rc(tid * 16 + i_ * 8192, R_, C_);
                        gcur[h_][i_] = *(volatile LAS unsigned*)(lds + STAGE_BYTES + wid * 1024 + (2 * h_ + i_) * 256 + lane * 4) * (unsigned)KB + (unsigned)(C_ * 2); } } }
            PG8_WAIT_V(8); PG8_WAIT_L(0); PG8_BAR; PG8_MMA(0, 0, At, B0); PG8_MMA(0, 1, At, B1); PG8_BAR; PG8_SCHED;
            PG8_LDA(At, 0, 1); PG8_STAGE(PG8_SB(0, 0), b2, voffA); PG8_STAGE(PG8_SB(0, 1), b2 + hstep, voffA); PG8_STAGE_A(PG8_SA(0, 0), a2, 0, nx);
            PG8_WAIT_V(8); PG8_WAIT_L(0); PG8_BAR; PG8_MMA(1, 0, At, B0); PG8_MMA(1, 1, At, B1); PG8_BAR; PG8_SCHED;
            PG8_LDB(B0, 1, 0); PG8_LDB(B1, 1, 1); PG8_SCHED; PG8_LDA(At, 1, 0); PG8_STAGE_A(PG8_SA(0, 1), a2, 1, nx);
            PG8_WAIT_V(8); PG8_WAIT_L(0); PG8_BAR; PG8_MMA(0, 0, At, B0); PG8_MMA(0, 1, At, B1); PG8_BAR; PG8_SCHED;
            PG8_LDA(At, 1, 1); PG8_STAGE(PG8_SB(1, 0), b3, voffA); PG8_STAGE(PG8_SB(1, 1), b3 + hstep, voffA); PG8_STAGE_A(PG8_SA(1, 0), a3, 0, nx);
            PG8_WAIT_V(8); PG8_WAIT_L(0); PG8_BAR; PG8_MMA(1, 0, At, B0); PG8_MMA(1, 1, At, B1); PG8_BAR; PG8_SCHED;
        }
        if constexpr (ALIGN_EPI) { if (wr == 0) PG8_BAR; }
        bool keep = false;
        { int fr_ = fr, fq_ = fq; asm volatile("" : "+v"(fr_), "+v"(fq_));
          if constexpr (Prob::FUSED2) keep = P.epi2(acc, cur, wr, wc, fr_, fq_); else P.epi(acc, cur, wr, wc, fr_, fq_); }
        if (!has_next) break;
        if (!keep) {
#pragma unroll
        for (int a = 0; a < 2; ++a)
#pragma unroll
            for (int b = 0; b < 2; ++b)
#pragma unroll
                for (int m = 0; m < 4; ++m)
#pragma unroll
                    for (int n = 0; n < 2; ++n) acc[a][b][m][n] = (f32x4){0.f, 0.f, 0.f, 0.f};
        }
        cur = nxt; cA = nA; cB = nB; ++ui;
        if constexpr (ALIGN_EPI) { if (wr == 1) PG8_BAR; }
    }
    PG8_WAIT_V(0);
    if constexpr (!ALIGN_EPI) { if (wr == 0) PG8_BAR; }
    PG8_BAR;
#undef PG8_SA
#undef PG8_SB
#undef PG8_STAGE
#undef PG8_STAGE_A
#undef PG8_GLOAD
#undef PG8_LDA
#undef PG8_LDB
#undef PG8_LD8
#undef PG8_LO
#undef PG8_HI
#undef PG8_MMA
#undef PG8_WAIT_V
#undef PG8_WAIT_L
#undef PG8_BAR
#undef PG8_SCHED
}
}
using pg8::Unit;

struct Args { const float* in[25]; float* out; unsigned char* ws; int ph_lo, ph_hi; };
struct Ctx {
    const float* const* in; float* out; unsigned char* ws;
    LAS unsigned char* lds; int tid, lane, wave, G, bid;
};
__device__ __forceinline__ Ctx fresh(const Ctx& c0) {
    Ctx c = c0; int t = threadIdx.x; asm volatile("" : "+v"(t)); c.tid = t; c.lane = t & 63; c.wave = __builtin_amdgcn_readfirstlane(t >> 6); return c;
}
enum { I_X = 0, I_C, I_CTX, I_CCTX, I_ADAW, I_ADAB, I_NMG, I_WIN, I_SINK, I_CONVW, I_CONVB, I_LWA, I_LBA, I_LWX, I_LBX, I_LAM, I_WABR, I_WRBR, I_WOUT, I_NFG, I_WROUTER, I_WGATE, I_WUP, I_WDOWN, I_FNG };

#define EPI_LOOP_ROWS _Pragma("unroll") for (int ai = 0; ai < 2; ++ai) _Pragma("unroll") for (int m = 0; m < 4; ++m)

__host__ __device__ __forceinline__ int ropedim(int s) { const int wc = s >> 5, n = (s >> 4) & 1, fq = (s >> 2) & 3, i = s & 3, p = 16 * wc + 4 * fq + i; return 64 * (p >> 5) + (p & 31) + 32 * n; }

#define FENCE() asm volatile("" ::: "memory")
constexpr float W8_SCALE = 64.0f, W8_INV = 1.0f / 64.0f, YE_SCALE = 16.0f, YE_INV = 1.0f / 16.0f;
struct ProbIn {
    static constexpr int K = 1024, KB = 2048; static constexpr bool FP8 = false, GATHER = false, FUSED2 = false;
    unsigned char* ws; int G, c, nM, nLat, nCtx;
    __device__ __forceinline__ bool next(int i, Unit& u) const {
        long L = (long)i * G + c; u.e = 0;
        if (L < nLat) { int pm, pn; pg8::static_map((int)L, nM, 13, pm, pn); u.pm = pm; u.pn = pn < 5 ? pn : pn + 1; return true; }
        L -= nLat; if (L >= nCtx) return false;
        u.pm = 128 + (int)(L % 16); const int idx = (int)(L / 16); u.pn = idx == 0 ? 4 : 5 + idx; return true;
    }
    __device__ __forceinline__ const char* aptr(const Unit& u) const { return (const char*)(ws + WS_H) + (size_t)u.pm * 256 * K * 2; }
    __device__ __forceinline__ const char* bptr(const Unit& u) const { return (const char*)(ws + WS_WIN) + (size_t)u.pn * 256 * K * 2; }
    __device__ __forceinline__ void epi(const f32x4 (&acc)[2][2][4][2], const Unit& u, int wr, int wc, int fr, int fq) const {
        const int pn = u.pn; const int row0 = u.pm * 256 + wr * 64 + fr, lc = wc * 32 + 4 * fq;
        if (pn <= 4) {
            bf16* base = (bf16*)(ws + (pn < 4 ? WS_Q : WS_K)); const int ldc = pn < 4 ? 1024 : 256, cb = (pn < 4 ? pn * 256 : 0) + lc;
            const bool lat = u.pm < 128; const int i0 = 16 * (wc & 1) + 4 * fq;
            const float* COS = (const float*)(ws + WS_COS); const float* SIN = (const float*)(ws + WS_SIN);
            EPI_LOOP_ROWS {
                const int row = row0 + ai * 128 + m * 16;
                f32x4 cs = (f32x4){1.f, 1.f, 1.f, 1.f}, sn = (f32x4){0.f, 0.f, 0.f, 0.f};
                if (lat) { const int t = row & 2047, pos = wc < 2 ? (t >> 6) : (t & 63); cs = *(const f32x4*)(COS + pos * 32 + i0); sn = *(const f32x4*)(SIN + pos * 32 + i0); }
#pragma unroll
                for (int bj = 0; bj < 2; ++bj) {
                    const f32x4 x1 = acc[ai][bj][m][0], x2 = acc[ai][bj][m][1];
                    const f32x4 o1 = x1 * cs - x2 * sn, o2 = x1 * sn + x2 * cs;
                    bf16* p = base + (size_t)row * ldc + cb + bj * 128;
                    *(u32x2*)p = pk4(o1); *(u32x2*)(p + 16) = pk4(o2);
                }
                FENCE();
            }
        } else {
            size_t off; int cb; int mode;
            if (pn <= 9) { off = WS_U; cb = (pn - 6) * 256; mode = 0; }
            else { off = WS_GZ; cb = (pn - 10) * 256; mode = 1; }
            bf16* base = (bf16*)(ws + off);
            cb += wc * 64 + 16 * fq;
            EPI_LOOP_ROWS {
                const int row = row0 + ai * 128 + m * 16;
#pragma unroll
                for (int bj = 0; bj < 2; ++bj) { f32x4 v0 = acc[ai][bj][m][0], v1 = acc[ai][bj][m][1];
                    if (mode == 1) { const f32x2 a = gelu2((f32x2){v0[0], v0[1]}), b = gelu2((f32x2){v0[2], v0[3]}), c2 = gelu2((f32x2){v1[0], v1[1]}), d = gelu2((f32x2){v1[2], v1[3]}); v0 = (f32x4){a.x, a.y, b.x, b.y}; v1 = (f32x4){c2.x, c2.y, d.x, d.y}; }
                    const u32x2 a = pk4(v0), b = pk4(v1);
                    *(u32x4*)(base + (size_t)row * 1024 + cb + bj * 8) = (u32x4){a.x, a.y, b.x, b.y}; }
                FENCE();
            }
        }
    }
};
struct ProbIn8 {
    static constexpr int KB = 1024; static constexpr bool FP8 = true, GATHER = false, FUSED2 = false;
    unsigned char* ws; int G, c, nM; bool bal;
    __device__ __forceinline__ bool next(int i, Unit& u) const { long L = (long)i * G + c;
        if (bal) { if (i >= 3) { if (c < 96 || i > 4 || (i == 4 && c >= 192)) return false; L = (i == 3 ? 768 : 928) + (c - 96); } }
        if (L >= nM * 8) return false; int pm, pn; pg8::static_map((int)L, nM, 8, pm, pn); u.pm = pm; u.pn = pn; u.e = 0; return true; }
    __device__ __forceinline__ const char* aptr(const Unit& u) const { return (const char*)(ws + WS_H8) + (size_t)u.pm * 256 * KB; }
    __device__ __forceinline__ const char* bptr(const Unit& u) const { return (const char*)(ws + WS_WIN8) + (size_t)u.pn * 256 * KB; }
    __device__ __forceinline__ void epi(const f32x4 (&acc)[2][2][4][2], const Unit& u, int wr, int wc, int fr, int fq) const {
        const int row0 = u.pm * 256 + wr * 64 + fr; const int cb = (u.pn & 3) * 256 + wc * 64 + 16 * fq;
        bf16* base = (bf16*)(ws + (u.pn < 4 ? WS_SMA : WS_SMR));
        EPI_LOOP_ROWS {
            const int row = row0 + ai * 128 + m * 16;
#pragma unroll
            for (int bj = 0; bj < 2; ++bj) { const f32x4 v0 = acc[ai][bj][m][0] * W8_INV, v1 = acc[ai][bj][m][1] * W8_INV;
                const f32x2 a = sigmoid2((f32x2){v0[0], v0[1]}), b = sigmoid2((f32x2){v0[2], v0[3]}), c2 = sigmoid2((f32x2){v1[0], v1[1]}), d = sigmoid2((f32x2){v1[2], v1[3]});
                const u32x2 p = pk4((f32x4){a.x, a.y, b.x, b.y}), q = pk4((f32x4){c2.x, c2.y, d.x, d.y});
                *(u32x4*)(base + (size_t)row * 1024 + cb + bj * 8) = (u32x4){p.x, p.y, q.x, q.y}; }
            FENCE();
        }
    }
};
struct ProbVt {
    static constexpr int K = 1024, KB = 2048; static constexpr bool FP8 = false, GATHER = false, FUSED2 = false;
    unsigned char* ws; int G, c; bool bal;
    __device__ __forceinline__ bool next(int i, Unit& u) const { int L = i * G + (G - 1 - c); if (bal) L = i > 0 ? 144 : (c >= 208 ? c - 208 : (c < 96 ? 48 + c : 144)); if (L >= 144) return false; u.pm = 0; u.pn = L; u.e = 0; return true; }
    __device__ __forceinline__ const char* aptr(const Unit&) const { return (const char*)(ws + WS_WIN) + (size_t)1280 * 1024 * 2; }
    __device__ __forceinline__ const char* bptr(const Unit& u) const { return (const char*)(ws + WS_H) + (size_t)u.pn * 256 * K * 2; }
    __device__ __forceinline__ void epi(const f32x4 (&acc)[2][2][4][2], const Unit& u, int wr, int wc, int fr, int fq) const {
        const int row0 = wr * 64 + fr, cb = u.pn * 256 + wc * 32 + 4 * fq; bf16* Vt = (bf16*)(ws + WS_VT);
        EPI_LOOP_ROWS { const int row = row0 + ai * 128 + m * 16;
#pragma unroll
            for (int bj = 0; bj < 2; ++bj)
#pragma unroll
                for (int n = 0; n < 2; ++n) *(u32x2*)(Vt + (size_t)row * NROW + cb + bj * 128 + n * 16) = pk4(acc[ai][bj][m][n]); }
    }
};
template <int MODE> struct ProbMerge {
    static constexpr int K = 1024, KB = 2048; static constexpr bool FP8 = false, GATHER = false, FUSED2 = false;
    unsigned char* ws; int G, c, nM, l; const float* xin; const float* cin;
    int ubeg, ustride, ucnt;
    __device__ __forceinline__ bool next(int i, Unit& u) const { if (i >= ucnt) return false; const int L = ubeg + i * ustride; if (L >= nM * 4) return false;
        int pm, pn; if (L < 512) pg8::static_map(L, 128, 4, pm, pn); else { pm = 128 + ((L - 512) & 15); pn = (L - 512) >> 4; } u.pm = pm; u.pn = pn; u.e = 0; return true; }
    __device__ __forceinline__ const char* aptr(const Unit& u) const { return (const char*)(ws + (MODE == 0 ? WS_H : MODE == 1 ? WS_REC : WS_GZ)) + (size_t)u.pm * 256 * K * 2; }
    __device__ __forceinline__ const char* bptr(const Unit& u) const { return (const char*)(ws + (MODE == 0 ? WS_WA : MODE == 1 ? WS_WR : WS_WO)) + (size_t)u.pn * 256 * K * 2; }
    __device__ __forceinline__ void epi(const f32x4 (&acc)[2][2][4][2], const Unit& u, int wr, int wc, int fr, int fq) const {
        const int row0 = u.pm * 256 + wr * 64 + fr, cb = u.pn * 256 + wc * 64 + 16 * fq;
        const int r = u.pm < 128 ? (u.pm >> 3) : 16;
        const bf16* S = (const bf16*)(ws + (MODE == 0 ? WS_SMA : WS_SMR)); bf16* T1 = (bf16*)(ws + WS_T1); bf16* MRG = (bf16*)(ws + WS_GZ); bf16* X = (bf16*)(ws + WS_X);
        const float* gate = (const float*)(ws + WS_MOD) + (size_t)(l * 17 + r) * 6144 + 2048;
        const float* RB = (u.pm < 128 ? xin : cin - (size_t)NLAT * D);
        u32x4 svn[2], tvn[2]; f32x4 rbn[2][2];
#define MG_LOAD(g_) do { const int row_ = row0 + ((g_) >> 2) * 128 + ((g_) & 3) * 16; _Pragma("unroll") for (int bj_ = 0; bj_ < 2; ++bj_) { const size_t o_ = (size_t)row_ * 1024 + cb + bj_ * 8; \
            if (MODE != 2) svn[bj_] = *(const u32x4*)(S + o_); if (MODE == 1) tvn[bj_] = *(const u32x4*)(T1 + o_); \
            if (MODE == 2) { if (l == 0) { rbn[bj_][0] = *(const f32x4*)(RB + o_); rbn[bj_][1] = *(const f32x4*)(RB + o_ + 4); } \
                             else { const u32x4 xb_ = *(const u32x4*)(X + o_); rbn[bj_][0] = unpk4((u32x2){xb_.x, xb_.y}); rbn[bj_][1] = unpk4((u32x2){xb_.z, xb_.w}); } } } } while (0)
        f32x4 gt[2][2];
        if (MODE == 2) {
#pragma unroll
            for (int bj = 0; bj < 2; ++bj) { gt[bj][0] = *(const f32x4*)(gate + cb + bj * 8); gt[bj][1] = *(const f32x4*)(gate + cb + bj * 8 + 4); } }
        MG_LOAD(0);
#pragma unroll
        for (int g = 0; g < 8; ++g) { const int ai = g >> 2, m = g & 3; const int row = row0 + ai * 128 + m * 16;
            u32x4 sv[2], tv[2]; f32x4 rb[2][2];
#pragma unroll
            for (int bj = 0; bj < 2; ++bj) { sv[bj] = svn[bj]; tv[bj] = tvn[bj]; rb[bj][0] = rbn[bj][0]; rb[bj][1] = rbn[bj][1]; }
            if (g + 1 < 8) MG_LOAD(g + 1);
#pragma unroll
            for (int bj = 0; bj < 2; ++bj) {
                const size_t o = (size_t)row * 1024 + cb + bj * 8; const f32x4 a0 = acc[ai][bj][m][0], a1 = acc[ai][bj][m][1];
                if (MODE == 0) { const u32x2 p = pk4(a0 * unpk4((u32x2){sv[bj].x, sv[bj].y})), q = pk4(a1 * unpk4((u32x2){sv[bj].z, sv[bj].w})); *(u32x4*)(T1 + o) = (u32x4){p.x, p.y, q.x, q.y}; }
                else if (MODE == 1) { const u32x2 p = pk4(unpk4((u32x2){tv[bj].x, tv[bj].y}) + a0 * unpk4((u32x2){sv[bj].x, sv[bj].y})), q = pk4(unpk4((u32x2){tv[bj].z, tv[bj].w}) + a1 * unpk4((u32x2){sv[bj].z, sv[bj].w})); *(u32x4*)(MRG + o) = (u32x4){p.x, p.y, q.x, q.y}; }
                else { const u32x2 p = pk4(rb[bj][0] + gt[bj][0] * a0), q = pk4(rb[bj][1] + gt[bj][1] * a1); *(u32x4*)(X + o) = (u32x4){p.x, p.y, q.x, q.y}; }
            }
            FENCE();
        }
#undef MG_LOAD
    }
};
struct ProbMerge01 {
    static constexpr int K = 1024, KB = 2048; static constexpr bool FP8 = false, GATHER = false, FUSED2 = true;
    unsigned char* ws; int G, c, nM, pbeg, pend;
    __device__ __forceinline__ bool next(int i, Unit& u) const { const int p = pbeg + (i >> 1); if (p >= pend) return false; const int L = p * G + c; if (L >= nM * 4) return false;
        int pm, pn; if (L < 512) pg8::static_map(L, 128, 4, pm, pn); else { pm = 128 + ((L - 512) & 15); pn = (L - 512) >> 4; } u.pm = pm; u.pn = pn; u.e = i & 1; return true; }
    __device__ __forceinline__ const char* aptr(const Unit& u) const { return (const char*)(ws + (u.e == 0 ? WS_H : WS_REC)) + (size_t)u.pm * 256 * K * 2; }
    __device__ __forceinline__ const char* bptr(const Unit& u) const { return (const char*)(ws + (u.e == 0 ? WS_WA : WS_WR)) + (size_t)u.pn * 256 * K * 2; }
    static __device__ __forceinline__ f32x4 clampsr(u32x2 w) { const f32x4 v = unpk4(w); return (f32x4){__builtin_fmaxf(v[0], 1e-18f), __builtin_fmaxf(v[1], 1e-18f), __builtin_fmaxf(v[2], 1e-18f), __builtin_fmaxf(v[3], 1e-18f)}; }
    __device__ __forceinline__ bool epi2(f32x4 (&acc)[2][2][4][2], const Unit& u, int wr, int wc, int fr, int fq) const {
        const int row0 = u.pm * 256 + wr * 64 + fr, cb = u.pn * 256 + wc * 64 + 16 * fq;
        const bf16* SA = (const bf16*)(ws + WS_SMA); const bf16* SR = (const bf16*)(ws + WS_SMR); bf16* MRG = (bf16*)(ws + WS_GZ);
        const bool first = (u.e == 0);
        u32x4 san[2], srn[2];
#define MG_LOAD(g_) do { const int row_ = row0 + ((g_) >> 2) * 128 + ((g_) & 3) * 16; _Pragma("unroll") for (int bj_ = 0; bj_ < 2; ++bj_) { const size_t o_ = (size_t)row_ * 1024 + cb + bj_ * 8; \
            srn[bj_] = *(const u32x4*)(SR + o_); if (first) san[bj_] = *(const u32x4*)(SA + o_); } } while (0)
        MG_LOAD(0);
#pragma unroll
        for (int g = 0; g < 8; ++g) { const int ai = g >> 2, m = g & 3; const int row = row0 + ai * 128 + m * 16;
            u32x4 sa[2], sr[2];
#pragma unroll
            for (int bj = 0; bj < 2; ++bj) { sa[bj] = san[bj]; sr[bj] = srn[bj]; }
            if (g + 1 < 8) MG_LOAD(g + 1);
#pragma unroll
            for (int bj = 0; bj < 2; ++bj) {
                const f32x4 r0 = clampsr((u32x2){sr[bj].x, sr[bj].y}), r1 = clampsr((u32x2){sr[bj].z, sr[bj].w});
                if (first) {
                    const f32x4 q0 = (f32x4){__builtin_amdgcn_rcpf(r0[0]), __builtin_amdgcn_rcpf(r0[1]), __builtin_amdgcn_rcpf(r0[2]), __builtin_amdgcn_rcpf(r0[3])};
                    const f32x4 q1 = (f32x4){__builtin_amdgcn_rcpf(r1[0]), __builtin_amdgcn_rcpf(r1[1]), __builtin_amdgcn_rcpf(r1[2]), __builtin_amdgcn_rcpf(r1[3])};
                    acc[ai][bj][m][0] = acc[ai][bj][m][0] * (unpk4((u32x2){sa[bj].x, sa[bj].y}) * q0);
                    acc[ai][bj][m][1] = acc[ai][bj][m][1] * (unpk4((u32x2){sa[bj].z, sa[bj].w}) * q1);
                } else {
                    const u32x2 p = pk4(acc[ai][bj][m][0] * r0), q = pk4(acc[ai][bj][m][1] * r1);
                    *(u32x4*)(MRG + (size_t)row * 1024 + cb + bj * 8) = (u32x4){p.x, p.y, q.x, q.y};
                }
            }
            FENCE();
        }
#undef MG_LOAD
        return first;
    }
};
__device__ __forceinline__ bool grouped_next(int i, int G, int c, int nPM, int nPN, Unit& u) {
    const int nloc = G / 8, x = c & 7, loc = c >> 3; const int per = nPM * nPN; const long L = (long)i * nloc + loc;
    if (L >= 2 * per) return false;
    u.e = 2 * x + (int)(L / per); const int rem = (int)(L % per);
    const int nig = 8 * nPN, gid = rem / nig, fm = gid * 8, gsz = (nPM - fm) < 8 ? (nPM - fm) : 8;
    u.pm = fm + ((rem % nig) % gsz); u.pn = (rem % nig) / gsz; return true;
}
struct ProbUp {
    static constexpr int KB = 1024; static constexpr bool FP8 = true, GATHER = true, FUSED2 = false;
    unsigned char* ws; int G, c, Me, l;
    __device__ __forceinline__ bool next(int i, Unit& u) const { return grouped_next(i, G, c, Me / 256, 16, u); }
    __device__ __forceinline__ const char* aptr(const Unit&) const { return (const char*)(ws + WS_H); }
    __device__ __forceinline__ const int* rowidx(const Unit& u) const { return (const int*)(ws + WS_ROWIDX) + (size_t)u.e * Me + (size_t)u.pm * 256; }
    __device__ __forceinline__ const char* bptr(const Unit& u) const { return (const char*)(ws + ws_wgu(l)) + ((size_t)u.e * 4096 + (size_t)u.pn * 256) * KB; }
    __device__ __forceinline__ void epi(const f32x4 (&acc)[2][2][4][2], const Unit& u, int wr, int wc, int fr, int fq) const {
        const size_t row0 = (size_t)u.e * Me + u.pm * 256 + wr * 64 + fr; const int cb = u.pn * 128 + wc * 32 + 8 * fq; unsigned char* HID = ws + WS_HID;
        EPI_LOOP_ROWS { const size_t row = row0 + ai * 128 + m * 16; u32x2 wv;
#pragma unroll
            for (int bj = 0; bj < 2; ++bj) { const f32x4 g = acc[ai][bj][m][0] * W8_INV, up = acc[ai][bj][m][1] * W8_INV; f32x4 h;
#pragma unroll
                for (int i = 0; i < 4; i += 2) { const f32x2 g2 = (f32x2){g[i], g[i + 1]}, hh = g2 * sigmoid2(g2) * (f32x2){up[i], up[i + 1]}; h[i] = hh.x; h[i + 1] = hh.y; }
                int w = 0; w = __builtin_amdgcn_cvt_pk_fp8_f32(h[0], h[1], w, false); w = __builtin_amdgcn_cvt_pk_fp8_f32(h[2], h[3], w, true);
                if (bj == 0) wv.x = (unsigned)w; else wv.y = (unsigned)w; }
            *(u32x2*)(HID + row * 2048 + cb) = wv; }
    }
};
struct ProbDown {
    static constexpr int KB = 2048; static constexpr bool FP8 = true, GATHER = false, FUSED2 = false;
    unsigned char* ws; int G, c, Me, l;
    __device__ __forceinline__ bool next(int i, Unit& u) const { return grouped_next(i, G, c, Me / 256, 4, u); }
    __device__ __forceinline__ const char* aptr(const Unit& u) const { return (const char*)(ws + WS_HID) + ((size_t)u.e * Me + (size_t)u.pm * 256) * KB; }
    __device__ __forceinline__ const char* bptr(const Unit& u) const { return (const char*)(ws + ws_wdn(l)) + ((size_t)u.e * 1024 + (size_t)u.pn * 256) * KB; }
    __device__ __forceinline__ void epi(const f32x4 (&acc)[2][2][4][2], const Unit& u, int wr, int wc, int fr, int fq) const {
        const size_t row0 = (size_t)u.e * Me + u.pm * 256 + wr * 64 + fr; const int cb = u.pn * 256 + wc * 64 + 16 * fq; unsigned char* YE = ws + WS_YE; const float* GV = (const float*)(ws + WS_GVAL);
        float gv[8];
#pragma unroll
        for (int g8 = 0; g8 < 8; ++g8) gv[g8] = GV[row0 + (g8 >> 2) * 128 + (g8 & 3) * 16];
        EPI_LOOP_ROWS { const size_t row = row0 + ai * 128 + m * 16; const float g = gv[ai * 4 + m] * (W8_INV * YE_SCALE); u32x4 wv;
#pragma unroll
            for (int bj = 0; bj < 2; ++bj)
#pragma unroll
                for (int n = 0; n < 2; ++n) { const f32x4 v = acc[ai][bj][m][n] * g; int w = 0; w = __builtin_amdgcn_cvt_pk_fp8_f32(v[0], v[1], w, false); w = __builtin_amdgcn_cvt_pk_fp8_f32(v[2], v[3], w, true); wv[2 * bj + n] = (unsigned)w; }
            *(u32x4*)(YE + row * 1024 + cb) = wv; }
    }
};

template <class ColPtr>
__device__ __forceinline__ void tr_item(const ColPtr& cp, int K, bf16* WT, int item, int nblk, LAS float* scr, int lane) {
    const int kb = item / nblk, nb = item % nblk, k0 = 64 * kb, n0 = 32 * nb;
    size_t stride; const float* src = cp(n0 + (lane & 31), stride) + (size_t)k0 * stride;
    float tv[32];
#pragma unroll
    for (int i = 0; i < 32; ++i) tv[i] = src[(size_t)(2 * i + (lane >> 5)) * stride];
#pragma unroll
    for (int i = 0; i < 32; ++i) scr[(2 * i + (lane >> 5)) * 33 + (lane & 31)] = tv[i];
    asm volatile("s_waitcnt lgkmcnt(0)" ::: "memory");
    const int c = lane & 7;
#pragma unroll
    for (int j = 0; j < 4; ++j) { const int n = (lane >> 3) + 8 * j; const LAS float* s = scr + (8 * c) * 33 + n;
        u32x4 o; o.x = pk2(s[0 * 33], s[1 * 33]); o.y = pk2(s[2 * 33], s[3 * 33]); o.z = pk2(s[4 * 33], s[5 * 33]); o.w = pk2(s[6 * 33], s[7 * 33]);
        *(u32x4*)(WT + (size_t)(n0 + n) * K + k0 + 8 * c) = o; }
    asm volatile("s_waitcnt lgkmcnt(0)" ::: "memory");
}
template <class ColPtr>
__device__ __forceinline__ void tr_item8(const ColPtr& cp, int K, unsigned char* WT, int item, int nblk, LAS float* scr, int lane, float scale) {
    const int kb = item / nblk, nb = item % nblk, k0 = 128 * kb, n0 = 32 * nb;
    size_t stride; const float* src = cp(n0 + (lane & 31), stride) + (size_t)k0 * stride;
    const float* rp = src + (size_t)(lane >> 5) * stride;
#pragma unroll
    for (int hb = 0; hb < 2; ++hb) { float tv[32];
#pragma unroll
        for (int i = 0; i < 32; ++i) { tv[i] = *rp; rp += 2 * stride; }
#pragma unroll
        for (int i = 0; i < 32; ++i) scr[(64 * hb + 2 * i + (lane >> 5)) * 33 + (lane & 31)] = tv[i];
        asm volatile("" ::: "memory"); }
    asm volatile("s_waitcnt lgkmcnt(0)" ::: "memory");
    const int c = lane & 7;
#pragma unroll
    for (int j = 0; j < 4; ++j) { const int n = (lane >> 3) + 8 * j; const LAS float* s = scr + (16 * c) * 33 + n; u32x4 o;
#pragma unroll
        for (int q = 0; q < 4; ++q) { int w = 0; w = __builtin_amdgcn_cvt_pk_fp8_f32(s[(4 * q) * 33] * scale, s[(4 * q + 1) * 33] * scale, w, false); w = __builtin_amdgcn_cvt_pk_fp8_f32(s[(4 * q + 2) * 33] * scale, s[(4 * q + 3) * 33] * scale, w, true); o[q] = (unsigned)w; }
        *(u32x4*)(WT + (size_t)(n0 + n) * K + k0 + 16 * c) = o; asm volatile("" ::: "memory"); }
    asm volatile("s_waitcnt lgkmcnt(0)" ::: "memory");
}
__host__ __device__ __forceinline__ int sig16(int s) { return 64 * ((s >> 5) & 3) + 16 * ((s >> 2) & 3) + 8 * (s >> 7) + 4 * ((s >> 4) & 1) + (s & 3); }
struct ColIn { const float* W; __device__ __forceinline__ const float* operator()(int n, size_t& stride) const { stride = INW; int col = n; if (n < 1280) col = (n & ~127) + ropedim(n & 127); else if (n >= 1536) col = (n & ~255) + sig16(n & 255); return W + col; } };
struct ColIn8 { const float* W; __device__ __forceinline__ const float* operator()(int n, size_t& stride) const { stride = INW; return W + 3584 + (n & ~255) + sig16(n & 255); } };
struct ColPlain { const float* W; int N; __device__ __forceinline__ const float* operator()(int n, size_t& stride) const { stride = (size_t)N; return W + n; } };
struct ColP16 { const float* W; int N; __device__ __forceinline__ const float* operator()(int n, size_t& stride) const { stride = (size_t)N; return W + (n & ~255) + sig16(n & 255); } };
struct ColGU { const float* Wg; const float* Wu; __device__ __forceinline__ const float* operator()(int n, size_t& stride) const { stride = DE;
    const int hc = 128 * (n >> 8) + 32 * ((n >> 5) & 3) + 8 * ((n >> 2) & 3) + 4 * ((n >> 7) & 1) + (n & 3);
    const unsigned long long d = (unsigned long long)Wu - (unsigned long long)Wg; return (const float*)((unsigned long long)Wg + (((n >> 4) & 1) ? d : 0ull)) + hc; } };

constexpr int CT_P = 257;
__device__ __forceinline__ void convert_moe_tiles(const Ctx& c, int l, int wg_first = 0, int wg_count = 0, int tile_lo = 0, int tile_hi = 1 << 20) {
    LAS float* T = (LAS float*)c.lds;
    constexpr int T_GU = NE * 8 * 16, T_DN = NE * 16 * 4;
    const int nwg_ = wg_count ? wg_count : c.G;
    const int tend = tile_hi < T_GU + T_DN ? tile_hi : T_GU + T_DN;
    for (int tile = tile_lo + c.bid - wg_first; tile < tend; tile += nwg_) {
        const bool gu = tile < T_GU; const int tt = gu ? tile : tile - T_GU;
        const int e = gu ? tt >> 7 : tt >> 6, kt = gu ? (tt >> 4) & 7 : (tt >> 2) & 15, pn = gu ? tt & 15 : tt & 3;
        const int K = gu ? D : DE, N = gu ? DE : D, k0 = 128 * kt;
        const float* W0 = gu ? c.in[I_WGATE] + ((size_t)l * NE + e) * D * DE : c.in[I_WDOWN] + ((size_t)l * NE + e) * DE * D;
        const float* W1 = gu ? c.in[I_WUP] + ((size_t)l * NE + e) * D * DE : W0;
        f32x4 ld[16];
#pragma unroll
        for (int i = 0; i < 16; ++i) { const int g = c.tid + 512 * i, k = g >> 6, c4 = g & 63;
            const float* src = gu ? ((c4 < 32 ? W0 : W1) + (size_t)(k0 + k) * N + 128 * pn + 4 * (c4 & 31)) : (W0 + (size_t)(k0 + k) * N + 256 * pn + 4 * c4);
            ld[i] = *(const f32x4*)src; }
#pragma unroll
        for (int i = 0; i < 16; ++i) { const int g = c.tid + 512 * i, k = g >> 6, c4 = g & 63; LAS float* t = T + k * CT_P + 4 * c4; t[0] = ld[i][0]; t[1] = ld[i][1]; t[2] = ld[i][2]; t[3] = ld[i][3]; }
        __syncthreads();
        unsigned char* WT = gu ? c.ws + ws_wgu(l) + ((size_t)e * 4096 + 256 * pn) * D : c.ws + ws_wdn(l) + ((size_t)e * 1024 + 256 * pn) * DE;
#pragma unroll
        for (int j = 0; j < 4; ++j) { const int q = c.tid + 512 * j, n = q >> 3, ch = q & 7;
            const int sc = gu ? 128 * ((n >> 4) & 1) + 32 * ((n >> 5) & 3) + 8 * ((n >> 2) & 3) + 4 * (n >> 7) + (n & 3) : sig16(n);
            const LAS float* t = T + (16 * ch) * CT_P + sc; u32x4 o;
#pragma unroll
            for (int w4 = 0; w4 < 4; ++w4) { int w = 0; w = __builtin_amdgcn_cvt_pk_fp8_f32(t[(4 * w4) * CT_P] * W8_SCALE, t[(4 * w4 + 1) * CT_P] * W8_SCALE, w, false); w = __builtin_amdgcn_cvt_pk_fp8_f32(t[(4 * w4 + 2) * CT_P] * W8_SCALE, t[(4 * w4 + 3) * CT_P] * W8_SCALE, w, true); o[w4] = (unsigned)w; }
            *(u32x4*)(WT + (size_t)n * K + k0 + 16 * ch) = o; }
        __syncthreads();
    }
}
__device__ __forceinline__ void phase_convert_weights(const Ctx& c0, int l, int wg_first = 0, int wg_count = 0) {
    const Ctx c = fresh(c0);
    LAS float* scr = (LAS float*)(c.lds + c.wave * 17408);
    const int gw = (c.bid - wg_first) * NWAVES + c.wave, NGW = (wg_count ? wg_count : c.G) * NWAVES;
    constexpr int I_IN = 16 * 112, I_IN8 = 8 * 64, I_SQ = 16 * 32;
    constexpr int I_LW = 32 * 8;
    constexpr int NITEMS = I_IN + I_IN8 + 3 * I_SQ + I_LW;
    for (int it = gw; it < NITEMS; it += NGW) {
        int r = it;
        if (r < I_IN) { ColIn cp{c.in[I_WIN] + (size_t)l * D * INW}; tr_item(cp, D, (bf16*)(c.ws + WS_WIN), r, 112, scr, c.lane); continue; } r -= I_IN;
        if (r < I_IN8) { ColIn8 cp{c.in[I_WIN] + (size_t)l * D * INW}; tr_item8(cp, D, c.ws + WS_WIN8, r, 64, scr, c.lane, W8_SCALE); continue; } r -= I_IN8;
        if (r < I_SQ) { ColP16 cp{c.in[I_WABR] + (size_t)l * D * D, D}; tr_item(cp, D, (bf16*)(c.ws + WS_WA), r, 32, scr, c.lane); continue; } r -= I_SQ;
        if (r < I_SQ) { ColP16 cp{c.in[I_WRBR] + (size_t)l * D * D, D}; tr_item(cp, D, (bf16*)(c.ws + WS_WR), r, 32, scr, c.lane); continue; } r -= I_SQ;
        if (r < I_SQ) { ColP16 cp{c.in[I_WOUT] + (size_t)l * D * D, D}; tr_item(cp, D, (bf16*)(c.ws + WS_WO), r, 32, scr, c.lane); continue; } r -= I_SQ;
        { const int mat = r >> 3, g = mat & 1, dn = mat >> 1;
          ColPlain cp{c.in[g ? I_LWX : I_LWA] + ((size_t)l * 16 + dn) * 16384, 128}; tr_item(cp, 128, (bf16*)(c.ws + WS_LW) + (size_t)mat * 16384, r & 7, 4, scr, c.lane); }
    }
}
__device__ __forceinline__ void phase_convert_moe(const Ctx& c0, int l, int wg_first = 0, int wg_count = 0, int tile_lo = 0, int tile_hi = 1 << 20) { const Ctx c = fresh(c0); __syncthreads(); convert_moe_tiles(c, l, wg_first, wg_count, tile_lo, tile_hi); __syncthreads(); }
__device__ __forceinline__ void phase_mod(const Ctx& c0) {
    const Ctx c = fresh(c0);
    LAS float* sc = (LAS float*)c.lds; LAS float* red = (LAS float*)(c.lds + 17 * 1024 * 4);
    for (int i = c.tid; i < 17 * 1024; i += NTHR) { const int r = i >> 10, k = i & 1023; const float v = r < 16 ? c.in[I_C][r * 1024 + k] : c.in[I_CCTX][k]; sc[i] = v / (1.0f + expf(-v)); }
    __syncthreads();
    float* MOD = (float*)(c.ws + WS_MOD);
    for (int item = c.bid; item < 2 * 96; item += c.G) {
        const int l = item / 96, n0 = (item % 96) * 64;
        const float* w = c.in[I_ADAW] + (size_t)l * D * 6144 + n0 + c.lane;
        float acc[17];
#pragma unroll
        for (int r = 0; r < 17; ++r) acc[r] = 0.f;
        const int k0 = c.wave * 128;
        for (int kb = 0; kb < 128; kb += 32) {
            float wv[32];
#pragma unroll
            for (int k = 0; k < 32; ++k) wv[k] = w[(size_t)(k0 + kb + k) * 6144];
#pragma unroll
            for (int k = 0; k < 32; ++k) {
#pragma unroll
                for (int r = 0; r < 17; ++r) acc[r] += sc[r * 1024 + k0 + kb + k] * wv[k]; }
        }
#pragma unroll
        for (int r = 0; r < 17; ++r) red[(c.wave * 17 + r) * 64 + c.lane] = acc[r];
        __syncthreads();
        for (int i = c.tid; i < 17 * 64; i += NTHR) { const int r = i >> 6, ln = i & 63; float s = 0.f;
#pragma unroll
            for (int w8 = 0; w8 < 8; ++w8) s += red[(w8 * 17 + r) * 64 + ln];
            MOD[(size_t)(l * 17 + r) * 6144 + n0 + ln] = s + c.in[I_ADAB][l * 6144 + n0 + ln]; }
        __syncthreads();
    }
    float* COS = (float*)(c.ws + WS_COS); float* SIN = (float*)(c.ws + WS_SIN);
    for (int i = c.bid * NTHR + c.tid; i < 64 * 32; i += c.G * NTHR) { const int pos = i >> 5, k = i & 31; const float fr = powf(10000.0f, -(float)k / 32.0f), ang = (float)pos * fr; COS[i] = cosf(ang); SIN[i] = sinf(ang); }
}

__device__ __forceinline__ void phase_norm1(const Ctx& c0, int l) {
    const Ctx c = fresh(c0);
    const bool fin = (l == DEPTH);
    const int gw = c.bid * NWAVES + c.wave, NGW = c.G * NWAVES, nrows = fin ? NLAT : NROW;
    const float* MOD = (const float*)(c.ws + WS_MOD); bf16* X = (bf16*)(c.ws + WS_X); bf16* H = (bf16*)(c.ws + WS_H);
    const short* SLOT = (const short*)(c.ws + WS_SLOT); const unsigned char* YE = c.ws + WS_YE;
    int cur_r = -1; f32x4 al[4], be[4];
    if (l == 0) {
        const f32x4* g = (const f32x4*)(c.in[I_NMG]);
        const int npair = NROW / 2, ppw = (npair + NGW - 1) / NGW, pbeg = gw * ppw, pend = (pbeg + ppw < npair) ? pbeg + ppw : npair;
        for (int rp = pbeg; rp < pend; ++rp) {
            f32x4 v[2][4];
#pragma unroll
            for (int k = 0; k < 2; ++k) { const int row = 2 * rp + k; const f32x4* src = (const f32x4*)(row < NLAT ? c.in[I_X] + (size_t)row * D : c.in[I_CTX] + (size_t)(row - NLAT) * D);
#pragma unroll
                for (int j = 0; j < 4; ++j) v[k][j] = src[c.lane + 64 * j]; }
            { const int row = 2 * rp, r = row < NLAT ? (row >> 11) : 16;
              if (r != cur_r) { cur_r = r; const float* mp = MOD + (size_t)r * 6144; const f32x4* sh = (const f32x4*)mp; const f32x4* scl = (const f32x4*)(mp + 1024);
#pragma unroll
                  for (int j = 0; j < 4; ++j) { const int q = c.lane + 64 * j; al[j] = g[q] * (scl[q] + 1.0f); be[j] = sh[q]; } } }
#pragma unroll
            for (int k = 0; k < 2; ++k) { const int row = 2 * rp + k; float ss = 0.f;
#pragma unroll
                for (int j = 0; j < 4; ++j) ss += (v[k][j][0] * v[k][j][0] + v[k][j][1] * v[k][j][1]) + (v[k][j][2] * v[k][j][2] + v[k][j][3] * v[k][j][3]);
                const float rstd = 1.0f / sqrtf(wave_sum(ss) * (1.0f / D) + EPS);
                u32x2* o = (u32x2*)(H + (size_t)row * D); unsigned* o8 = (unsigned*)(c.ws + WS_H8 + (size_t)row * D);
#pragma unroll
                for (int j = 0; j < 4; ++j) { const f32x4 hv = v[k][j] * rstd * al[j] + be[j]; o[c.lane + 64 * j] = pk4(hv); o8[c.lane + 64 * j] = f8x4(hv); } }
        }
        return;
    }
    const int MeP = (l - 1 == DEPTH - 1) ? 4096 : 4608;
    const int rpw = (nrows + NGW - 1) / NGW, rbeg = gw * rpw, rend = (rbeg + rpw < nrows) ? rbeg + rpw : nrows;
    f32x4 vn[4], g2v[4]; int slotn = -1;
    if (rbeg < rend) { const u32x2* src = (const u32x2*)(X + (size_t)rbeg * D);
#pragma unroll
        for (int j = 0; j < 4; ++j) vn[j] = unpk4(src[c.lane + 64 * j]);
        slotn = (int)SLOT[(size_t)rbeg * 16 + (c.lane & 15)]; }
    for (int row = rbeg; row < rend; ++row) {
        const int r = row < NLAT ? (row >> 11) : 16;
        f32x4 v[4];
#pragma unroll
        for (int j = 0; j < 4; ++j) v[j] = vn[j];
        const int myslot = slotn;
        { const int nr = row + 1; if (nr < rend) { const u32x2* src = (const u32x2*)(X + (size_t)nr * D);
#pragma unroll
            for (int j = 0; j < 4; ++j) vn[j] = unpk4(src[c.lane + 64 * j]);
            slotn = (int)SLOT[(size_t)nr * 16 + (c.lane & 15)]; } }
        if (r != cur_r) { cur_r = r; const f32x4* g2 = (const f32x4*)(MOD + (size_t)((l - 1) * 17 + r) * 6144 + 5120);
#pragma unroll
            for (int j = 0; j < 4; ++j) g2v[j] = g2[c.lane + 64 * j] * YE_INV;
            if (!fin) { const f32x4* g = (const f32x4*)(c.in[I_NMG] + l * D); const float* mp = MOD + (size_t)(l * 17 + r) * 6144; const f32x4* sh = (const f32x4*)mp; const f32x4* scl = (const f32x4*)(mp + 1024);
#pragma unroll
                for (int j = 0; j < 4; ++j) { const int q = c.lane + 64 * j; al[j] = g[q] * (scl[q] + 1.0f); be[j] = sh[q]; } }
            else { const f32x4* g = (const f32x4*)c.in[I_FNG];
#pragma unroll
                for (int j = 0; j < 4; ++j) al[j] = g[c.lane + 64 * j]; } }
        f32x4 a[4];
#pragma unroll
        for (int j = 0; j < 4; ++j) a[j] = (f32x4){0.f, 0.f, 0.f, 0.f};
        const int ybase = row < NLAT ? (row >> 11) * CAPL : 4096 + ((row - NLAT) >> 8) * CAPC;
        unsigned long long sel = __builtin_amdgcn_ballot_w64(myslot >= 0) & 0xFFFFull;
        while (sel) {
            const int e0 = __builtin_ctzll(sel); sel &= sel - 1; const bool two = sel != 0; const int e1 = two ? __builtin_ctzll(sel) : e0; if (two) sel &= sel - 1;
            const int s0 = __builtin_amdgcn_readlane(myslot, e0), s1 = __builtin_amdgcn_readlane(myslot, e1);
            const int* y0 = (const int*)(YE + ((size_t)e0 * MeP + ybase + s0) * D); const int* y1 = (const int*)(YE + ((size_t)e1 * MeP + ybase + s1) * D);
            int w0[4], w1[4];
#pragma unroll
            for (int j = 0; j < 4; ++j) { w0[j] = y0[c.lane + 64 * j]; w1[j] = y1[c.lane + 64 * j]; }
            const float k1 = two ? 1.0f : 0.0f;
#pragma unroll
            for (int j = 0; j < 4; ++j) { const f32x2 lo0 = __builtin_amdgcn_cvt_pk_f32_fp8(w0[j], false), hi0 = __builtin_amdgcn_cvt_pk_f32_fp8(w0[j], true), lo1 = __builtin_amdgcn_cvt_pk_f32_fp8(w1[j], false), hi1 = __builtin_amdgcn_cvt_pk_f32_fp8(w1[j], true);
                a[j] += (f32x4){lo0.x, lo0.y, hi0.x, hi0.y} + (f32x4){lo1.x, lo1.y, hi1.x, hi1.y} * k1; }
        }
#pragma unroll
        for (int j = 0; j < 4; ++j) v[j] += g2v[j] * a[j];
        if (!fin) { u32x2* dst = (u32x2*)(X + (size_t)row * D);
#pragma unroll
            for (int j = 0; j < 4; ++j) dst[c.lane + 64 * j] = pk4(v[j]); }
        float ss = 0.f;
#pragma unroll
        for (int j = 0; j < 4; ++j) ss += (v[j][0] * v[j][0] + v[j][1] * v[j][1]) + (v[j][2] * v[j][2] + v[j][3] * v[j][3]);
        const float rstd = 1.0f / sqrtf(wave_sum(ss) * (1.0f / D) + EPS);
        if (fin) { f32x4* o = (f32x4*)(c.out + (size_t)row * D);
#pragma unroll
            for (int j = 0; j < 4; ++j) o[c.lane + 64 * j] = v[j] * rstd * al[j];
        } else { u32x2* o = (u32x2*)(H + (size_t)row * D); unsigned* o8 = (unsigned*)(c.ws + WS_H8 + (size_t)row * D);
#pragma unroll
            for (int j = 0; j < 4; ++j) { const f32x4 hv = v[j] * rstd * al[j] + be[j]; o[c.lane + 64 * j] = pk4(hv); o8[c.lane + 64 * j] = f8x4(hv); } }
    }
}
constexpr int F1_P = 1028;
__device__ __forceinline__ void phase_norm2(const Ctx& c0, int l) {
    const Ctx c = fresh(c0);
    LAS float* T = (LAS float*)c.lds;
    LAS float* PART = T + 16 * F1_P;
    LAS float* RS = PART + 8 * 256;
    LAS float* CP = RS + 16;
    const int nrows = (l == DEPTH - 1) ? NLAT : NROW, ntile = nrows / 16;
    const int tpw = (ntile + c.G - 1) / c.G, tbeg = c.bid * tpw, tend = (tbeg + tpw < ntile) ? tbeg + tpw : ntile;
    const float* MOD = (const float*)(c.ws + WS_MOD); const bf16* X = (const bf16*)(c.ws + WS_X); unsigned char* H = c.ws + WS_H; float* AFF = (float*)(c.ws + WS_AFF);
    const float* WR = c.in[I_WROUTER] + (size_t)l * 16384; const float* GF = c.in[I_NFG] + l * D;
    const int tid = c.tid, lane = c.lane, w = c.wave, e16 = lane & 15, kk = lane >> 4;
    u32x4 ld[4];
#define F1_LOAD(t_, tq_) do { const u32x4* src_ = (const u32x4*)(X + (size_t)(t_) * 16 * D) + (tq_); _Pragma("unroll") for (int i_ = 0; i_ < 4; ++i_) ld[i_] = src_[512 * i_]; } while (0)
    if (tbeg < tend) F1_LOAD(tbeg, tid);
    float Breg[32]; float creg = 0.f; int cur_r = -1;
    for (int t = tbeg; t < tend; ++t) {
        int tq = tid; asm volatile("" : "+v"(tq));
        const int row0 = t * 16, r = row0 < NLAT ? (row0 >> 11) : 16;
#pragma unroll
        for (int i = 0; i < 4; ++i) { const int g = tq + 512 * i; LAS f32x4* tp = (LAS f32x4*)(T + (g >> 7) * F1_P + 8 * (g & 127)); tp[0] = unpk4((u32x2){ld[i].x, ld[i].y}); tp[1] = unpk4((u32x2){ld[i].z, ld[i].w}); }
        if (t + 1 < tend) F1_LOAD(t + 1, tq);
        const float* mp = MOD + (size_t)(l * 17 + r) * 6144;
        if (r != cur_r) { cur_r = r;
            float cpart = 0.f;
#pragma unroll
            for (int s4 = 0; s4 < 32; ++s4) { const int k = 128 * w + 4 * s4 + kk; const float wv = WR[k * 16 + e16]; Breg[s4] = GF[k] * (mp[4096 + k] + 1.0f) * wv; cpart += mp[3072 + k] * wv; if ((s4 & 3) == 3) asm volatile("" ::: "memory"); }
            CP[(w * 4 + kk) * 16 + e16] = cpart; }
        __syncthreads();
#pragma unroll
        for (int k2 = 0; k2 < 2; ++k2) { const int row = 2 * w + k2; float ss = 0.f;
#pragma unroll
            for (int j = 0; j < 4; ++j) { const f32x4 x = *(const LAS f32x4*)(T + row * F1_P + 4 * (lane + 64 * j)); ss += (x[0] * x[0] + x[1] * x[1]) + (x[2] * x[2] + x[3] * x[3]); }
            ss = wave_sum(ss); if (lane == 0) RS[row] = 1.0f / sqrtf(ss * (1.0f / D) + EPS); }
        f32x4 acc = (f32x4){0.f, 0.f, 0.f, 0.f};
#pragma unroll
        for (int s4 = 0; s4 < 32; ++s4) { acc = __builtin_amdgcn_mfma_f32_16x16x4f32(T[e16 * F1_P + 128 * w + 4 * s4 + kk], Breg[s4], acc, 0, 0, 0);
            if ((s4 & 7) == 7) asm volatile("" ::: "memory"); }
#pragma unroll
        for (int i = 0; i < 4; ++i) PART[w * 256 + (4 * kk + i) * 16 + e16] = acc[i];
        __syncthreads();
        if (tq < 256) { const int row = tq >> 4, e = tq & 15; float sum = 0.f, cc = 0.f;
#pragma unroll
            for (int w8 = 0; w8 < 8; ++w8) sum += PART[w8 * 256 + row * 16 + e];
#pragma unroll
            for (int q = 0; q < 32; ++q) cc += CP[q * 16 + e];
            const float lg = RS[row] * sum + cc;
            float mx = lg; mx = fmaxf(mx, __shfl_xor(mx, 1)); mx = fmaxf(mx, __shfl_xor(mx, 2)); mx = fmaxf(mx, __shfl_xor(mx, 4)); mx = fmaxf(mx, __shfl_xor(mx, 8));
            const float ex = expf(lg - mx); float sm = ex; sm += __shfl_xor(sm, 1); sm += __shfl_xor(sm, 2); sm += __shfl_xor(sm, 4); sm += __shfl_xor(sm, 8);
            AFF[(size_t)(row0 + row) * 16 + e] = ex / sm; }
#pragma unroll
        for (int i = 0; i < 8; ++i) { const int g = tq + 512 * i, row = g >> 8, c4 = g & 255; const f32x4 x = *(const LAS f32x4*)(T + row * F1_P + 4 * c4);
            const f32x4 gf = *(const f32x4*)(GF + 4 * c4), sc = *(const f32x4*)(mp + 4096 + 4 * c4), sh = *(const f32x4*)(mp + 3072 + 4 * c4);
            const f32x4 hv = x * RS[row] * gf * (sc + 1.0f) + sh;
            int wv = 0; wv = __builtin_amdgcn_cvt_pk_fp8_f32(hv[0], hv[1], wv, false); wv = __builtin_amdgcn_cvt_pk_fp8_f32(hv[2], hv[3], wv, true);
            *(int*)(H + (size_t)(row0 + row) * D + 4 * c4) = wv; if (i & 1) asm volatile("" ::: "memory"); }
        __syncthreads();
    }
#undef F1_LOAD
}
__device__ __forceinline__ void phase_topk(const Ctx& c0, int l) {
    const Ctx c = fresh(c0);
    LAS unsigned long long* keys = (LAS unsigned long long*)c.lds;
    const float* AFF = (const float*)(c.ws + WS_AFF); int* ROWIDX = (int*)(c.ws + WS_ROWIDX); float* GVAL = (float*)(c.ws + WS_GVAL); short* SLOT = (short*)(c.ws + WS_SLOT);
    const bool last = (l == DEPTH - 1); const int Me = last ? 4096 : 4608; const int nitems = last ? 256 : 512;
    for (int item = c.bid; item < nitems; item += c.G) {
        const bool isctx = item >= 256; const int b = (item & 255) >> 4, e = item & 15;
        const int n = isctx ? CTXL : SEQ, cap = isctx ? CAPC : CAPL, rbase = isctx ? NLAT + b * CTXL : b * SEQ;
        for (int t = c.tid; t < n; t += NTHR) { const unsigned a = __builtin_bit_cast(unsigned, AFF[(size_t)(rbase + t) * 16 + e]); keys[t] = ((unsigned long long)a << 32) | (unsigned long long)(0xFFFFFFFFu - (unsigned)t); }
        __syncthreads();
        for (int k = 2; k <= n; k <<= 1) {
            if ((k >> 1) > 32) __syncthreads();
            for (int lj = 31 - __builtin_clz(k >> 1); lj >= 0; --lj) { const int j = 1 << lj;
                for (int i = c.tid; i < n / 2; i += NTHR) { const int ix = ((i >> lj) << (lj + 1)) | (i & (j - 1)), iy = ix + j; const unsigned long long a = keys[ix], bb = keys[iy]; const bool up = (ix & k) == 0;
                    if (up ? (a < bb) : (a > bb)) { keys[ix] = bb; keys[iy] = a; } }
                if (j > 32) __syncthreads(); else asm volatile("s_waitcnt lgkmcnt(0)" ::: "memory");
            } }
        __syncthreads();
        const int ybase = e * Me + (isctx ? 4096 + b * CAPC : b * CAPL);
        for (int p = c.tid; p < n; p += NTHR) { const unsigned long long kv = keys[p]; const int t = (int)(0xFFFFFFFFu - (unsigned)(kv & 0xFFFFFFFFull));
            SLOT[(size_t)(rbase + t) * 16 + e] = (short)(p < cap ? p : -1);
            if (p < cap) { ROWIDX[ybase + p] = rbase + t; GVAL[ybase + p] = __builtin_bit_cast(float, (unsigned)(kv >> 32)); } }
        __syncthreads();
    }
}
typedef float f32x16 __attribute__((ext_vector_type(16)));
constexpr int AT_KP = 272, AT_VP = 136, AT_KB = 64 * AT_KP, AT_VB = 128 * AT_VP;
__device__ __forceinline__ void phase_attn(const Ctx& c0, int l, int r_lo, int r_hi) {
    const Ctx c = fresh(c0);
    const bool lastl = (l == DEPTH - 1); const int nitems = lastl ? 1024 : 1152;
    const bf16* Q = (const bf16*)(c.ws + WS_Q); const bf16* Kb = (const bf16*)(c.ws + WS_K); const bf16* Vt = (const bf16*)(c.ws + WS_VT); bf16* ATT = (bf16*)(c.ws + WS_H);
    const int w = c.wave, lane = c.lane, lq = lane & 31, h = lane >> 5, tid = c.tid;
    const float scale2 = 0.08838834764831845f * 1.4426950408889634f;
    for (int item = c.bid + c.G * r_lo; item < nitems && item < c.bid + c.G * r_hi; item += c.G) {
        int b, n, kvh, hp; bool isctx;
        if (item < 1024) { b = item >> 6; n = (item >> 2) & 15; kvh = (item >> 1) & 1; hp = item & 1; isctx = false; }
        else { const int it = item - 1024; b = it >> 3; kvh = (it >> 2) & 1; hp = (it >> 1) & 1; n = it & 1; isctx = true; }
        const int qw = (w & 3) ^ ((w >> 2) << 1);
        const int head = kvh * 4 + hp * 2 + (w >> 2), qi = qw * 32 + lq;
        const int qrow = (isctx ? NLAT + b * CTXL : b * SEQ) + n * 128 + qi;
        const int tlo = isctx ? 0 : (n == 0 ? 2 : 0), nband = isctx ? 0 : ((n == 15 ? 4 : 6) - tlo), ntile = nband + 4;
        bf16x8 qf[8];
        { const u32x4* qp = (const u32x4*)(Q + (size_t)qrow * 1024 + head * 128 + 8 * h);
#pragma unroll
            for (int ks = 0; ks < 8; ++ks) qf[ks] = __builtin_bit_cast(bf16x8, qp[2 * ks]); }
        f32x16 O[4];
#pragma unroll
        for (int dt = 0; dt < 4; ++dt)
#pragma unroll
            for (int r = 0; r < 16; ++r) O[dt][r] = 0.f;
        float mrun = c.in[I_SINK][l * 8 + head] * (1.4426950408889634f / scale2), lsum = (h == 0) ? 1.0f : 0.0f;
        u32x4 kreg[2], vreg[2];
        auto tile_row0 = [&](int i) -> int { return i < nband ? b * SEQ + (n - 1) * 128 + (tlo + i) * 64 : NLAT + b * CTXL + (i - nband) * 64; };
#define AT_LOAD(i_) do { const int r0_ = tile_row0(i_); _Pragma("unroll") for (int i2 = 0; i2 < 2; ++i2) { const int cidx = tid + 512 * i2; \
            kreg[i2] = *(const u32x4*)(Kb + (size_t)(r0_ + (cidx >> 4)) * 256 + kvh * 128 + (cidx & 15) * 8); \
            vreg[i2] = *(const u32x4*)(Vt + (size_t)(kvh * 128 + (cidx >> 3)) * NROW + r0_ + (cidx & 7) * 8); } } while (0)
#define AT_STORE(buf_) do { _Pragma("unroll") for (int i2 = 0; i2 < 2; ++i2) { const int cidx = tid + 512 * i2; \
            *(LAS u32x4*)(c.lds + (buf_) * AT_KB + (cidx >> 4) * AT_KP + (cidx & 15) * 16) = kreg[i2]; \
            LAS u32x2* vp_ = (LAS u32x2*)(c.lds + 2 * AT_KB + (buf_) * AT_VB + (cidx >> 3) * AT_VP + (cidx & 7) * 16); \
            vp_[0] = (u32x2){vreg[i2].x, vreg[i2].y}; vp_[1] = (u32x2){vreg[i2].z, vreg[i2].w}; } } while (0)
        AT_LOAD(0); AT_STORE(0);
        __syncthreads();
        for (int i = 0; i < ntile; ++i) {
            const int buf = i & 1;
            if (i + 1 < ntile) AT_LOAD(i + 1);
            const int tau = i < nband ? tlo + i : 2;
            const int mtype = tau >> 1, kbase = (tau & 1) * 64;
            const LAS unsigned char* Kl = c.lds + buf * AT_KB; const LAS unsigned char* Vl = c.lds + 2 * AT_KB + buf * AT_VB;
            const int ks0 = (tau & 1) * 2;
            const bool d0 = (mtype == 0 && ks0 < qw) || (mtype == 2 && ks0 > qw), d1 = (mtype == 0 && ks0 + 1 < qw) || (mtype == 2 && ks0 + 1 > qw);
            if (!(d0 && d1)) {
            f32x16 S[2];
#pragma unroll
            for (int sub = 0; sub < 2; ++sub) { if (sub ? d1 : d0) continue;
#pragma unroll
                for (int r = 0; r < 16; ++r) S[sub][r] = 0.f;
#pragma unroll
                for (int ks = 0; ks < 8; ++ks) { const bf16x8 kf = *(const LAS bf16x8*)(Kl + (sub * 32 + lq) * AT_KP + ks * 32 + h * 16);
                    S[sub] = __builtin_amdgcn_mfma_f32_32x32x16_bf16(kf, qf[ks], S[sub], 0, 0, 0); }
            }
            float mx = -INFINITY;
            if (mtype != 1) {
#pragma unroll
                for (int sub = 0; sub < 2; ++sub) if (ks0 + sub == qw)
#pragma unroll
                    for (int r = 0; r < 16; ++r) { const int kj = kbase + sub * 32 + (r & 3) + 8 * (r >> 2) + 4 * h; const bool valid = (mtype == 0) ? (kj >= qi) : (kj <= qi); S[sub][r] = valid ? S[sub][r] : -INFINITY; } }
#pragma unroll
            for (int sub = 0; sub < 2; ++sub) if (!(sub ? d1 : d0))
#pragma unroll
                for (int r = 0; r < 16; r += 2) mx = fmaxf(mx, fmaxf(S[sub][r], S[sub][r + 1]));
            mx = fmaxf(mx, __shfl_xor(mx, 32));
            const float mnew = fmaxf(mrun, mx), alpha = __builtin_amdgcn_exp2f((mrun - mnew) * scale2); mrun = mnew;
            const f32x2 nms = (f32x2){-mnew * scale2, -mnew * scale2};
            f32x2 ps2 = (f32x2){0.f, 0.f};
#pragma unroll
            for (int sub = 0; sub < 2; ++sub) if (!(sub ? d1 : d0))
#pragma unroll
                for (int r = 0; r < 16; r += 2) { const f32x2 a2 = (f32x2){S[sub][r], S[sub][r + 1]} * scale2 + nms; const f32x2 p2 = (f32x2){__builtin_amdgcn_exp2f(a2.x), __builtin_amdgcn_exp2f(a2.y)}; S[sub][r] = p2.x; S[sub][r + 1] = p2.y; ps2 += p2; }
            const float psum = ps2.x + ps2.y;
            lsum = lsum * alpha + psum;
#pragma unroll
            for (int dt = 0; dt < 4; ++dt) O[dt] = O[dt] * alpha;
#pragma unroll
            for (int sub = 0; sub < 2; ++sub) if (!(sub ? d1 : d0))
#pragma unroll
                for (int s2 = 0; s2 < 2; ++s2) {
                    u32x4 pw; pw.x = pk2(S[sub][8 * s2 + 0], S[sub][8 * s2 + 1]); pw.y = pk2(S[sub][8 * s2 + 2], S[sub][8 * s2 + 3]); pw.z = pk2(S[sub][8 * s2 + 4], S[sub][8 * s2 + 5]); pw.w = pk2(S[sub][8 * s2 + 6], S[sub][8 * s2 + 7]);
                    const bf16x8 pf = __builtin_bit_cast(bf16x8, pw);
                    const int kb2 = (sub * 32 + 16 * s2 + 4 * h) * 2;
#pragma unroll
                    for (int dt = 0; dt < 4; ++dt) { const LAS unsigned char* vp = Vl + (32 * dt + lq) * AT_VP + kb2;
                        const u32x2 v0 = *(const LAS u32x2*)vp, v1 = *(const LAS u32x2*)(vp + 16);
                        const bf16x8 vf = __builtin_bit_cast(bf16x8, (u32x4){v0.x, v0.y, v1.x, v1.y});
                        O[dt] = __builtin_amdgcn_mfma_f32_32x32x16_bf16(vf, pf, O[dt], 0, 0, 0); }
                }
            }
            if (i + 1 < ntile) AT_STORE(buf ^ 1);
            __syncthreads();
        }
#undef AT_LOAD
#undef AT_STORE
        const float inv = 1.0f / (lsum + __shfl_xor(lsum, 32));
        bf16* op = ATT + (size_t)qrow * 1024 + head * 128 + 4 * h;
#pragma unroll
        for (int dt = 0; dt < 4; ++dt)
#pragma unroll
            for (int g = 0; g < 4; ++g) { u32x2 wv; wv.x = pk2(O[dt][4 * g] * inv, O[dt][4 * g + 1] * inv); wv.y = pk2(O[dt][4 * g + 2] * inv, O[dt][4 * g + 3] * inv); *(u32x2*)(op + 32 * dt + 8 * g) = wv; }
    }
}

constexpr int RG_UP = 272;
template <bool REV> __device__ __forceinline__ void rg_scan(const float (&a)[4][4], float (&bc)[4][4], float& H, int q, const int (&baddr)[4]) {
    float A4[4], B4[4];
#pragma unroll
    for (int tt = 0; tt < 4; ++tt) { float A = 1.f, B = 0.f;
#pragma unroll
        for (int ri = 0; ri < 4; ++ri) { const int r = REV ? 3 - ri : ri; B = a[tt][r] * B + bc[tt][r]; A *= a[tt][r]; }
        A4[tt] = A; B4[tt] = B; }
    float Ag[4][4], Bg[4][4];
#pragma unroll
    for (int tt = 0; tt < 4; ++tt)
#pragma unroll
        for (int qq = 0; qq < 4; ++qq) { Ag[tt][qq] = __builtin_bit_cast(float, __builtin_amdgcn_ds_bpermute(baddr[qq], __builtin_bit_cast(int, A4[tt]))); Bg[tt][qq] = __builtin_bit_cast(float, __builtin_amdgcn_ds_bpermute(baddr[qq], __builtin_bit_cast(int, B4[tt]))); }
    const int g0 = REV ? 3 : 0, g1 = REV ? 2 : 1, g2 = REV ? 1 : 2, g3 = REV ? 0 : 3;
    const int rank = REV ? 3 - q : q;
#pragma unroll
    for (int tti = 0; tti < 4; ++tti) { const int tt = REV ? 3 - tti : tti;
        const float A1 = Ag[tt][g1] * Ag[tt][g0], B1 = Ag[tt][g1] * Bg[tt][g0] + Bg[tt][g1];
        const float A2 = Ag[tt][g2] * A1, B2 = Ag[tt][g2] * B1 + Bg[tt][g2];
        const float A3 = Ag[tt][g3] * A2, B3 = Ag[tt][g3] * B2 + Bg[tt][g3];
        float myA = rank == 1 ? Ag[tt][g0] : 1.f, myB = rank == 1 ? Bg[tt][g0] : 0.f;
        myA = rank == 2 ? A1 : myA; myB = rank == 2 ? B1 : myB; myA = rank == 3 ? A2 : myA; myB = rank == 3 ? B2 : myB;
        float hc = myA * H + myB;
#pragma unroll
        for (int ri = 0; ri < 4; ++ri) { const int r = REV ? 3 - ri : ri; hc = a[tt][r] * hc + bc[tt][r]; bc[tt][r] = hc; }
        H = A3 * H + B3;
    }
}
__device__ __forceinline__ void phase_rglru(const Ctx& c0, int l) {
    const Ctx c = fresh(c0);
    const bool lastl = (l == DEPTH - 1);
    LAS unsigned char* UC = c.lds; LAS unsigned char* HS = c.lds + 2 * 64 * RG_UP;
    const bf16* U = (const bf16*)(c.ws + WS_U); const bf16* GZ = (const bf16*)(c.ws + WS_GZ); bf16* REC = (bf16*)(c.ws + WS_REC); const bf16* LW = (const bf16*)(c.ws + WS_LW);
    const int tid = c.tid, lane = c.lane, w = c.wave, dir = w >> 2, cg = w & 3, chl = lane & 15, q = lane >> 4;
    for (int item = c.bid; item < 256; item += c.G) {
        const int b = item >> 4, nb = (item >> 1) & 7, half = item & 1, cbase = nb * 128, oc = 16 * cg + chl, och = half * 64 + oc, col = cbase + och;
        bf16x8 wf[2][4];
#pragma unroll
        for (int g = 0; g < 2; ++g)
#pragma unroll
            for (int ks = 0; ks < 4; ++ks) wf[g][ks] = *(const bf16x8*)(LW + (size_t)(((dir * 8 + nb) * 2 + g) * 128 + och) * 128 + 32 * ks + 8 * q);
        const float ba = c.in[I_LBA][(l * 2 + dir) * D + col], bx = c.in[I_LBX][(l * 2 + dir) * D + col];
        const float Kc = -8.0f * log1pf(expf(-c.in[I_LAM][(l * 2 + dir) * D + col])) * 1.4426950408889634f;
        f32x2 cw[4][4], cbias[4];
        const int c8 = tid & 15, tg = (tid >> 4) & 15, dcv = tid >> 8;
        {
#pragma unroll
            for (int p = 0; p < 4; ++p) { cbias[p] = (f32x2){c.in[I_CONVB][l * D + cbase + 8 * c8 + 2 * p], c.in[I_CONVB][l * D + cbase + 8 * c8 + 2 * p + 1]};
#pragma unroll
                for (int k = 0; k < 4; ++k) cw[k][p] = (f32x2){c.in[I_CONVW][(l * 4 + k) * D + cbase + 8 * c8 + 2 * p], c.in[I_CONVW][(l * 4 + k) * D + cbase + 8 * c8 + 2 * p + 1]}; } }
        float H = 0.f;
        int baddr[4];
#pragma unroll
        for (int qq = 0; qq < 4; ++qq) baddr[qq] = (chl + 16 * qq) * 4;
        u32x4 uraw[7];
#define RG_ULOAD(s_) do { const int tau_ = dcv == 0 ? (s_) : ((s_) < 4 ? 3 - (s_) : 39 - (s_)); const bool isc_ = tau_ < 4; const int T_ = isc_ ? CTXL : SEQ, ts0_ = (isc_ ? tau_ : tau_ - 4) * 64 + 4 * tg - 2; \
            const bf16* up_ = U + (size_t)((isc_ ? NLAT + b * CTXL : b * SEQ) + ts0_) * D + cbase + 8 * c8; \
            _Pragma("unroll") for (int i_ = 0; i_ < 7; ++i_) uraw[i_] = (ts0_ + i_ >= 0 && ts0_ + i_ < T_) ? *(const u32x4*)(up_ + (size_t)i_ * D) : (u32x4){0u, 0u, 0u, 0u}; } while (0)
        RG_ULOAD(0);
        for (int s = 0; s < 36; ++s) {
#pragma unroll
            for (int tk = 0; tk < 4; ++tk) {
                u32x4 pw;
#pragma unroll
                for (int p = 0; p < 4; ++p) {
                    f32x2 o = cbias[p];
#pragma unroll
                    for (int k = 0; k < 4; ++k) o = cw[k][p] * (f32x2){bf_lo(uraw[tk + k][p]), bf_hi(uraw[tk + k][p])} + o;
                    pw[p] = pk2(o.x, o.y); }
                *(LAS u32x4*)(UC + (dcv * 64 + 4 * tg + tk) * RG_UP + c8 * 16) = pw;
            }
            __syncthreads();
            if (s + 1 < 36) RG_ULOAD(s + 1);
            u32x4 rvp[2], zvp[2];
#pragma unroll
            for (int dc = 0; dc < 2; ++dc) {
                const int t = tid >> 3, o8 = tid & 7;
                const int tau = dc == 0 ? s : (s < 4 ? 3 - s : 39 - s);
                const int other = dc == 0 ? (tau < 4 ? 3 - tau : 39 - tau) : tau;
                rvp[dc] = (u32x4){0u, 0u, 0u, 0u}; zvp[dc] = (u32x4){0u, 0u, 0u, 0u};
                if (other < s && !(lastl && tau < 4)) { const int row = (tau < 4 ? NLAT + b * CTXL + tau * 64 : b * SEQ + (tau - 4) * 64) + t; const size_t o = (size_t)row * D + cbase + half * 64 + o8 * 8;
                    rvp[dc] = *(const u32x4*)(REC + o); zvp[dc] = *(const u32x4*)(GZ + o); }
            }
            f32x4 gr[4], gi[4];
#pragma unroll
            for (int tt = 0; tt < 4; ++tt) { gr[tt] = (f32x4){0.f, 0.f, 0.f, 0.f}; gi[tt] = (f32x4){0.f, 0.f, 0.f, 0.f}; }
#pragma unroll
            for (int tt = 0; tt < 4; ++tt)
#pragma unroll
                for (int ks = 0; ks < 4; ++ks) { const bf16x8 af = *(const LAS bf16x8*)(UC + (dir * 64 + 16 * tt + chl) * RG_UP + (32 * ks + 8 * q) * 2);
                    gr[tt] = __builtin_amdgcn_mfma_f32_16x16x32_bf16(af, wf[0][ks], gr[tt], 0, 0, 0); gi[tt] = __builtin_amdgcn_mfma_f32_16x16x32_bf16(af, wf[1][ks], gi[tt], 0, 0, 0); }
            float av[4][4], bv[4][4];
            { const float L2E = 1.4426950408889634f; const f32x2 nba = (f32x2){-L2E * ba, -L2E * ba}, nbx = (f32x2){-L2E * bx, -L2E * bx};
#pragma unroll
              for (int tt = 0; tt < 4; ++tt)
#pragma unroll
                for (int rp = 0; rp < 2; ++rp) { const int tok = 16 * tt + 4 * q + 2 * rp;
                    const LAS unsigned char* up = UC + (dir * 64 + tok) * RG_UP + och * 2;
                    const f32x2 ucv = (f32x2){bf2f(*(const LAS bf16*)up), bf2f(*(const LAS bf16*)(up + RG_UP))};
                    const f32x2 xr = (f32x2){gr[tt][2 * rp], gr[tt][2 * rp + 1]} * (-L2E) + nba, xi = (f32x2){gi[tt][2 * rp], gi[tt][2 * rp + 1]} * (-L2E) + nbx;
                    f32x2 er = (f32x2){__builtin_amdgcn_exp2f(xr.x), __builtin_amdgcn_exp2f(xr.y)} + 1.0f, ei = (f32x2){__builtin_amdgcn_exp2f(xi.x), __builtin_amdgcn_exp2f(xi.y)} + 1.0f;
                    const f32x2 rr = (f32x2){__builtin_amdgcn_rcpf(er.x), __builtin_amdgcn_rcpf(er.y)}, ii = (f32x2){__builtin_amdgcn_rcpf(ei.x), __builtin_amdgcn_rcpf(ei.y)};
                    const f32x2 la = rr * Kc; const f32x2 a2 = (f32x2){__builtin_amdgcn_exp2f(la.x), __builtin_amdgcn_exp2f(la.y)};
                    f32x2 om = 1.0f - a2 * a2; om.x = fmaxf(om.x, 0.f); om.y = fmaxf(om.y, 0.f);
                    const f32x2 b2 = (f32x2){__builtin_amdgcn_sqrtf(om.x), __builtin_amdgcn_sqrtf(om.y)} * (ii * ucv);
                    av[tt][2 * rp] = a2.x; av[tt][2 * rp + 1] = a2.y; bv[tt][2 * rp] = b2.x; bv[tt][2 * rp + 1] = b2.y; } }
            if (dir) rg_scan<true>(av, bv, H, q, baddr); else rg_scan<false>(av, bv, H, q, baddr);
#pragma unroll
            for (int tt = 0; tt < 4; ++tt)
#pragma unroll
                for (int rp = 0; rp < 2; ++rp) { const unsigned w2 = pk2(bv[tt][2 * rp], bv[tt][2 * rp + 1]); LAS unsigned char* hp = HS + (dir * 64 + 16 * tt + 4 * q + 2 * rp) * 128 + oc * 2;
                    *(LAS bf16*)hp = (bf16)(w2 & 0xffffu); *(LAS bf16*)(hp + 128) = (bf16)(w2 >> 16); }
            __syncthreads();
#pragma unroll
            for (int dc = 0; dc < 2; ++dc) {
                const int t = tid >> 3, o8 = tid & 7;
                const int tau = dc == 0 ? s : (s < 4 ? 3 - s : 39 - s);
                const int other = dc == 0 ? (tau < 4 ? 3 - tau : 39 - tau) : tau; const bool second = other < s;
                if (lastl && tau < 4) continue;
                const int row = (tau < 4 ? NLAT + b * CTXL + tau * 64 : b * SEQ + (tau - 4) * 64) + t;
                const u32x4 hv = *(const LAS u32x4*)(HS + (dc * 64 + t) * 128 + o8 * 16);
                const size_t o = (size_t)row * D + cbase + half * 64 + o8 * 8;
                if (!second) *(u32x4*)(REC + o) = hv;
                else { const u32x4 rv = rvp[dc], zv = zvp[dc]; u32x4 ov;
#pragma unroll
                    for (int p = 0; p < 4; ++p) { const f32x2 y = ((f32x2){bf_lo(rv[p]), bf_hi(rv[p])} + (f32x2){bf_lo(hv[p]), bf_hi(hv[p])}) * (f32x2){bf_lo(zv[p]), bf_hi(zv[p])}; ov[p] = pk2(y.x, y.y); }
                    *(u32x4*)(REC + o) = ov; }
            }
        }
#undef RG_ULOAD
        __syncthreads();
    }
}

constexpr int PH_PER_LAYER = 10, NPH = 1 + DEPTH * PH_PER_LAYER + 1;
#ifndef PHASE_MASK
#define PHASE_MASK 0xFFFFu
#endif
#define PM(j) ((PHASE_MASK >> (j)) & 1u)
#ifndef PROBE_DOUBLE
#define PROBE_DOUBLE (-1)
#endif
#define REP(k) for (int rep_ = 0; rep_ < ((PROBE_DOUBLE == (k)) ? 2 : 1); ++rep_)
#define IN(k) (lo <= (k) && (k) < hi)
#define SEAM(k) do { if (IN(k) && IN((k) + 1)) xcd_barrier(bar); } while (0)
template <int l> __device__ __forceinline__ void run_layer(const Ctx& c, const XcdBarrier& bar, int lo, int hi) {
    LAS unsigned char* ring = c.lds;
        const int pb = 1 + l * PH_PER_LAYER; const bool last = (l == DEPTH - 1);
        const int nMrows = last ? 128 : 144, Me = last ? 4096 : 4608;
        const bool ovl = (l == 0 && c.G == 256 && lo <= pb + 3 && pb + 4 < hi);
        if (PM(1) && IN(pb + 0)) { if (l > 0 && !(c.G == 256 && IN(pb - 1))) { REP(1) phase_convert_weights(c, l); } phase_norm1(c, l); }
        SEAM(pb + 0);
        if (PM(2) && IN(pb + 1)) {
            REP(2) { ProbIn P; P.ws = c.ws; P.G = c.G; P.c = c.bid; P.nM = nMrows; P.nLat = nMrows * 13; P.nCtx = last ? 80 : 0; pg8::gemm_phase<ProbIn, true>(ring, P); }
            { ProbIn8 P; P.ws = c.ws; P.G = c.G; P.c = c.bid; P.nM = nMrows; P.bal = last && c.G == 256; pg8::gemm_phase<ProbIn8, true>(ring, P); }
            { ProbVt P; P.ws = c.ws; P.G = c.G; P.c = c.bid; P.bal = last && c.G == 256; pg8::gemm_phase<ProbVt, true>(ring, P); }
        }
        SEAM(pb + 1);
        if (PM(3) && IN(pb + 2)) {
            const int cgrp = c.bid % 6;
            const int tlo_ = (l > 0 && c.G == 256 && lo <= pb - 7 && pb - 6 < hi) ? 768 : 0;
            if (cgrp == 0) phase_convert_moe(c, l, 0, 0, tlo_);
            REP(3) phase_rglru(c, l); __syncthreads();
            if (cgrp == 1) phase_convert_moe(c, l, 0, 0, tlo_);
            REP(4) {
            phase_attn(c, l, 0, 1); if (cgrp == 2) phase_convert_moe(c, l, 0, 0, tlo_);
            phase_attn(c, l, 1, 2); if (cgrp == 3) phase_convert_moe(c, l, 0, 0, tlo_);
            phase_attn(c, l, 2, 3); if (cgrp == 4) phase_convert_moe(c, l, 0, 0, tlo_);
            phase_attn(c, l, 3, 8); if (cgrp == 5) phase_convert_moe(c, l, 0, 0, tlo_);
            }
        }
        SEAM(pb + 2);
        if (PM(4) && IN(pb + 3)) REP(5) {
            if (ovl) {
                unsigned* hw = (unsigned*)(c.ws + WS_CTL) + 8192;
                { ProbMerge01 P; P.ws = c.ws; P.G = c.G; P.c = c.bid; P.nM = nMrows; P.pbeg = 0; P.pend = 2; pg8::gemm_phase<ProbMerge01, true>(ring, P); }
                pg8::handoff_signal(bar, hw);
                if (c.bid < 64) { ProbMerge01 P; P.ws = c.ws; P.G = c.G; P.c = c.bid; P.nM = nMrows; P.pbeg = 2; P.pend = 3; pg8::gemm_phase<ProbMerge01, true>(ring, P); }
                else { pg8::handoff_wait(bar, hw);
                    ProbMerge<2> P; P.ws = c.ws; P.G = c.G; P.c = c.bid; P.nM = nMrows; P.l = l; P.xin = c.in[I_X]; P.cin = c.in[I_CTX]; P.ubeg = c.bid - 64; P.ustride = 192; P.ucnt = 2; pg8::gemm_phase<ProbMerge<2>, true>(ring, P); }
            } else { ProbMerge01 P; P.ws = c.ws; P.G = c.G; P.c = c.bid; P.nM = nMrows; P.pbeg = 0; P.pend = 1 << 20; pg8::gemm_phase<ProbMerge01, true>(ring, P); }
        }
        SEAM(pb + 3);
        if (PM(5) && IN(pb + 4)) { ProbMerge<2> P; P.ws = c.ws; P.G = c.G; P.c = c.bid; P.nM = nMrows; P.l = l; P.xin = c.in[I_X]; P.cin = c.in[I_CTX]; P.ubeg = c.bid; P.ustride = c.G; P.ucnt = 1 << 20;
            if (ovl) { P.ustride = 0; P.ucnt = c.bid < 192 ? 1 : 0; P.ubeg = c.bid < 128 ? 384 + c.bid : 512 + (c.bid - 128); }
            pg8::gemm_phase<ProbMerge<2>, true>(ring, P);
            if (ovl && c.bid >= 192) phase_convert_moe(c, l + 1, 192, 64, 0, 768); }
        SEAM(pb + 4);
        if (PM(6) && IN(pb + 5)) REP(6) phase_norm2(c, l);
        SEAM(pb + 5);
        if (PM(7) && IN(pb + 6)) REP(7) { phase_topk(c, l); __syncthreads(); }
        SEAM(pb + 6);
        if (PM(9) && IN(pb + 8)) REP(9) { ProbUp P; P.ws = c.ws; P.G = c.G; P.c = c.bid; P.Me = Me; P.l = l; pg8::gemm_phase<ProbUp, true>(ring, P); }
        SEAM(pb + 8);
        if (PM(10) && IN(pb + 9)) { REP(10) { ProbDown P; P.ws = c.ws; P.G = c.G; P.c = c.bid; P.Me = Me; P.l = l; pg8::gemm_phase<ProbDown, true>(ring, P); }
            if (!last && c.G == 256 && IN(pb + 10) && c.bid >= 128) { __syncthreads(); phase_convert_weights(c, l + 1, 128, 128); __syncthreads(); } }
        SEAM(pb + 9);
}
__global__ void __launch_bounds__(NTHR, 2) fwd(Args args) {
    extern __shared__ __attribute__((aligned(16))) unsigned char lds_raw[];
    Ctx c;
    c.in = args.in;
    c.out = args.out; c.ws = args.ws; c.lds = (LAS unsigned char*)lds_raw;
    c.tid = threadIdx.x; c.lane = c.tid & 63; c.wave = __builtin_amdgcn_readfirstlane(c.tid >> 6); c.G = gridDim.x; c.bid = blockIdx.x;
    volatile LAS unsigned* MISC = (volatile LAS unsigned*)(c.lds + MISC_OFF);
    if (c.tid < 4) MISC[c.tid] = 0u;
    __syncthreads();
    const int lo = args.ph_lo, hi = args.ph_hi;
    XcdBarrier bar; bar.bar = (unsigned*)(c.ws + WS_CTL) + 1024; bar.x = 0; bar.st = MISC;
    if (hi - lo > 1) bar = xcd_barrier_post((unsigned*)(c.ws + WS_CTL) + 1024, MISC);
    if (PM(0) && IN(0)) { REP(0) { phase_mod(c); __syncthreads(); phase_convert_weights(c, 0); } }
    SEAM(0);
    run_layer<0>(c, bar, lo, hi);
    run_layer<1>(c, bar, lo, hi);
    if (PM(11) && IN(NPH - 1)) phase_norm1(c, DEPTH);
#undef IN
#undef SEAM
}

extern "C" void kernel_launch(void* const* d_in, const int* in_sizes, int n_in, void* d_out, int out_size, void* d_ws, size_t ws_size, hipStream_t stream) {
    static int grid = 0;
    if (grid == 0) {
        if (n_in != 25 || in_sizes[0] != NLAT * D || out_size != NLAT * D || ws_size < WS_END) { fprintf(stderr, "kernel_launch: unexpected problem (n_in %d, in0 %d, out %d, ws %zu < %zu)\n", n_in, n_in > 0 ? in_sizes[0] : -1, out_size, ws_size, (size_t)WS_END); grid = -1; return; }
        int dev = 0, cus = 0, per_cu = 0;
        if (hipGetDevice(&dev) != hipSuccess || hipDeviceGetAttribute(&cus, hipDeviceAttributeMultiprocessorCount, dev) != hipSuccess) { grid = -1; return; }
        if (hipFuncSetAttribute((const void*)fwd, hipFuncAttributeMaxDynamicSharedMemorySize, LDS_BYTES) != hipSuccess) { fprintf(stderr, "kernel_launch: hipFuncSetAttribute failed\n"); grid = -1; return; }
        if (hipOccupancyMaxActiveBlocksPerMultiprocessor(&per_cu, (const void*)fwd, NTHR, LDS_BYTES) != hipSuccess || per_cu < 1) fprintf(stderr, "kernel_launch: occupancy query says %d\n", per_cu);
        (void)hipGetLastError();
        grid = cus;
        if (grid % 8 != 0) grid -= grid % 8;
    }
    if (grid < 0) return;
    (void)hipMemsetAsync((char*)d_ws + WS_CTL, 0, CTL_ZERO_BYTES, stream);
    Args a{};
    for (int i = 0; i < 25; ++i) a.in[i] = (const float*)d_in[i];
    a.out = (float*)d_out; a.ws = (unsigned char*)d_ws;
#if MK_PER_PHASE
    for (int p = 0; p < NPH; ++p) { a.ph_lo = p; a.ph_hi = p + 1; hipLaunchKernelGGL(fwd, dim3(grid), dim3(NTHR), LDS_BYTES, stream, a); }
#else
    a.ph_lo = 0; a.ph_hi = NPH; hipLaunchKernelGGL(fwd, dim3(grid), dim3(NTHR), LDS_BYTES, stream, a);
#endif
    const hipError_t le = hipPeekAtLastError();
    if (le != hipSuccess) fprintf(stderr, "kernel_launch: launch failed: %s\n", hipGetErrorName(le));
}
```

```cpp
#include <hip/hip_runtime.h>
#include <cstdio>
#include <cstdint>

#ifndef MK_PER_PHASE
#define MK_PER_PHASE 0
#endif

#define LAS __attribute__((address_space(3)))
#define GAS __attribute__((address_space(1)))
typedef unsigned short bf16;
typedef short bf16x8 __attribute__((ext_vector_type(8)));
typedef float f32x4 __attribute__((ext_vector_type(4)));
typedef float f32x2 __attribute__((ext_vector_type(2)));
typedef unsigned u32x4 __attribute__((ext_vector_type(4)));
typedef unsigned u32x2 __attribute__((ext_vector_type(2)));

constexpr int D = 1024, NB = 16, SEQ = 2048, CTXL = 256, DEPTH = 2;
constexpr int NLAT = NB * SEQ, NCTX = NB * CTXL, NROW = NLAT + NCTX;
constexpr int INW = 5632, NE = 16, DE = 2048, CAPL = 256, CAPC = 32, NMOD = 6;
constexpr float EPS = 1e-6f;
constexpr int NWAVES = 8, NTHR = 512;

constexpr size_t MiB = 1u << 20;
constexpr size_t WS_CTL = 0, CTL_ZERO_BYTES = 64 * 1024;
constexpr size_t WS_MOD = 1 * MiB;
constexpr size_t WS_COS = 2 * MiB;
constexpr size_t WS_SIN = 2 * MiB + 16384;
constexpr size_t WS_ROWIDX = 3 * MiB;
constexpr size_t WS_GVAL = 4 * MiB;
constexpr size_t WS_SLOT = 5 * MiB;
constexpr size_t WS_AFF = 8 * MiB;
constexpr size_t WS_WIN8 = 12 * MiB;
constexpr size_t WS_WIN = 16 * MiB;
constexpr size_t WS_WA = 27 * MiB, WS_WR = 29 * MiB, WS_WO = 31 * MiB;
__host__ __device__ constexpr size_t ws_wgu(int l) { return (33 + 64 * l) * MiB; }
__host__ __device__ constexpr size_t ws_wdn(int l) { return (161 + 32 * l) * MiB; }
constexpr size_t WS_LW = 225 * MiB;
constexpr size_t WS_X = 226 * MiB;
constexpr size_t WS_H8 = 298 * MiB;
constexpr size_t WS_H = 370 * MiB;
constexpr size_t WS_Q = 442 * MiB;
constexpr size_t WS_U = 514 * MiB;
constexpr size_t WS_T1 = 442 * MiB;
constexpr size_t WS_K = 586 * MiB;
constexpr size_t WS_VT = 604 * MiB;
constexpr size_t WS_GZ = 622 * MiB;
constexpr size_t WS_SMA = 694 * MiB, WS_SMR = 766 * MiB, WS_REC = 838 * MiB;
constexpr size_t WS_HID = 442 * MiB;
constexpr size_t WS_YE = 730 * MiB;
constexpr size_t WS_END = 910 * MiB;

constexpr int LDS_BYTES = 147456;
constexpr int RING_BYTES = 131072;
constexpr int MISC_OFF = LDS_BYTES - 16;

__device__ __forceinline__ unsigned f2bf(float f) { unsigned u = __builtin_bit_cast(unsigned, f); return (u + 0x7fffu + ((u >> 16) & 1u)) >> 16; }
__device__ __forceinline__ unsigned pk2(float lo, float hi) { unsigned r; asm volatile("v_cvt_pk_bf16_f32 %0, %1, %2" : "=v"(r) : "v"(lo), "v"(hi)); return r; }
__device__ __forceinline__ float bf_lo(unsigned w) { return __builtin_bit_cast(float, w << 16); }
__device__ __forceinline__ float bf_hi(unsigned w) { return __builtin_bit_cast(float, w & 0xffff0000u); }
__device__ __forceinline__ float bf2f(bf16 b) { return __builtin_bit_cast(float, ((unsigned)b) << 16); }
__device__ __forceinline__ u32x2 pk4(f32x4 v) { u32x2 w; w.x = pk2(v[0], v[1]); w.y = pk2(v[2], v[3]); return w; }
__device__ __forceinline__ f32x4 unpk4(u32x2 w) { return (f32x4){bf_lo(w.x), bf_hi(w.x), bf_lo(w.y), bf_hi(w.y)}; }
__device__ __forceinline__ unsigned f8x4(f32x4 v) { int w = 0; w = __builtin_amdgcn_cvt_pk_fp8_f32(v[0], v[1], w, false); w = __builtin_amdgcn_cvt_pk_fp8_f32(v[2], v[3], w, true); return (unsigned)w; }
__device__ __forceinline__ float wave_sum(float v) {
#pragma unroll
    for (int o = 1; o < 64; o <<= 1) v += __shfl_xor(v, o);
    return v;
}
__device__ __forceinline__ float wave_max(float v) {
#pragma unroll
    for (int o = 1; o < 64; o <<= 1) v = fmaxf(v, __shfl_xor(v, o));
    return v;
}
__device__ __forceinline__ float bsel(unsigned m, float a0, float a1) { return __builtin_bit_cast(float, (__builtin_bit_cast(unsigned, a1) & m) | (__builtin_bit_cast(unsigned, a0) & ~m)); }
__device__ __forceinline__ float sigmoidf_(float x) { return __builtin_amdgcn_rcpf(1.0f + __expf(-x)); }
__device__ __forceinline__ f32x2 sigmoid2(f32x2 x) { const f32x2 t = x * (-1.4426950408889634f); const f32x2 e = (f32x2){__builtin_amdgcn_exp2f(t.x), __builtin_amdgcn_exp2f(t.y)} + 1.0f; return (f32x2){__builtin_amdgcn_rcpf(e.x), __builtin_amdgcn_rcpf(e.y)}; }
__device__ __forceinline__ f32x2 gelu2(f32x2 z) { const f32x2 y = (z * z * 0.044715f + 1.0f) * z * (-1.5957691216057308f * 1.4426950408889634f); const f32x2 e = (f32x2){__builtin_amdgcn_exp2f(y.x), __builtin_amdgcn_exp2f(y.y)} + 1.0f; return z * (f32x2){__builtin_amdgcn_rcpf(e.x), __builtin_amdgcn_rcpf(e.y)}; }
__device__ __forceinline__ float gelu_tanh(float z) { const float y = 1.5957691216057308f * (z + 0.044715f * z * z * z); return z * __builtin_amdgcn_rcpf(1.0f + __expf(-y)); }

#define XB_TMO      128
#define XB_XCNT(j)  (256  + 64 * (j))
#define XB_XSUB(j)  (1280 + 64 * (j))
#define XB_XGEN(j)  (2304 + 64 * (j))
#define XB_TOP      3328
#define XB_TOPGEN   3392
#define XCD_BAR_WORDS 3456
#define XB_SPIN_CAP (1u << 18)
__device__ __forceinline__ unsigned xb_ld(unsigned* p)              { return __hip_atomic_load(p, __ATOMIC_RELAXED, __HIP_MEMORY_SCOPE_AGENT); }
__device__ __forceinline__ unsigned xb_add(unsigned* p, unsigned v) { return __hip_atomic_fetch_add(p, v, __ATOMIC_RELAXED, __HIP_MEMORY_SCOPE_AGENT); }
__device__ __forceinline__ unsigned xb_xcc_id() { return (unsigned)__builtin_amdgcn_s_getreg((3 << 11) | 20) & 0xFu; }
#define XB_SPIN(cond, bar) do { unsigned _sp = 0; while (cond) { __builtin_amdgcn_s_sleep(1); \
    if ((++_sp & 255u) == 0u) { if (xb_ld(&(bar)[XB_TMO])) break; if (_sp > XB_SPIN_CAP) { atomicAdd(&(bar)[XB_TMO], 1u); break; } } } } while (0)
struct XcdBarrier { unsigned* bar; unsigned x; volatile LAS unsigned* st; };
__device__ __forceinline__ XcdBarrier xcd_barrier_post(unsigned* bar, volatile LAS unsigned* st) {
    XcdBarrier b; b.bar = bar; b.x = xb_xcc_id(); b.st = st;
    if (threadIdx.x == 0) (void)xb_add(&bar[XB_XCNT(b.x)], 1u);
    return b;
}
__device__ __forceinline__ void xcd_barrier_complete(unsigned* bar, unsigned x, unsigned& nloc, unsigned& nx) {
    const unsigned G = gridDim.x * gridDim.y * gridDim.z;
    unsigned sum, cnt, mine, sp = 0u;
    for (;;) {
        sum = 0u; cnt = 0u; mine = 0u;
#pragma unroll
        for (unsigned j = 0; j < 16; ++j) { const unsigned c = xb_ld(&bar[XB_XCNT(j)]); sum += c; cnt += (c > 0u) ? 1u : 0u; mine = (j == x) ? c : mine; }
        if (sum == G) break;
        __builtin_amdgcn_s_sleep(1);
        if ((++sp & 255u) == 0u) { if (xb_ld(&bar[XB_TMO])) break; if (sp > XB_SPIN_CAP) { atomicAdd(&bar[XB_TMO], 1u); break; } }
    }
    nloc = mine > 0u ? mine : 1u; nx = cnt > 0u ? cnt : 1u;
}
__device__ __forceinline__ void xcd_barrier(const XcdBarrier& b) {
    asm volatile("s_waitcnt vmcnt(0)" ::: "memory");
    __syncthreads();
    if (threadIdx.x == 0) {
        unsigned* bar = b.bar;
        __builtin_amdgcn_s_waitcnt(0);
        unsigned nloc = b.st[0], nx = b.st[1];
        if (nloc == 0u) { xcd_barrier_complete(bar, b.x, nloc, nx); b.st[0] = nloc; b.st[1] = nx; }
        const unsigned old = xb_add(&bar[XB_XSUB(b.x)], 1u);
        const unsigned gen = old / nloc;
        if (old + 1u == (gen + 1u) * nloc) {
            __builtin_amdgcn_fence(__ATOMIC_RELEASE, "agent");
            asm volatile("s_waitcnt vmcnt(0)" ::: "memory");
            const unsigned og = xb_add(&bar[XB_TOP], 1u);
            const unsigned tg = og / nx;
            if (og + 1u == (tg + 1u) * nx) xb_add(&bar[XB_TOPGEN], 1u);
            else XB_SPIN(xb_ld(&bar[XB_TOPGEN]) == tg, bar);
            __builtin_amdgcn_fence(__ATOMIC_ACQUIRE, "agent");
            xb_add(&bar[XB_XGEN(b.x)], 1u);
            asm volatile("s_waitcnt vmcnt(0)" ::: "memory");
        } else {
            XB_SPIN(xb_ld(&bar[XB_XGEN(b.x)]) == gen, bar);
            __builtin_amdgcn_fence(__ATOMIC_ACQUIRE, "agent");
            asm volatile("s_waitcnt vmcnt(0)" ::: "memory");
        }
    }
    __syncthreads();
}

namespace pg8 {
constexpr int BM = 256, BK = 64, HALF = 128, HTB = HALF * BK * 2, STAGE_BYTES = 8 * HTB, NXCD = 8, WGM = 8;
__host__ __device__ __forceinline__ int lds_byte(int r, int c) { const int st = (r >> 4) * 2 + (c >> 5), rr = r & 15, cc = c & 31, ob = rr * 64 + cc * 2; return st * 1024 + (ob ^ (((ob >> 9) & 1) << 5)); }
__host__ __device__ __forceinline__ void stage_rc(int b, int& R, int& C) { const int st = b / 1024, sb = b % 1024, swz = sb ^ (((sb >> 9) & 1) << 5); R = (st >> 1) * 16 + swz / 64; C = (st & 1) * 32 + (swz % 64) / 2; }
struct Unit { int pm, pn, e; };
typedef int v8i __attribute__((ext_vector_type(8)));
typedef int v4i __attribute__((ext_vector_type(4)));
#define HF_XSUB(j) (64 * (j))
#define HF_TOP     1024
__device__ __forceinline__ void handoff_signal(const XcdBarrier& b, unsigned* hw) {
    asm volatile("s_waitcnt vmcnt(0)" ::: "memory");
    __syncthreads();
    if (threadIdx.x == 0) {
        const unsigned nloc = b.st[0];
        const unsigned old = xb_add(&hw[HF_XSUB(b.x)], 1u);
        if (old + 1u == nloc) { __builtin_amdgcn_fence(__ATOMIC_RELEASE, "agent"); asm volatile("s_waitcnt vmcnt(0)" ::: "memory"); (void)xb_add(&hw[HF_TOP], 1u); }
    }
}
__device__ __forceinline__ void handoff_wait(const XcdBarrier& b, unsigned* hw) {
    if (threadIdx.x == 0) {
        const unsigned nx = b.st[1]; unsigned* bar = b.bar;
        XB_SPIN(xb_ld(&hw[HF_TOP]) < nx, bar);
        __builtin_amdgcn_fence(__ATOMIC_ACQUIRE, "agent");
        asm volatile("s_waitcnt vmcnt(0)" ::: "memory");
    }
    __syncthreads();
}
__device__ __forceinline__ void glds16_s(const char* gbase, unsigned voff, unsigned lds_dst) {
    unsigned keep;
    asm volatile("s_mov_b32 %0, m0\n\ts_mov_b32 m0, %3\n\ts_nop 0\n\tglobal_load_lds_dwordx4 %1, %2\n\ts_mov_b32 m0, %0" : "=&s"(keep) : "v"(voff), "s"(gbase), "s"(lds_dst) : "memory");
}
__device__ __forceinline__ void glds4_s(const void* gbase, unsigned voff, unsigned lds_dst) {
    unsigned keep;
    asm volatile("s_mov_b32 %0, m0\n\ts_mov_b32 m0, %3\n\ts_nop 0\n\tglobal_load_lds_dword %1, %2\n\ts_mov_b32 m0, %0" : "=&s"(keep) : "v"(voff), "s"(gbase), "s"(lds_dst) : "memory");
}
__device__ __forceinline__ v8i cat8(bf16x8 a, bf16x8 b) { const u32x4 x = __builtin_bit_cast(u32x4, a), y = __builtin_bit_cast(u32x4, b); return (v8i){(int)x.x, (int)x.y, (int)x.z, (int)x.w, (int)y.x, (int)y.y, (int)y.z, (int)y.w}; }
__device__ __forceinline__ void static_map(int L, int nM, int nN, int& pm, int& pn) {
    const int nwg = nM * nN; int wgid = L;
    { const int q = nwg / NXCD, r = nwg % NXCD, xcd = wgid % NXCD, off = wgid / NXCD; wgid = (xcd < r ? xcd * (q + 1) : r * (q + 1) + (xcd - r) * q) + off; }
    const int nig = WGM * nN, gid = wgid / nig, fm = gid * WGM, gsz = (nM - fm) < WGM ? (nM - fm) : WGM;
    pm = fm + ((wgid % nig) % gsz); pn = (wgid % nig) / gsz;
}
template <class Prob, bool ALIGN_EPI>
__device__ __forceinline__ void gemm_phase(LAS unsigned char* lds, const Prob& P) {
    constexpr int KB = Prob::KB, nt = KB / (BK * 2);
    int tid_ = threadIdx.x; asm volatile("" : "+v"(tid_));
    const int tid = tid_, wid = __builtin_amdgcn_readfirstlane(tid >> 6), lane = tid & 63, wr = wid >> 2, wc = wid & 3, fr = lane & 15, fq = lane >> 4;
    unsigned voffA[2];
#pragma unroll
    for (int i = 0; i < 2; ++i) { int R, C; stage_rc(tid * 16 + i * 8192, R, C); voffA[i] = (unsigned)(R * KB + C * 2); }
    unsigned gcur[2][2];
#define PG8_GLOAD(dst, u_) do { if constexpr (Prob::GATHER) { const int* ri_ = P.rowidx(u_); _Pragma("unroll") for (int h_ = 0; h_ < 2; ++h_) _Pragma("unroll") for (int i_ = 0; i_ < 2; ++i_) { int R_, C_; stage_rc(tid * 16 + i_ * 8192, R_, C_); \
        dst[h_][i_] = (unsigned)ri_[h_ * HALF + R_] * (unsigned)KB + (unsigned)(C_ * 2); } } } while (0)
    const size_t kstep = (size_t)(BK * 2);
    const size_t hstep = (size_t)HALF * KB;
    const unsigned gmail = (unsigned)(unsigned long long)lds + (unsigned)STAGE_BYTES + (unsigned)wid * 1024u;
    const unsigned ldsb = (unsigned)(unsigned long long)lds + (unsigned)wid * 1024u;
    const int aoff = lds_byte(wr * 64 + fr, fq * 8), boff = lds_byte(wc * 32 + fr, fq * 8);
#define PG8_SA(b, h) (((b) * 2 + (h)) * HTB)
#define PG8_SB(b, h) ((4 + (b) * 2 + (h)) * HTB)
#define PG8_STAGE(bufoff, gbase, voff) do { _Pragma("unroll") for (int _i = 0; _i < 2; ++_i) glds16_s((gbase), (voff)[_i], ldsb + (unsigned)((bufoff) + _i * 8192)); } while (0)
#define PG8_STAGE_A(bufoff, kbase_, h_, nx_) do { if constexpr (Prob::GATHER) { _Pragma("unroll") for (int _i = 0; _i < 2; ++_i) glds16_s((kbase_), gcur[h_][_i], ldsb + (unsigned)((bufoff) + _i * 8192)); } \
        else PG8_STAGE(bufoff, (kbase_) + (h_) * hstep, voffA); } while (0)
#define PG8_LD8(p_) __builtin_shufflevector(*(const LAS v4i*)(p_), *(const LAS v4i*)((p_) + 1024), 0, 1, 2, 3, 4, 5, 6, 7)
#define PG8_LDA(dst, b, h) do { _Pragma("unroll") for (int m = 0; m < 4; ++m) dst[m] = PG8_LD8(lds + PG8_SA(b, h) + aoff + m * 2048); } while (0)
#define PG8_LDB(dst, b, h) do { _Pragma("unroll") for (int n = 0; n < 2; ++n) dst[n] = PG8_LD8(lds + PG8_SB(b, h) + boff + n * 2048); } while (0)
#define PG8_LO(v_) __builtin_bit_cast(bf16x8, __builtin_shufflevector(v_, v_, 0, 1, 2, 3))
#define PG8_HI(v_) __builtin_bit_cast(bf16x8, __builtin_shufflevector(v_, v_, 4, 5, 6, 7))
#define PG8_MMA(ai, bj, At, Bt) do { __builtin_amdgcn_s_setprio(1); _Pragma("unroll") for (int m = 0; m < 4; ++m) _Pragma("unroll") for (int n = 0; n < 2; ++n) { \
        if constexpr (Prob::FP8) { acc[ai][bj][m][n] = __builtin_amdgcn_mfma_scale_f32_16x16x128_f8f6f4(Bt[n], At[m], acc[ai][bj][m][n], 0, 0, 0, 0x7F7F7F7F, 0, 0x7F7F7F7F); } \
        else { acc[ai][bj][m][n] = __builtin_amdgcn_mfma_f32_16x16x32_bf16(PG8_LO(Bt[n]), PG8_LO(At[m]), acc[ai][bj][m][n], 0, 0, 0); \
               acc[ai][bj][m][n] = __builtin_amdgcn_mfma_f32_16x16x32_bf16(PG8_HI(Bt[n]), PG8_HI(At[m]), acc[ai][bj][m][n], 0, 0, 0); } } __builtin_amdgcn_s_setprio(0); } while (0)
#define PG8_WAIT_V(n) asm volatile("s_waitcnt vmcnt(" #n ")" ::: "memory")
#define PG8_WAIT_L(n) asm volatile("s_waitcnt lgkmcnt(" #n ")" ::: "memory")
#define PG8_BAR __builtin_amdgcn_s_barrier()
#define PG8_SCHED __builtin_amdgcn_sched_barrier(0)
    Unit cur, nxt; int ui = 0;
    if (!P.next(0, cur)) return;
    f32x4 acc[2][2][4][2];
#pragma unroll
    for (int a = 0; a < 2; ++a)
#pragma unroll
        for (int b = 0; b < 2; ++b)
#pragma unroll
            for (int m = 0; m < 4; ++m)
#pragma unroll
                for (int n = 0; n < 2; ++n) acc[a][b][m][n] = (f32x4){0.f, 0.f, 0.f, 0.f};
    v8i At[4], B0[2], B1[2];
    const char* cA = P.aptr(cur); const char* cB = P.bptr(cur);
    PG8_GLOAD(gcur, cur);
    PG8_STAGE(PG8_SB(0, 0), cB, voffA); PG8_STAGE(PG8_SB(0, 1), cB + hstep, voffA); PG8_STAGE_A(PG8_SA(0, 0), cA, 0, false); PG8_STAGE_A(PG8_SA(0, 1), cA, 1, false);
    if (wr == 1) PG8_BAR;
    PG8_WAIT_V(2); PG8_BAR;
    PG8_STAGE(PG8_SB(1, 0), cB + kstep, voffA); PG8_STAGE_A(PG8_SA(1, 0), cA + kstep, 0, false); PG8_STAGE(PG8_SB(1, 1), cB + hstep + kstep, voffA);
    PG8_WAIT_V(6); PG8_BAR;
    for (;;) {
        const bool has_next = P.next(ui + 1, nxt);
        const char* nA = has_next ? P.aptr(nxt) : cA; const char* nB = has_next ? P.bptr(nxt) : cB;
        if constexpr (Prob::GATHER) { if (has_next) {
            const int* ri_ = P.rowidx(nxt);
#pragma unroll
            for (int h_ = 0; h_ < 2; ++h_)
#pragma unroll
                for (int i_ = 0; i_ < 2; ++i_) { int R_, C_; stage_rc(tid * 16 + i_ * 8192, R_, C_); glds4_s(ri_, (unsigned)((h_ * HALF + R_) * 4), gmail + (unsigned)((2 * h_ + i_) * 256)); } } }
#pragma nounroll
        for (int t = 0; t < nt; t += 2) {
            const bool last = (t == nt - 2);
            const char* a1 = cA + (size_t)(t + 1) * kstep;
            const char* a2 = last ? nA : cA + (size_t)(t + 2) * kstep; const char* b2 = last ? nB : cB + (size_t)(t + 2) * kstep;
            const char* a3 = a2 + kstep; const char* b3 = b2 + kstep;
            const bool nx = last && has_next;
            PG8_LDB(B0, 0, 0); PG8_LDB(B1, 0, 1); PG8_SCHED; PG8_LDA(At, 0, 0); PG8_STAGE_A(PG8_SA(1, 1), a1, 1, false);
            if constexpr (Prob::GATHER) { if (nx) {
#pragma unroll
                for (int h_ = 0; h_ < 2; ++h_)
#pragma unroll
                    for (int i_ = 0; i_ < 2; ++i_) { int R_, C_; stage_rc(tid * 16 + i_ * 8192, R_, C_);
                        gcur[h_][i_] = *(volatile LAS unsigned*)(lds + STAGE_BYTES + wid * 1024 + (2 * h_ + i_) * 256 + lane * 4) * (unsigned)KB + (unsigned)(C_ * 2); } } }
            PG8_WAIT_V(8); PG8_WAIT_L(0); PG8_BAR; PG8_MMA(0, 0, At, B0); PG8_MMA(0, 1, At, B1); PG8_BAR; PG8_SCHED;
            PG8_LDA(At, 0, 1); PG8_STAGE(PG8_SB(0, 0), b2, voffA); PG8_STAGE(PG8_SB(0, 1), b2 + hstep, voffA); PG8_STAGE_A(PG8_SA(0, 0), a2, 0, nx);
            PG8_WAIT_V(8); PG8_WAIT_L(0); PG8_BAR; PG8_MMA(1, 0, At, B0); PG8_MMA(1, 1, At, B1); PG8_BAR; PG8_SCHED;
            PG8_LDB(B0, 1, 0); PG8_LDB(B1, 1, 1); PG8_SCHED; PG8_LDA(At, 1, 0); PG8_STAGE_A(PG8_SA(0, 1), a2, 1, nx);
            PG8_WAIT_V(8); PG8_WAIT_L(0); PG8_BAR; PG8_MMA(0, 0, At, B0); PG8_MMA(0, 1, At, B1); PG8_BAR; PG8_SCHED;
            PG8_LDA(At, 1, 1); PG8_STAGE(PG8_SB(1, 0), b3, voffA); PG8_STAGE(PG8_SB(1, 1), b3 + hstep, voffA); PG8_STAGE_A(PG8_SA(1, 0), a3, 0, nx);
            PG8_WAIT_V(8); PG8_WAIT_L(0); PG8_BAR; PG8_MMA(1, 0, At, B0); PG8_MMA(1, 1, At, B1); PG8_BAR; PG8_SCHED;
        }
        if constexpr (ALIGN_EPI) { if (wr == 0) PG8_BAR; }
        bool keep = false;
        { int fr_ = fr, fq_ = fq; asm volatile("" : "+v"(fr_), "+v"(fq_));
          if constexpr (Prob::FUSED2) keep = P.epi2(acc, cur, wr, wc, fr_, fq_); else P.epi(acc, cur, wr, wc, fr_, fq_); }
        if (!has_next) break;
        if (!keep) {
#pragma unroll
        for (int a = 0; a < 2; ++a)
#pragma unroll
            for (int b = 0; b < 2; ++b)
#pragma unroll
                for (int m = 0; m < 4; ++m)
#pragma unroll
                    for (int n = 0; n < 2; ++n) acc[a][b][m][n] = (f32x4){0.f, 0.f, 0.f, 0.f};
        }
        cur = nxt; cA = nA; cB = nB; ++ui;
        if constexpr (ALIGN_EPI) { if (wr == 1) PG8_BAR; }
    }
    PG8_WAIT_V(0);
    if constexpr (!ALIGN_EPI) { if (wr == 0) PG8_BAR; }
    PG8_BAR;
#undef PG8_SA
#undef PG8_SB
#undef PG8_STAGE
#undef PG8_STAGE_A
#undef PG8_GLOAD
#undef PG8_LDA
#undef PG8_LDB
#undef PG8_LD8
#undef PG8_LO
#undef PG8_HI
#undef PG8_MMA
#undef PG8_WAIT_V
#undef PG8_WAIT_L
#undef PG8_BAR
#undef PG8_SCHED
}
}
using pg8::Unit;

struct Args { const float* in[25]; float* out; unsigned char* ws; int ph_lo, ph_hi; };
struct Ctx {
    const float* const* in; float* out; unsigned char* ws;
    LAS unsigned char* lds; int tid, lane, wave, G, bid;
};
__device__ __forceinline__ Ctx fresh(const Ctx& c0) {
    Ctx c = c0; int t = threadIdx.x; asm volatile("" : "+v"(t)); c.tid = t; c.lane = t & 63; c.wave = __builtin_amdgcn_readfirstlane(t >> 6); return c;
}
enum { I_X = 0, I_C, I_CTX, I_CCTX, I_ADAW, I_ADAB, I_NMG, I_WIN, I_SINK, I_CONVW, I_CONVB, I_LWA, I_LBA, I_LWX, I_LBX, I_LAM, I_WABR, I_WRBR, I_WOUT, I_NFG, I_WROUTER, I_WGATE, I_WUP, I_WDOWN, I_FNG };

#define EPI_LOOP_ROWS _Pragma("unroll") for (int ai = 0; ai < 2; ++ai) _Pragma("unroll") for (int m = 0; m < 4; ++m)

__host__ __device__ __forceinline__ int ropedim(int s) { const int wc = s >> 5, n = (s >> 4) & 1, fq = (s >> 2) & 3, i = s & 3, p = 16 * wc + 4 * fq + i; return 64 * (p >> 5) + (p & 31) + 32 * n; }

#define FENCE() asm volatile("" ::: "memory")
constexpr float W8_SCALE = 64.0f, W8_INV = 1.0f / 64.0f, YE_SCALE = 16.0f, YE_INV = 1.0f / 16.0f;
struct ProbIn {
    static constexpr int K = 1024, KB = 2048; static constexpr bool FP8 = false, GATHER = false, FUSED2 = false;
    unsigned char* ws; int G, c, nM, nLat, nCtx;
    __device__ __forceinline__ bool next(int i, Unit& u) const {
        long L = (long)i * G + c; u.e = 0;
        if (L < nLat) { int pm, pn; pg8::static_map((int)L, nM, 13, pm, pn); u.pm = pm; u.pn = pn < 5 ? pn : pn + 1; return true; }
        L -= nLat; if (L >= nCtx) return false;
        u.pm = 128 + (int)(L % 16); const int idx = (int)(L / 16); u.pn = idx == 0 ? 4 : 5 + idx; return true;
    }
    __device__ __forceinline__ const char* aptr(const Unit& u) const { return (const char*)(ws + WS_H) + (size_t)u.pm * 256 * K * 2; }
    __device__ __forceinline__ const char* bptr(const Unit& u) const { return (const char*)(ws + WS_WIN) + (size_t)u.pn * 256 * K * 2; }
    __device__ __forceinline__ void epi(const f32x4 (&acc)[2][2][4][2], const Unit& u, int wr, int wc, int fr, int fq) const {
        const int pn = u.pn; const int row0 = u.pm * 256 + wr * 64 + fr, lc = wc * 32 + 4 * fq;
        if (pn <= 4) {
            bf16* base = (bf16*)(ws + (pn < 4 ? WS_Q : WS_K)); const int ldc = pn < 4 ? 1024 : 256, cb = (pn < 4 ? pn * 256 : 0) + lc;
            const bool lat = u.pm < 128; const int i0 = 16 * (wc & 1) + 4 * fq;
            const float* COS = (const float*)(ws + WS_COS); const float* SIN = (const float*)(ws + WS_SIN);
            EPI_LOOP_ROWS {
                const int row = row0 + ai * 128 + m * 16;
                f32x4 cs = (f32x4){1.f, 1.f, 1.f, 1.f}, sn = (f32x4){0.f, 0.f, 0.f, 0.f};
                if (lat) { const int t = row & 2047, pos = wc < 2 ? (t >> 6) : (t & 63); cs = *(const f32x4*)(COS + pos * 32 + i0); sn = *(const f32x4*)(SIN + pos * 32 + i0); }
#pragma unroll
                for (int bj = 0; bj < 2; ++bj) {
                    const f32x4 x1 = acc[ai][bj][m][0], x2 = acc[ai][bj][m][1];
                    const f32x4 o1 = x1 * cs - x2 * sn, o2 = x1 * sn + x2 * cs;
                    bf16* p = base + (size_t)row * ldc + cb + bj * 128;
                    *(u32x2*)p = pk4(o1); *(u32x2*)(p + 16) = pk4(o2);
                }
                FENCE();
            }
        } else {
            size_t off; int cb; int mode;
            if (pn <= 9) { off = WS_U; cb = (pn - 6) * 256; mode = 0; }
            else { off = WS_GZ; cb = (pn - 10) * 256; mode = 1; }
            bf16* base = (bf16*)(ws + off);
            cb += wc * 64 + 16 * fq;
            EPI_LOOP_ROWS {
                const int row = row0 + ai * 128 + m * 16;
#pragma unroll
                for (int bj = 0; bj < 2; ++bj) { f32x4 v0 = acc[ai][bj][m][0], v1 = acc[ai][bj][m][1];
                    if (mode == 1) { const f32x2 a = gelu2((f32x2){v0[0], v0[1]}), b = gelu2((f32x2){v0[2], v0[3]}), c2 = gelu2((f32x2){v1[0], v1[1]}), d = gelu2((f32x2){v1[2], v1[3]}); v0 = (f32x4){a.x, a.y, b.x, b.y}; v1 = (f32x4){c2.x, c2.y, d.x, d.y}; }
                    const u32x2 a = pk4(v0), b = pk4(v1);
                    *(u32x4*)(base + (size_t)row * 1024 + cb + bj * 8) = (u32x4){a.x, a.y, b.x, b.y}; }
                FENCE();
            }
        }
    }
};
struct ProbIn8 {
    static constexpr int KB = 1024; static constexpr bool FP8 = true, GATHER = false, FUSED2 = false;
    unsigned char* ws; int G, c, nM; bool bal;
    __device__ __forceinline__ bool next(int i, Unit& u) const { long L = (long)i * G + c;
        if (bal) { if (i >= 3) { if (c < 96 || i > 4 || (i == 4 && c >= 192)) return false; L = (i == 3 ? 768 : 928) + (c - 96); } }
        if (L >= nM * 8) return false; int pm, pn; pg8::static_map((int)L, nM, 8, pm, pn); u.pm = pm; u.pn = pn; u.e = 0; return true; }
    __device__ __forceinline__ const char* aptr(const Unit& u) const { return (const char*)(ws + WS_H8) + (size_t)u.pm * 256 * KB; }
    __device__ __forceinline__ const char* bptr(const Unit& u) const { return (const char*)(ws + WS_WIN8) + (size_t)u.pn * 256 * KB; }
    __device__ __forceinline__ void epi(const f32x4 (&acc)[2][2][4][2], const Unit& u, int wr, int wc, int fr, int fq) const {
        const int row0 = u.pm * 256 + wr * 64 + fr; const int cb = (u.pn & 3) * 256 + wc * 64 + 16 * fq;
        bf16* base = (bf16*)(ws + (u.pn < 4 ? WS_SMA : WS_SMR));
        EPI_LOOP_ROWS {
            const int row = row0 + ai * 128 + m * 16;
#pragma unroll
            for (int bj = 0; bj < 2; ++bj) { const f32x4 v0 = acc[ai][bj][m][0] * W8_INV, v1 = acc[ai][bj][m][1] * W8_INV;
                const f32x2 a = sigmoid2((f32x2){v0[0], v0[1]}), b = sigmoid2((f32x2){v0[2], v0[3]}), c2 = sigmoid2((f32x2){v1[0], v1[1]}), d = sigmoid2((f32x2){v1[2], v1[3]});
                const u32x2 p = pk4((f32x4){a.x, a.y, b.x, b.y}), q = pk4((f32x4){c2.x, c2.y, d.x, d.y});
                *(u32x4*)(base + (size_t)row * 1024 + cb + bj * 8) = (u32x4){p.x, p.y, q.x, q.y}; }
            FENCE();
        }
    }
};
struct ProbVt {
    static constexpr int K = 1024, KB = 2048; static constexpr bool FP8 = false, GATHER = false, FUSED2 = false;
    unsigned char* ws; int G, c; bool bal;
    __device__ __forceinline__ bool next(int i, Unit& u) const { int L = i * G + (G - 1 - c); if (bal) L = i > 0 ? 144 : (c >= 208 ? c - 208 : (c < 96 ? 48 + c : 144)); if (L >= 144) return false; u.pm = 0; u.pn = L; u.e = 0; return true; }
    __device__ __forceinline__ const char* aptr(const Unit&) const { return (const char*)(ws + WS_WIN) + (size_t)1280 * 1024 * 2; }
    __device__ __forceinline__ const char* bptr(const Unit& u) const { return (const char*)(ws + WS_H) + (size_t)u.pn * 256 * K * 2; }
    __device__ __forceinline__ void epi(const f32x4 (&acc)[2][2][4][2], const Unit& u, int wr, int wc, int fr, int fq) const {
        const int row0 = wr * 64 + fr, cb = u.pn * 256 + wc * 32 + 4 * fq; bf16* Vt = (bf16*)(ws + WS_VT);
        EPI_LOOP_ROWS { const int row = row0 + ai * 128 + m * 16;
#pragma unroll
            for (int bj = 0; bj < 2; ++bj)
#pragma unroll
                for (int n = 0; n < 2; ++n) *(u32x2*)(Vt + (size_t)row * NROW + cb + bj * 128 + n * 16) = pk4(acc[ai][bj][m][n]); }
    }
};
template <int MODE> struct ProbMerge {
    static constexpr int K = 1024, KB = 2048; static constexpr bool FP8 = false, GATHER = false, FUSED2 = false;
    unsigned char* ws; int G, c, nM, l; const float* xin; const float* cin;
    int ubeg, ustride, ucnt;
    __device__ __forceinline__ bool next(int i, Unit& u) const { if (i >= ucnt) return false; const int L = ubeg + i * ustride; if (L >= nM * 4) return false;
        int pm, pn; if (L < 512) pg8::static_map(L, 128, 4, pm, pn); else { pm = 128 + ((L - 512) & 15); pn = (L - 512) >> 4; } u.pm = pm; u.pn = pn; u.e = 0; return true; }
    __device__ __forceinline__ const char* aptr(const Unit& u) const { return (const char*)(ws + (MODE == 0 ? WS_H : MODE == 1 ? WS_REC : WS_GZ)) + (size_t)u.pm * 256 * K * 2; }
    __device__ __forceinline__ const char* bptr(const Unit& u) const { return (const char*)(ws + (MODE == 0 ? WS_WA : MODE == 1 ? WS_WR : WS_WO)) + (size_t)u.pn * 256 * K * 2; }
    __device__ __forceinline__ void epi(const f32x4 (&acc)[2][2][4][2], const Unit& u, int wr, int wc, int fr, int fq) const {
        const int row0 = u.pm * 256 + wr * 64 + fr, cb = u.pn * 256 + wc * 64 + 16 * fq;
        const int r = u.pm < 128 ? (u.pm >> 3) : 16;
        const bf16* S = (const bf16*)(ws + (MODE == 0 ? WS_SMA : WS_SMR)); bf16* T1 = (bf16*)(ws + WS_T1); bf16* MRG = (bf16*)(ws + WS_GZ); bf16* X = (bf16*)(ws + WS_X);
        const float* gate = (const float*)(ws + WS_MOD) + (size_t)(l * 17 + r) * 6144 + 2048;
        const float* RB = (u.pm < 128 ? xin : cin - (size_t)NLAT * D);
        u32x4 svn[2], tvn[2]; f32x4 rbn[2][2];
#define MG_LOAD(g_) do { const int row_ = row0 + ((g_) >> 2) * 128 + ((g_) & 3) * 16; _Pragma("unroll") for (int bj_ = 0; bj_ < 2; ++bj_) { const size_t o_ = (size_t)row_ * 1024 + cb + bj_ * 8; \
            if (MODE != 2) svn[bj_] = *(const u32x4*)(S + o_); if (MODE == 1) tvn[bj_] = *(const u32x4*)(T1 + o_); \
            if (MODE == 2) { if (l == 0) { rbn[bj_][0] = *(const f32x4*)(RB + o_); rbn[bj_][1] = *(const f32x4*)(RB + o_ + 4); } \
                             else { const u32x4 xb_ = *(const u32x4*)(X + o_); rbn[bj_][0] = unpk4((u32x2){xb_.x, xb_.y}); rbn[bj_][1] = unpk4((u32x2){xb_.z, xb_.w}); } } } } while (0)
        f32x4 gt[2][2];
        if (MODE == 2) {
#pragma unroll
            for (int bj = 0; bj < 2; ++bj) { gt[bj][0] = *(const f32x4*)(gate + cb + bj * 8); gt[bj][1] = *(const f32x4*)(gate + cb + bj * 8 + 4); } }
        MG_LOAD(0);
#pragma unroll
        for (int g = 0; g < 8; ++g) { const int ai = g >> 2, m = g & 3; const int row = row0 + ai * 128 + m * 16;
            u32x4 sv[2], tv[2]; f32x4 rb[2][2];
#pragma unroll
            for (int bj = 0; bj < 2; ++bj) { sv[bj] = svn[bj]; tv[bj] = tvn[bj]; rb[bj][0] = rbn[bj][0]; rb[bj][1] = rbn[bj][1]; }
            if (g + 1 < 8) MG_LOAD(g + 1);
#pragma unroll
            for (int bj = 0; bj < 2; ++bj) {
                const size_t o = (size_t)row * 1024 + cb + bj * 8; const f32x4 a0 = acc[ai][bj][m][0], a1 = acc[ai][bj][m][1];
                if (MODE == 0) { const u32x2 p = pk4(a0 * unpk4((u32x2){sv[bj].x, sv[bj].y})), q = pk4(a1 * unpk4((u32x2){sv[bj].z, sv[bj].w})); *(u32x4*)(T1 + o) = (u32x4){p.x, p.y, q.x, q.y}; }
                else if (MODE == 1) { const u32x2 p = pk4(unpk4((u32x2){tv[bj].x, tv[bj].y}) + a0 * unpk4((u32x2){sv[bj].x, sv[bj].y})), q = pk4(unpk4((u32x2){tv[bj].z, tv[bj].w}) + a1 * unpk4((u32x2){sv[bj].z, sv[bj].w})); *(u32x4*)(MRG + o) = (u32x4){p.x, p.y, q.x, q.y}; }
                else { const u32x2 p = pk4(rb[bj][0] + gt[bj][0] * a0), q = pk4(rb[bj][1] + gt[bj][1] * a1); *(u32x4*)(X + o) = (u32x4){p.x, p.y, q.x, q.y}; }
            }
            FENCE();
        }
#undef MG_LOAD
    }
};
struct ProbMerge01 {
    static constexpr int K = 1024, KB = 2048; static constexpr bool FP8 = false, GATHER = false, FUSED2 = true;
    unsigned char* ws; int G, c, nM, pbeg, pend;
    __device__ __forceinline__ bool next(int i, Unit& u) const { const int p = pbeg + (i >> 1); if (p >= pend) return false; const int L = p * G + c; if (L >= nM * 4) return false;
        int pm, pn; if (L < 512) pg8::static_map(L, 128, 4, pm, pn); else { pm = 128 + ((L - 512) & 15); pn = (L - 512) >> 4; } u.pm = pm; u.pn = pn; u.e = i & 1; return true; }
    __device__ __forceinline__ const char* aptr(const Unit& u) const { return (const char*)(ws + (u.e == 0 ? WS_H : WS_REC)) + (size_t)u.pm * 256 * K * 2; }
    __device__ __forceinline__ const char* bptr(const Unit& u) const { return (const char*)(ws + (u.e == 0 ? WS_WA : WS_WR)) + (size_t)u.pn * 256 * K * 2; }
    static __device__ __forceinline__ f32x4 clampsr(u32x2 w) { const f32x4 v = unpk4(w); return (f32x4){__builtin_fmaxf(v[0], 1e-18f), __builtin_fmaxf(v[1], 1e-18f), __builtin_fmaxf(v[2], 1e-18f), __builtin_fmaxf(v[3], 1e-18f)}; }
    __device__ __forceinline__ bool epi2(f32x4 (&acc)[2][2][4][2], const Unit& u, int wr, int wc, int fr, int fq) const {
        const int row0 = u.pm * 256 + wr * 64 + fr, cb = u.pn * 256 + wc * 64 + 16 * fq;
        const bf16* SA = (const bf16*)(ws + WS_SMA); const bf16* SR = (const bf16*)(ws + WS_SMR); bf16* MRG = (bf16*)(ws + WS_GZ);
        const bool first = (u.e == 0);
        u32x4 san[2], srn[2];
#define MG_LOAD(g_) do { const int row_ = row0 + ((g_) >> 2) * 128 + ((g_) & 3) * 16; _Pragma("unroll") for (int bj_ = 0; bj_ < 2; ++bj_) { const size_t o_ = (size_t)row_ * 1024 + cb + bj_ * 8; \
            srn[bj_] = *(const u32x4*)(SR + o_); if (first) san[bj_] = *(const u32x4*)(SA + o_); } } while (0)
        MG_LOAD(0);
#pragma unroll
        for (int g = 0; g < 8; ++g) { const int ai = g >> 2, m = g & 3; const int row = row0 + ai * 128 + m * 16;
            u32x4 sa[2], sr[2];
#pragma unroll
            for (int bj = 0; bj < 2; ++bj) { sa[bj] = san[bj]; sr[bj] = srn[bj]; }
            if (g + 1 < 8) MG_LOAD(g + 1);
#pragma unroll
            for (int bj = 0; bj < 2; ++bj) {
                const f32x4 r0 = clampsr((u32x2){sr[bj].x, sr[bj].y}), r1 = clampsr((u32x2){sr[bj].z, sr[bj].w});
                if (first) {
                    const f32x4 q0 = (f32x4){__builtin_amdgcn_rcpf(r0[0]), __builtin_amdgcn_rcpf(r0[1]), __builtin_amdgcn_rcpf(r0[2]), __builtin_amdgcn_rcpf(r0[3])};
                    const f32x4 q1 = (f32x4){__builtin_amdgcn_rcpf(r1[0]), __builtin_amdgcn_rcpf(r1[1]), __builtin_amdgcn_rcpf(r1[2]), __builtin_amdgcn_rcpf(r1[3])};
                    acc[ai][bj][m][0] = acc[ai][bj][m][0] * (unpk4((u32x2){sa[bj].x, sa[bj].y}) * q0);
                    acc[ai][bj][m][1] = acc[ai][bj][m][1] * (unpk4((u32x2){sa[bj].z, sa[bj].w}) * q1);
                } else {
                    const u32x2 p = pk4(acc[ai][bj][m][0] * r0), q = pk4(acc[ai][bj][m][1] * r1);
                    *(u32x4*)(MRG + (size_t)row * 1024 + cb + bj * 8) = (u32x4){p.x, p.y, q.x, q.y};
                }
            }
            FENCE();
        }
#undef MG_LOAD
        return first;
    }
};
__device__ __forceinline__ bool grouped_next(int i, int G, int c, int nPM, int nPN, Unit& u) {
    const int nloc = G / 8, x = c & 7, loc = c >> 3; const int per = nPM * nPN; const long L = (long)i * nloc + loc;
    if (L >= 2 * per) return false;
    u.e = 2 * x + (int)(L / per); const int rem = (int)(L % per);
    const int nig = 8 * nPN, gid = rem / nig, fm = gid * 8, gsz = (nPM - fm) < 8 ? (nPM - fm) : 8;
    u.pm = fm + ((rem % nig) % gsz); u.pn = (rem % nig) / gsz; return true;
}
struct ProbUp {
    static constexpr int KB = 1024; static constexpr bool FP8 = true, GATHER = true, FUSED2 = false;
    unsigned char* ws; int G, c, Me, l;
    __device__ __forceinline__ bool next(int i, Unit& u) const { return grouped_next(i, G, c, Me / 256, 16, u); }
    __device__ __forceinline__ const char* aptr(const Unit&) const { return (const char*)(ws + WS_H); }
    __device__ __forceinline__ const int* rowidx(const Unit& u) const { return (const int*)(ws + WS_ROWIDX) + (size_t)u.e * Me + (size_t)u.pm * 256; }
    __device__ __forceinline__ const char* bptr(const Unit& u) const { return (const char*)(ws + ws_wgu(l)) + ((size_t)u.e * 4096 + (size_t)u.pn * 256) * KB; }
    __device__ __forceinline__ void epi(const f32x4 (&acc)[2][2][4][2], const Unit& u, int wr, int wc, int fr, int fq) const {
        const size_t row0 = (size_t)u.e * Me + u.pm * 256 + wr * 64 + fr; const int cb = u.pn * 128 + wc * 32 + 8 * fq; unsigned char* HID = ws + WS_HID;
        EPI_LOOP_ROWS { const size_t row = row0 + ai * 128 + m * 16; u32x2 wv;
#pragma unroll
            for (int bj = 0; bj < 2; ++bj) { const f32x4 g = acc[ai][bj][m][0] * W8_INV, up = acc[ai][bj][m][1] * W8_INV; f32x4 h;
#pragma unroll
                for (int i = 0; i < 4; i += 2) { const f32x2 g2 = (f32x2){g[i], g[i + 1]}, hh = g2 * sigmoid2(g2) * (f32x2){up[i], up[i + 1]}; h[i] = hh.x; h[i + 1] = hh.y; }
                int w = 0; w = __builtin_amdgcn_cvt_pk_fp8_f32(h[0], h[1], w, false); w = __builtin_amdgcn_cvt_pk_fp8_f32(h[2], h[3], w, true);
                if (bj == 0) wv.x = (unsigned)w; else wv.y = (unsigned)w; }
            *(u32x2*)(HID + row * 2048 + cb) = wv; }
    }
};
struct ProbDown {
    static constexpr int KB = 2048; static constexpr bool FP8 = true, GATHER = false, FUSED2 = false;
    unsigned char* ws; int G, c, Me, l;
    __device__ __forceinline__ bool next(int i, Unit& u) const { return grouped_next(i, G, c, Me / 256, 4, u); }
    __device__ __forceinline__ const char* aptr(const Unit& u) const { return (const char*)(ws + WS_HID) + ((size_t)u.e * Me + (size_t)u.pm * 256) * KB; }
    __device__ __forceinline__ const char* bptr(const Unit& u) const { return (const char*)(ws + ws_wdn(l)) + ((size_t)u.e * 1024 + (size_t)u.pn * 256) * KB; }
    __device__ __forceinline__ void epi(const f32x4 (&acc)[2][2][4][2], const Unit& u, int wr, int wc, int fr, int fq) const {
        const size_t row0 = (size_t)u.e * Me + u.pm * 256 + wr * 64 + fr; const int cb = u.pn * 256 + wc * 64 + 16 * fq; unsigned char* YE = ws + WS_YE; const float* GV = (const float*)(ws + WS_GVAL);
        float gv[8];
#pragma unroll
        for (int g8 = 0; g8 < 8; ++g8) gv[g8] = GV[row0 + (g8 >> 2) * 128 + (g8 & 3) * 16];
        EPI_LOOP_ROWS { const size_t row = row0 + ai * 128 + m * 16; const float g = gv[ai * 4 + m] * (W8_INV * YE_SCALE); u32x4 wv;
#pragma unroll
            for (int bj = 0; bj < 2; ++bj)
#pragma unroll
                for (int n = 0; n < 2; ++n) { const f32x4 v = acc[ai][bj][m][n] * g; int w = 0; w = __builtin_amdgcn_cvt_pk_fp8_f32(v[0], v[1], w, false); w = __builtin_amdgcn_cvt_pk_fp8_f32(v[2], v[3], w, true); wv[2 * bj + n] = (unsigned)w; }
            *(u32x4*)(YE + row * 1024 + cb) = wv; }
    }
};

template <class ColPtr>
__device__ __forceinline__ void tr_item(const ColPtr& cp, int K, bf16* WT, int item, int nblk, LAS float* scr, int lane) {
    const int kb = item / nblk, nb = item % nblk, k0 = 64 * kb, n0 = 32 * nb;
    size_t stride; const float* src = cp(n0 + (lane & 31), stride) + (size_t)k0 * stride;
    float tv[32];
#pragma unroll
    for (int i = 0; i < 32; ++i) tv[i] = src[(size_t)(2 * i + (lane >> 5)) * stride];
#pragma unroll
    for (int i = 0; i < 32; ++i) scr[(2 * i + (lane >> 5)) * 33 + (lane & 31)] = tv[i];
    asm volatile("s_waitcnt lgkmcnt(0)" ::: "memory");
    const int c = lane & 7;
#pragma unroll
    for (int j = 0; j < 4; ++j) { const int n = (lane >> 3) + 8 * j; const LAS float* s = scr + (8 * c) * 33 + n;
        u32x4 o; o.x = pk2(s[0 * 33], s[1 * 33]); o.y = pk2(s[2 * 33], s[3 * 33]); o.z = pk2(s[4 * 33], s[5 * 33]); o.w = pk2(s[6 * 33], s[7 * 33]);
        *(u32x4*)(WT + (size_t)(n0 + n) * K + k0 + 8 * c) = o; }
    asm volatile("s_waitcnt lgkmcnt(0)" ::: "memory");
}
template <class ColPtr>
__device__ __forceinline__ void tr_item8(const ColPtr& cp, int K, unsigned char* WT, int item, int nblk, LAS float* scr, int lane, float scale) {
    const int kb = item / nblk, nb = item % nblk, k0 = 128 * kb, n0 = 32 * nb;
    size_t stride; const float* src = cp(n0 + (lane & 31), stride) + (size_t)k0 * stride;
    const float* rp = src + (size_t)(lane >> 5) * stride;
#pragma unroll
    for (int hb = 0; hb < 2; ++hb) { float tv[32];
#pragma unroll
        for (int i = 0; i < 32; ++i) { tv[i] = *rp; rp += 2 * stride; }
#pragma unroll
        for (int i = 0; i < 32; ++i) scr[(64 * hb + 2 * i + (lane >> 5)) * 33 + (lane & 31)] = tv[i];
        asm volatile("" ::: "memory"); }
    asm volatile("s_waitcnt lgkmcnt(0)" ::: "memory");
    const int c = lane & 7;
#pragma unroll
    for (int j = 0; j < 4; ++j) { const int n = (lane >> 3) + 8 * j; const LAS float* s = scr + (16 * c) * 33 + n; u32x4 o;
#pragma unroll
        for (int q = 0; q < 4; ++q) { int w = 0; w = __builtin_amdgcn_cvt_pk_fp8_f32(s[(4 * q) * 33] * scale, s[(4 * q + 1) * 33] * scale, w, false); w = __builtin_amdgcn_cvt_pk_fp8_f32(s[(4 * q + 2) * 33] * scale, s[(4 * q + 3) * 33] * scale, w, true); o[q] = (unsigned)w; }
        *(u32x4*)(WT + (size_t)(n0 + n) * K + k0 + 16 * c) = o; asm volatile("" ::: "memory"); }
    asm volatile("s_waitcnt lgkmcnt(0)" ::: "memory");
}
__host__ __device__ __forceinline__ int sig16(int s) { return 64 * ((s >> 5) & 3) + 16 * ((s >> 2) & 3) + 8 * (s >> 7) + 4 * ((s >> 4) & 1) + (s & 3); }
struct ColIn { const float* W; __device__ __forceinline__ const float* operator()(int n, size_t& stride) const { stride = INW; int col = n; if (n < 1280) col = (n & ~127) + ropedim(n & 127); else if (n >= 1536) col = (n & ~255) + sig16(n & 255); return W + col; } };
struct ColIn8 { const float* W; __device__ __forceinline__ const float* operator()(int n, size_t& stride) const { stride = INW; return W + 3584 + (n & ~255) + sig16(n & 255); } };
struct ColPlain { const float* W; int N; __device__ __forceinline__ const float* operator()(int n, size_t& stride) const { stride = (size_t)N; return W + n; } };
struct ColP16 { const float* W; int N; __device__ __forceinline__ const float* operator()(int n, size_t& stride) const { stride = (size_t)N; return W + (n & ~255) + sig16(n & 255); } };
struct ColGU { const float* Wg; const float* Wu; __device__ __forceinline__ const float* operator()(int n, size_t& stride) const { stride = DE;
    const int hc = 128 * (n >> 8) + 32 * ((n >> 5) & 3) + 8 * ((n >> 2) & 3) + 4 * ((n >> 7) & 1) + (n & 3);
    const unsigned long long d = (unsigned long long)Wu - (unsigned long long)Wg; return (const float*)((unsigned long long)Wg + (((n >> 4) & 1) ? d : 0ull)) + hc; } };

constexpr int CT_P = 257;
__device__ __forceinline__ void convert_moe_tiles(const Ctx& c, int l, int wg_first = 0, int wg_count = 0) {
    LAS float* T = (LAS float*)c.lds;
    constexpr int T_GU = NE * 8 * 16, T_DN = NE * 16 * 4;
    const int nwg_ = wg_count ? wg_count : c.G;
    for (int tile = c.bid - wg_first; tile < T_GU + T_DN; tile += nwg_) {
        const bool gu = tile < T_GU; const int tt = gu ? tile : tile - T_GU;
        const int e = gu ? tt >> 7 : tt >> 6, kt = gu ? (tt >> 4) & 7 : (tt >> 2) & 15, pn = gu ? tt & 15 : tt & 3;
        const int K = gu ? D : DE, N = gu ? DE : D, k0 = 128 * kt;
        const float* W0 = gu ? c.in[I_WGATE] + ((size_t)l * NE + e) * D * DE : c.in[I_WDOWN] + ((size_t)l * NE + e) * DE * D;
        const float* W1 = gu ? c.in[I_WUP] + ((size_t)l * NE + e) * D * DE : W0;
        f32x4 ld[16];
#pragma unroll
        for (int i = 0; i < 16; ++i) { const int g = c.tid + 512 * i, k = g >> 6, c4 = g & 63;
            const float* src = gu ? ((c4 < 32 ? W0 : W1) + (size_t)(k0 + k) * N + 128 * pn + 4 * (c4 & 31)) : (W0 + (size_t)(k0 + k) * N + 256 * pn + 4 * c4);
            ld[i] = *(const f32x4*)src; }
#pragma unroll
        for (int i = 0; i < 16; ++i) { const int g = c.tid + 512 * i, k = g >> 6, c4 = g & 63; LAS float* t = T + k * CT_P + 4 * c4; t[0] = ld[i][0]; t[1] = ld[i][1]; t[2] = ld[i][2]; t[3] = ld[i][3]; }
        __syncthreads();
        unsigned char* WT = gu ? c.ws + ws_wgu(l) + ((size_t)e * 4096 + 256 * pn) * D : c.ws + ws_wdn(l) + ((size_t)e * 1024 + 256 * pn) * DE;
#pragma unroll
        for (int j = 0; j < 4; ++j) { const int q = c.tid + 512 * j, n = q >> 3, ch = q & 7;
            const int sc = gu ? 128 * ((n >> 4) & 1) + 32 * ((n >> 5) & 3) + 8 * ((n >> 2) & 3) + 4 * (n >> 7) + (n & 3) : sig16(n);
            const LAS float* t = T + (16 * ch) * CT_P + sc; u32x4 o;
#pragma unroll
            for (int w4 = 0; w4 < 4; ++w4) { int w = 0; w = __builtin_amdgcn_cvt_pk_fp8_f32(t[(4 * w4) * CT_P] * W8_SCALE, t[(4 * w4 + 1) * CT_P] * W8_SCALE, w, false); w = __builtin_amdgcn_cvt_pk_fp8_f32(t[(4 * w4 + 2) * CT_P] * W8_SCALE, t[(4 * w4 + 3) * CT_P] * W8_SCALE, w, true); o[w4] = (unsigned)w; }
            *(u32x4*)(WT + (size_t)n * K + k0 + 16 * ch) = o; }
        __syncthreads();
    }
}
__device__ __forceinline__ void phase_convert_weights(const Ctx& c0, int l, int wg_first = 0, int wg_count = 0) {
    const Ctx c = fresh(c0);
    LAS float* scr = (LAS float*)(c.lds + c.wave * 17408);
    const int gw = (c.bid - wg_first) * NWAVES + c.wave, NGW = (wg_count ? wg_count : c.G) * NWAVES;
    constexpr int I_IN = 16 * 112, I_IN8 = 8 * 64, I_SQ = 16 * 32;
    constexpr int I_LW = 32 * 8;
    constexpr int NITEMS = I_IN + I_IN8 + 3 * I_SQ + I_LW;
    for (int it = gw; it < NITEMS; it += NGW) {
        int r = it;
        if (r < I_IN) { ColIn cp{c.in[I_WIN] + (size_t)l * D * INW}; tr_item(cp, D, (bf16*)(c.ws + WS_WIN), r, 112, scr, c.lane); continue; } r -= I_IN;
        if (r < I_IN8) { ColIn8 cp{c.in[I_WIN] + (size_t)l * D * INW}; tr_item8(cp, D, c.ws + WS_WIN8, r, 64, scr, c.lane, W8_SCALE); continue; } r -= I_IN8;
        if (r < I_SQ) { ColP16 cp{c.in[I_WABR] + (size_t)l * D * D, D}; tr_item(cp, D, (bf16*)(c.ws + WS_WA), r, 32, scr, c.lane); continue; } r -= I_SQ;
        if (r < I_SQ) { ColP16 cp{c.in[I_WRBR] + (size_t)l * D * D, D}; tr_item(cp, D, (bf16*)(c.ws + WS_WR), r, 32, scr, c.lane); continue; } r -= I_SQ;
        if (r < I_SQ) { ColP16 cp{c.in[I_WOUT] + (size_t)l * D * D, D}; tr_item(cp, D, (bf16*)(c.ws + WS_WO), r, 32, scr, c.lane); continue; } r -= I_SQ;
        { const int mat = r >> 3, g = mat & 1, dn = mat >> 1;
          ColPlain cp{c.in[g ? I_LWX : I_LWA] + ((size_t)l * 16 + dn) * 16384, 128}; tr_item(cp, 128, (bf16*)(c.ws + WS_LW) + (size_t)mat * 16384, r & 7, 4, scr, c.lane); }
    }
}
__device__ __forceinline__ void phase_convert_moe(const Ctx& c0, int l, int wg_first = 0, int wg_count = 0) { const Ctx c = fresh(c0); __syncthreads(); convert_moe_tiles(c, l, wg_first, wg_count); __syncthreads(); }
__device__ __forceinline__ void phase_mod(const Ctx& c0) {
    const Ctx c = fresh(c0);
    LAS float* sc = (LAS float*)c.lds; LAS float* red = (LAS float*)(c.lds + 17 * 1024 * 4);
    for (int i = c.tid; i < 17 * 1024; i += NTHR) { const int r = i >> 10, k = i & 1023; const float v = r < 16 ? c.in[I_C][r * 1024 + k] : c.in[I_CCTX][k]; sc[i] = v / (1.0f + expf(-v)); }
    __syncthreads();
    float* MOD = (float*)(c.ws + WS_MOD);
    for (int item = c.bid; item < 2 * 96; item += c.G) {
        const int l = item / 96, n0 = (item % 96) * 64;
        const float* w = c.in[I_ADAW] + (size_t)l * D * 6144 + n0 + c.lane;
        float acc[17];
#pragma unroll
        for (int r = 0; r < 17; ++r) acc[r] = 0.f;
        const int k0 = c.wave * 128;
        for (int kb = 0; kb < 128; kb += 32) {
            float wv[32];
#pragma unroll
            for (int k = 0; k < 32; ++k) wv[k] = w[(size_t)(k0 + kb + k) * 6144];
#pragma unroll
            for (int k = 0; k < 32; ++k) {
#pragma unroll
                for (int r = 0; r < 17; ++r) acc[r] += sc[r * 1024 + k0 + kb + k] * wv[k]; }
        }
#pragma unroll
        for (int r = 0; r < 17; ++r) red[(c.wave * 17 + r) * 64 + c.lane] = acc[r];
        __syncthreads();
        for (int i = c.tid; i < 17 * 64; i += NTHR) { const int r = i >> 6, ln = i & 63; float s = 0.f;
#pragma unroll
            for (int w8 = 0; w8 < 8; ++w8) s += red[(w8 * 17 + r) * 64 + ln];
            MOD[(size_t)(l * 17 + r) * 6144 + n0 + ln] = s + c.in[I_ADAB][l * 6144 + n0 + ln]; }
        __syncthreads();
    }
    float* COS = (float*)(c.ws + WS_COS); float* SIN = (float*)(c.ws + WS_SIN);
    for (int i = c.bid * NTHR + c.tid; i < 64 * 32; i += c.G * NTHR) { const int pos = i >> 5, k = i & 31; const float fr = powf(10000.0f, -(float)k / 32.0f), ang = (float)pos * fr; COS[i] = cosf(ang); SIN[i] = sinf(ang); }
}

__device__ __forceinline__ void phase_norm1(const Ctx& c0, int l) {
    const Ctx c = fresh(c0);
    const bool fin = (l == DEPTH);
    const int gw = c.bid * NWAVES + c.wave, NGW = c.G * NWAVES, nrows = fin ? NLAT : NROW;
    const float* MOD = (const float*)(c.ws + WS_MOD); bf16* X = (bf16*)(c.ws + WS_X); bf16* H = (bf16*)(c.ws + WS_H);
    const short* SLOT = (const short*)(c.ws + WS_SLOT); const unsigned char* YE = c.ws + WS_YE;
    int cur_r = -1; f32x4 al[4], be[4];
    if (l == 0) {
        const f32x4* g = (const f32x4*)(c.in[I_NMG]);
        const int npair = NROW / 2, ppw = (npair + NGW - 1) / NGW, pbeg = gw * ppw, pend = (pbeg + ppw < npair) ? pbeg + ppw : npair;
        for (int rp = pbeg; rp < pend; ++rp) {
            f32x4 v[2][4];
#pragma unroll
            for (int k = 0; k < 2; ++k) { const int row = 2 * rp + k; const f32x4* src = (const f32x4*)(row < NLAT ? c.in[I_X] + (size_t)row * D : c.in[I_CTX] + (size_t)(row - NLAT) * D);
#pragma unroll
                for (int j = 0; j < 4; ++j) v[k][j] = src[c.lane + 64 * j]; }
            { const int row = 2 * rp, r = row < NLAT ? (row >> 11) : 16;
              if (r != cur_r) { cur_r = r; const float* mp = MOD + (size_t)r * 6144; const f32x4* sh = (const f32x4*)mp; const f32x4* scl = (const f32x4*)(mp + 1024);
#pragma unroll
                  for (int j = 0; j < 4; ++j) { const int q = c.lane + 64 * j; al[j] = g[q] * (scl[q] + 1.0f); be[j] = sh[q]; } } }
#pragma unroll
            for (int k = 0; k < 2; ++k) { const int row = 2 * rp + k; float ss = 0.f;
#pragma unroll
                for (int j = 0; j < 4; ++j) ss += (v[k][j][0] * v[k][j][0] + v[k][j][1] * v[k][j][1]) + (v[k][j][2] * v[k][j][2] + v[k][j][3] * v[k][j][3]);
                const float rstd = 1.0f / sqrtf(wave_sum(ss) * (1.0f / D) + EPS);
                u32x2* o = (u32x2*)(H + (size_t)row * D); unsigned* o8 = (unsigned*)(c.ws + WS_H8 + (size_t)row * D);
#pragma unroll
                for (int j = 0; j < 4; ++j) { const f32x4 hv = v[k][j] * rstd * al[j] + be[j]; o[c.lane + 64 * j] = pk4(hv); o8[c.lane + 64 * j] = f8x4(hv); } }
        }
        return;
    }
    const int MeP = (l - 1 == DEPTH - 1) ? 4096 : 4608;
    const int rpw = (nrows + NGW - 1) / NGW, rbeg = gw * rpw, rend = (rbeg + rpw < nrows) ? rbeg + rpw : nrows;
    f32x4 vn[4], g2v[4]; int slotn = -1;
    if (rbeg < rend) { const u32x2* src = (const u32x2*)(X + (size_t)rbeg * D);
#pragma unroll
        for (int j = 0; j < 4; ++j) vn[j] = unpk4(src[c.lane + 64 * j]);
        slotn = (int)SLOT[(size_t)rbeg * 16 + (c.lane & 15)]; }
    for (int row = rbeg; row < rend; ++row) {
        const int r = row < NLAT ? (row >> 11) : 16;
        f32x4 v[4];
#pragma unroll
        for (int j = 0; j < 4; ++j) v[j] = vn[j];
        const int myslot = slotn;
        { const int nr = row + 1; if (nr < rend) { const u32x2* src = (const u32x2*)(X + (size_t)nr * D);
#pragma unroll
            for (int j = 0; j < 4; ++j) vn[j] = unpk4(src[c.lane + 64 * j]);
            slotn = (int)SLOT[(size_t)nr * 16 + (c.lane & 15)]; } }
        if (r != cur_r) { cur_r = r; const f32x4* g2 = (const f32x4*)(MOD + (size_t)((l - 1) * 17 + r) * 6144 + 5120);
#pragma unroll
            for (int j = 0; j < 4; ++j) g2v[j] = g2[c.lane + 64 * j] * YE_INV;
            if (!fin) { const f32x4* g = (const f32x4*)(c.in[I_NMG] + l * D); const float* mp = MOD + (size_t)(l * 17 + r) * 6144; const f32x4* sh = (const f32x4*)mp; const f32x4* scl = (const f32x4*)(mp + 1024);
#pragma unroll
                for (int j = 0; j < 4; ++j) { const int q = c.lane + 64 * j; al[j] = g[q] * (scl[q] + 1.0f); be[j] = sh[q]; } }
            else { const f32x4* g = (const f32x4*)c.in[I_FNG];
#pragma unroll
                for (int j = 0; j < 4; ++j) al[j] = g[c.lane + 64 * j]; } }
        f32x4 a[4];
#pragma unroll
        for (int j = 0; j < 4; ++j) a[j] = (f32x4){0.f, 0.f, 0.f, 0.f};
        const int ybase = row < NLAT ? (row >> 11) * CAPL : 4096 + ((row - NLAT) >> 8) * CAPC;
        unsigned long long sel = __builtin_amdgcn_ballot_w64(myslot >= 0) & 0xFFFFull;
        while (sel) {
            const int e0 = __builtin_ctzll(sel); sel &= sel - 1; const bool two = sel != 0; const int e1 = two ? __builtin_ctzll(sel) : e0; if (two) sel &= sel - 1;
            const int s0 = __builtin_amdgcn_readlane(myslot, e0), s1 = __builtin_amdgcn_readlane(myslot, e1);
            const int* y0 = (const int*)(YE + ((size_t)e0 * MeP + ybase + s0) * D); const int* y1 = (const int*)(YE + ((size_t)e1 * MeP + ybase + s1) * D);
            int w0[4], w1[4];
#pragma unroll
            for (int j = 0; j < 4; ++j) { w0[j] = y0[c.lane + 64 * j]; w1[j] = y1[c.lane + 64 * j]; }
            const float k1 = two ? 1.0f : 0.0f;
#pragma unroll
            for (int j = 0; j < 4; ++j) { const f32x2 lo0 = __builtin_amdgcn_cvt_pk_f32_fp8(w0[j], false), hi0 = __builtin_amdgcn_cvt_pk_f32_fp8(w0[j], true), lo1 = __builtin_amdgcn_cvt_pk_f32_fp8(w1[j], false), hi1 = __builtin_amdgcn_cvt_pk_f32_fp8(w1[j], true);
                a[j] += (f32x4){lo0.x, lo0.y, hi0.x, hi0.y} + (f32x4){lo1.x, lo1.y, hi1.x, hi1.y} * k1; }
        }
#pragma unroll
        for (int j = 0; j < 4; ++j) v[j] += g2v[j] * a[j];
        if (!fin) { u32x2* dst = (u32x2*)(X + (size_t)row * D);
#pragma unroll
            for (int j = 0; j < 4; ++j) dst[c.lane + 64 * j] = pk4(v[j]); }
        float ss = 0.f;
#pragma unroll
        for (int j = 0; j < 4; ++j) ss += (v[j][0] * v[j][0] + v[j][1] * v[j][1]) + (v[j][2] * v[j][2] + v[j][3] * v[j][3]);
        const float rstd = 1.0f / sqrtf(wave_sum(ss) * (1.0f / D) + EPS);
        if (fin) { f32x4* o = (f32x4*)(c.out + (size_t)row * D);
#pragma unroll
            for (int j = 0; j < 4; ++j) o[c.lane + 64 * j] = v[j] * rstd * al[j];
        } else { u32x2* o = (u32x2*)(H + (size_t)row * D); unsigned* o8 = (unsigned*)(c.ws + WS_H8 + (size_t)row * D);
#pragma unroll
            for (int j = 0; j < 4; ++j) { const f32x4 hv = v[j] * rstd * al[j] + be[j]; o[c.lane + 64 * j] = pk4(hv); o8[c.lane + 64 * j] = f8x4(hv); } }
    }
}
constexpr int F1_P = 1028;
__device__ __forceinline__ void phase_norm2(const Ctx& c0, int l) {
    const Ctx c = fresh(c0);
    LAS float* T = (LAS float*)c.lds;
    LAS float* PART = T + 16 * F1_P;
    LAS float* RS = PART + 8 * 256;
    LAS float* CP = RS + 16;
    const int nrows = (l == DEPTH - 1) ? NLAT : NROW, ntile = nrows / 16;
    const int tpw = (ntile + c.G - 1) / c.G, tbeg = c.bid * tpw, tend = (tbeg + tpw < ntile) ? tbeg + tpw : ntile;
    const float* MOD = (const float*)(c.ws + WS_MOD); const bf16* X = (const bf16*)(c.ws + WS_X); unsigned char* H = c.ws + WS_H; float* AFF = (float*)(c.ws + WS_AFF);
    const float* WR = c.in[I_WROUTER] + (size_t)l * 16384; const float* GF = c.in[I_NFG] + l * D;
    const int tid = c.tid, lane = c.lane, w = c.wave, e16 = lane & 15, kk = lane >> 4;
    u32x4 ld[4];
#define F1_LOAD(t_, tq_) do { const u32x4* src_ = (const u32x4*)(X + (size_t)(t_) * 16 * D) + (tq_); _Pragma("unroll") for (int i_ = 0; i_ < 4; ++i_) ld[i_] = src_[512 * i_]; } while (0)
    if (tbeg < tend) F1_LOAD(tbeg, tid);
    float Breg[32]; float creg = 0.f; int cur_r = -1;
    for (int t = tbeg; t < tend; ++t) {
        int tq = tid; asm volatile("" : "+v"(tq));
        const int row0 = t * 16, r = row0 < NLAT ? (row0 >> 11) : 16;
#pragma unroll
        for (int i = 0; i < 4; ++i) { const int g = tq + 512 * i; LAS f32x4* tp = (LAS f32x4*)(T + (g >> 7) * F1_P + 8 * (g & 127)); tp[0] = unpk4((u32x2){ld[i].x, ld[i].y}); tp[1] = unpk4((u32x2){ld[i].z, ld[i].w}); }
        if (t + 1 < tend) F1_LOAD(t + 1, tq);
        const float* mp = MOD + (size_t)(l * 17 + r) * 6144;
        if (r != cur_r) { cur_r = r;
            float cpart = 0.f;
#pragma unroll
            for (int s4 = 0; s4 < 32; ++s4) { const int k = 128 * w + 4 * s4 + kk; const float wv = WR[k * 16 + e16]; Breg[s4] = GF[k] * (mp[4096 + k] + 1.0f) * wv; cpart += mp[3072 + k] * wv; if ((s4 & 3) == 3) asm volatile("" ::: "memory"); }
            CP[(w * 4 + kk) * 16 + e16] = cpart; }
        __syncthreads();
#pragma unroll
        for (int k2 = 0; k2 < 2; ++k2) { const int row = 2 * w + k2; float ss = 0.f;
#pragma unroll
            for (int j = 0; j < 4; ++j) { const f32x4 x = *(const LAS f32x4*)(T + row * F1_P + 4 * (lane + 64 * j)); ss += (x[0] * x[0] + x[1] * x[1]) + (x[2] * x[2] + x[3] * x[3]); }
            ss = wave_sum(ss); if (lane == 0) RS[row] = 1.0f / sqrtf(ss * (1.0f / D) + EPS); }
        f32x4 acc = (f32x4){0.f, 0.f, 0.f, 0.f};
#pragma unroll
        for (int s4 = 0; s4 < 32; ++s4) { acc = __builtin_amdgcn_mfma_f32_16x16x4f32(T[e16 * F1_P + 128 * w + 4 * s4 + kk], Breg[s4], acc, 0, 0, 0);
            if ((s4 & 7) == 7) asm volatile("" ::: "memory"); }
#pragma unroll
        for (int i = 0; i < 4; ++i) PART[w * 256 + (4 * kk + i) * 16 + e16] = acc[i];
        __syncthreads();
        if (tq < 256) { const int row = tq >> 4, e = tq & 15; float sum = 0.f, cc = 0.f;
#pragma unroll
            for (int w8 = 0; w8 < 8; ++w8) sum += PART[w8 * 256 + row * 16 + e];
#pragma unroll
            for (int q = 0; q < 32; ++q) cc += CP[q * 16 + e];
            const float lg = RS[row] * sum + cc;
            float mx = lg; mx = fmaxf(mx, __shfl_xor(mx, 1)); mx = fmaxf(mx, __shfl_xor(mx, 2)); mx = fmaxf(mx, __shfl_xor(mx, 4)); mx = fmaxf(mx, __shfl_xor(mx, 8));
            const float ex = expf(lg - mx); float sm = ex; sm += __shfl_xor(sm, 1); sm += __shfl_xor(sm, 2); sm += __shfl_xor(sm, 4); sm += __shfl_xor(sm, 8);
            AFF[(size_t)(row0 + row) * 16 + e] = ex / sm; }
#pragma unroll
        for (int i = 0; i < 8; ++i) { const int g = tq + 512 * i, row = g >> 8, c4 = g & 255; const f32x4 x = *(const LAS f32x4*)(T + row * F1_P + 4 * c4);
            const f32x4 gf = *(const f32x4*)(GF + 4 * c4), sc = *(const f32x4*)(mp + 4096 + 4 * c4), sh = *(const f32x4*)(mp + 3072 + 4 * c4);
            const f32x4 hv = x * RS[row] * gf * (sc + 1.0f) + sh;
            int wv = 0; wv = __builtin_amdgcn_cvt_pk_fp8_f32(hv[0], hv[1], wv, false); wv = __builtin_amdgcn_cvt_pk_fp8_f32(hv[2], hv[3], wv, true);
            *(int*)(H + (size_t)(row0 + row) * D + 4 * c4) = wv; if (i & 1) asm volatile("" ::: "memory"); }
        __syncthreads();
    }
#undef F1_LOAD
}
__device__ __forceinline__ void phase_topk(const Ctx& c0, int l) {
    const Ctx c = fresh(c0);
    LAS unsigned long long* keys = (LAS unsigned long long*)c.lds;
    const float* AFF = (const float*)(c.ws + WS_AFF); int* ROWIDX = (int*)(c.ws + WS_ROWIDX); float* GVAL = (float*)(c.ws + WS_GVAL); short* SLOT = (short*)(c.ws + WS_SLOT);
    const bool last = (l == DEPTH - 1); const int Me = last ? 4096 : 4608; const int nitems = last ? 256 : 512;
    for (int item = c.bid; item < nitems; item += c.G) {
        const bool isctx = item >= 256; const int b = (item & 255) >> 4, e = item & 15;
        const int n = isctx ? CTXL : SEQ, cap = isctx ? CAPC : CAPL, rbase = isctx ? NLAT + b * CTXL : b * SEQ;
        for (int t = c.tid; t < n; t += NTHR) { const unsigned a = __builtin_bit_cast(unsigned, AFF[(size_t)(rbase + t) * 16 + e]); keys[t] = ((unsigned long long)a << 32) | (unsigned long long)(0xFFFFFFFFu - (unsigned)t); }
        __syncthreads();
        for (int k = 2; k <= n; k <<= 1) {
            if ((k >> 1) > 32) __syncthreads();
            for (int lj = 31 - __builtin_clz(k >> 1); lj >= 0; --lj) { const int j = 1 << lj;
                for (int i = c.tid; i < n / 2; i += NTHR) { const int ix = ((i >> lj) << (lj + 1)) | (i & (j - 1)), iy = ix + j; const unsigned long long a = keys[ix], bb = keys[iy]; const bool up = (ix & k) == 0;
                    if (up ? (a < bb) : (a > bb)) { keys[ix] = bb; keys[iy] = a; } }
                if (j > 32) __syncthreads(); else asm volatile("s_waitcnt lgkmcnt(0)" ::: "memory");
            } }
        __syncthreads();
        const int ybase = e * Me + (isctx ? 4096 + b * CAPC : b * CAPL);
        for (int p = c.tid; p < n; p += NTHR) { const unsigned long long kv = keys[p]; const int t = (int)(0xFFFFFFFFu - (unsigned)(kv & 0xFFFFFFFFull));
            SLOT[(size_t)(rbase + t) * 16 + e] = (short)(p < cap ? p : -1);
            if (p < cap) { ROWIDX[ybase + p] = rbase + t; GVAL[ybase + p] = __builtin_bit_cast(float, (unsigned)(kv >> 32)); } }
        __syncthreads();
    }
}
typedef float f32x16 __attribute__((ext_vector_type(16)));
constexpr int AT_KP = 272, AT_VP = 144, AT_KB = 64 * AT_KP, AT_VB = 128 * AT_VP;
__device__ __forceinline__ void phase_attn(const Ctx& c0, int l, int r_lo, int r_hi) {
    const Ctx c = fresh(c0);
    const bool lastl = (l == DEPTH - 1); const int nitems = lastl ? 1024 : 1152;
    const bf16* Q = (const bf16*)(c.ws + WS_Q); const bf16* Kb = (const bf16*)(c.ws + WS_K); const bf16* Vt = (const bf16*)(c.ws + WS_VT); bf16* ATT = (bf16*)(c.ws + WS_H);
    const int w = c.wave, lane = c.lane, lq = lane & 31, h = lane >> 5, tid = c.tid;
    const float scale2 = 0.08838834764831845f * 1.4426950408889634f;
    for (int item = c.bid + c.G * r_lo; item < nitems && item < c.bid + c.G * r_hi; item += c.G) {
        int b, n, kvh, hp; bool isctx;
        if (item < 1024) { b = item >> 6; n = (item >> 2) & 15; kvh = (item >> 1) & 1; hp = item & 1; isctx = false; }
        else { const int it = item - 1024; b = it >> 3; kvh = (it >> 2) & 1; hp = (it >> 1) & 1; n = it & 1; isctx = true; }
        const int qw = (w & 3) ^ ((w >> 2) << 1);
        const int head = kvh * 4 + hp * 2 + (w >> 2), qi = qw * 32 + lq;
        const int qrow = (isctx ? NLAT + b * CTXL : b * SEQ) + n * 128 + qi;
        const int tlo = isctx ? 0 : (n == 0 ? 2 : 0), nband = isctx ? 0 : ((n == 15 ? 4 : 6) - tlo), ntile = nband + 4;
        bf16x8 qf[8];
        { const u32x4* qp = (const u32x4*)(Q + (size_t)qrow * 1024 + head * 128 + 8 * h);
#pragma unroll
            for (int ks = 0; ks < 8; ++ks) qf[ks] = __builtin_bit_cast(bf16x8, qp[2 * ks]); }
        f32x16 O[4];
#pragma unroll
        for (int dt = 0; dt < 4; ++dt)
#pragma unroll
            for (int r = 0; r < 16; ++r) O[dt][r] = 0.f;
        float mrun = c.in[I_SINK][l * 8 + head] * (1.4426950408889634f / scale2), lsum = (h == 0) ? 1.0f : 0.0f;
        u32x4 kreg[2], vreg[2];
        auto tile_row0 = [&](int i) -> int { return i < nband ? b * SEQ + (n - 1) * 128 + (tlo + i) * 64 : NLAT + b * CTXL + (i - nband) * 64; };
#define AT_LOAD(i_) do { const int r0_ = tile_row0(i_); _Pragma("unroll") for (int i2 = 0; i2 < 2; ++i2) { const int cidx = tid + 512 * i2; \
            kreg[i2] = *(const u32x4*)(Kb + (size_t)(r0_ + (cidx >> 4)) * 256 + kvh * 128 + (cidx & 15) * 8); \
            vreg[i2] = *(const u32x4*)(Vt + (size_t)(kvh * 128 + (cidx >> 3)) * NROW + r0_ + (cidx & 7) * 8); } } while (0)
#define AT_STORE(buf_) do { _Pragma("unroll") for (int i2 = 0; i2 < 2; ++i2) { const int cidx = tid + 512 * i2; \
            *(LAS u32x4*)(c.lds + (buf_) * AT_KB + (cidx >> 4) * AT_KP + (cidx & 15) * 16) = kreg[i2]; \
            LAS u32x2* vp_ = (LAS u32x2*)(c.lds + 2 * AT_KB + (buf_) * AT_VB + (cidx >> 3) * AT_VP + ((cidx & 7) >> 1) * 32 + (cidx & 1) * 8); \
            vp_[0] = (u32x2){vreg[i2].x, vreg[i2].y}; vp_[2] = (u32x2){vreg[i2].z, vreg[i2].w}; } } while (0)
        AT_LOAD(0); AT_STORE(0);
        __syncthreads();
        for (int i = 0; i < ntile; ++i) {
            const int buf = i & 1;
            if (i + 1 < ntile) AT_LOAD(i + 1);
            const int tau = i < nband ? tlo + i : 2;
            const int mtype = tau >> 1, kbase = (tau & 1) * 64;
            const LAS unsigned char* Kl = c.lds + buf * AT_KB; const LAS unsigned char* Vl = c.lds + 2 * AT_KB + buf * AT_VB;
            const int ks0 = (tau & 1) * 2;
            const bool d0 = (mtype == 0 && ks0 < qw) || (mtype == 2 && ks0 > qw), d1 = (mtype == 0 && ks0 + 1 < qw) || (mtype == 2 && ks0 + 1 > qw);
            if (!(d0 && d1)) {
            f32x16 S[2];
#pragma unroll
            for (int sub = 0; sub < 2; ++sub) { if (sub ? d1 : d0) continue;
#pragma unroll
                for (int r = 0; r < 16; ++r) S[sub][r] = 0.f;
#pragma unroll
                for (int ks = 0; ks < 8; ++ks) { const bf16x8 kf = *(const LAS bf16x8*)(Kl + (sub * 32 + lq) * AT_KP + ks * 32 + h * 16);
                    S[sub] = __builtin_amdgcn_mfma_f32_32x32x16_bf16(kf, qf[ks], S[sub], 0, 0, 0); }
            }
            float mx = -INFINITY;
            if (mtype != 1) {
#pragma unroll
                for (int sub = 0; sub < 2; ++sub) if (ks0 + sub == qw)
#pragma unroll
                    for (int r = 0; r < 16; ++r) { const int kj = kbase + sub * 32 + (r & 3) + 8 * (r >> 2) + 4 * h; const bool valid = (mtype == 0) ? (kj >= qi) : (kj <= qi); S[sub][r] = valid ? S[sub][r] : -INFINITY; } }
#pragma unroll
            for (int sub = 0; sub < 2; ++sub) if (!(sub ? d1 : d0))
#pragma unroll
                for (int r = 0; r < 16; r += 2) mx = fmaxf(mx, fmaxf(S[sub][r], S[sub][r + 1]));
            mx = fmaxf(mx, __shfl_xor(mx, 32));
            const float mnew = fmaxf(mrun, mx), alpha = __builtin_amdgcn_exp2f((mrun - mnew) * scale2); mrun = mnew;
            const f32x2 nms = (f32x2){-mnew * scale2, -mnew * scale2};
            f32x2 ps2 = (f32x2){0.f, 0.f};
#pragma unroll
            for (int sub = 0; sub < 2; ++sub) if (!(sub ? d1 : d0))
#pragma unroll
                for (int r = 0; r < 16; r += 2) { const f32x2 a2 = (f32x2){S[sub][r], S[sub][r + 1]} * scale2 + nms; const f32x2 p2 = (f32x2){__builtin_amdgcn_exp2f(a2.x), __builtin_amdgcn_exp2f(a2.y)}; S[sub][r] = p2.x; S[sub][r + 1] = p2.y; ps2 += p2; }
            const float psum = ps2.x + ps2.y;
            lsum = lsum * alpha + psum;
#pragma unroll
            for (int dt = 0; dt < 4; ++dt) O[dt] = O[dt] * alpha;
#pragma unroll
            for (int sub = 0; sub < 2; ++sub) if (!(sub ? d1 : d0))
#pragma unroll
                for (int s2 = 0; s2 < 2; ++s2) {
                    u32x4 pw; pw.x = pk2(S[sub][8 * s2 + 0], S[sub][8 * s2 + 1]); pw.y = pk2(S[sub][8 * s2 + 2], S[sub][8 * s2 + 3]); pw.z = pk2(S[sub][8 * s2 + 4], S[sub][8 * s2 + 5]); pw.w = pk2(S[sub][8 * s2 + 6], S[sub][8 * s2 + 7]);
                    const bf16x8 pf = __builtin_bit_cast(bf16x8, pw);
                    const int kb2 = (sub * 2 + s2) * 32 + h * 16;
#pragma unroll
                    for (int dt = 0; dt < 4; ++dt) { const bf16x8 vf = *(const LAS bf16x8*)(Vl + (32 * dt + lq) * AT_VP + kb2);
                        O[dt] = __builtin_amdgcn_mfma_f32_32x32x16_bf16(vf, pf, O[dt], 0, 0, 0); }
                }
            }
            if (i + 1 < ntile) AT_STORE(buf ^ 1);
            __syncthreads();
        }
#undef AT_LOAD
#undef AT_STORE
        const float inv = 1.0f / (lsum + __shfl_xor(lsum, 32));
        bf16* op = ATT + (size_t)qrow * 1024 + head * 128 + 4 * h;
#pragma unroll
        for (int dt = 0; dt < 4; ++dt)
#pragma unroll
            for (int g = 0; g < 4; ++g) { u32x2 wv; wv.x = pk2(O[dt][4 * g] * inv, O[dt][4 * g + 1] * inv); wv.y = pk2(O[dt][4 * g + 2] * inv, O[dt][4 * g + 3] * inv); *(u32x2*)(op + 32 * dt + 8 * g) = wv; }
    }
}

constexpr int RG_UP = 272;
template <bool REV> __device__ __forceinline__ void rg_scan(const float (&a)[4][4], float (&bc)[4][4], float& H, int q, const int (&baddr)[4]) {
    float A4[4], B4[4];
#pragma unroll
    for (int tt = 0; tt < 4; ++tt) { float A = 1.f, B = 0.f;
#pragma unroll
        for (int ri = 0; ri < 4; ++ri) { const int r = REV ? 3 - ri : ri; B = a[tt][r] * B + bc[tt][r]; A *= a[tt][r]; }
        A4[tt] = A; B4[tt] = B; }
    float Ag[4][4], Bg[4][4];
#pragma unroll
    for (int tt = 0; tt < 4; ++tt)
#pragma unroll
        for (int qq = 0; qq < 4; ++qq) { Ag[tt][qq] = __builtin_bit_cast(float, __builtin_amdgcn_ds_bpermute(baddr[qq], __builtin_bit_cast(int, A4[tt]))); Bg[tt][qq] = __builtin_bit_cast(float, __builtin_amdgcn_ds_bpermute(baddr[qq], __builtin_bit_cast(int, B4[tt]))); }
    const int g0 = REV ? 3 : 0, g1 = REV ? 2 : 1, g2 = REV ? 1 : 2, g3 = REV ? 0 : 3;
    const int rank = REV ? 3 - q : q;
#pragma unroll
    for (int tti = 0; tti < 4; ++tti) { const int tt = REV ? 3 - tti : tti;
        const float A1 = Ag[tt][g1] * Ag[tt][g0], B1 = Ag[tt][g1] * Bg[tt][g0] + Bg[tt][g1];
        const float A2 = Ag[tt][g2] * A1, B2 = Ag[tt][g2] * B1 + Bg[tt][g2];
        const float A3 = Ag[tt][g3] * A2, B3 = Ag[tt][g3] * B2 + Bg[tt][g3];
        float myA = rank == 1 ? Ag[tt][g0] : 1.f, myB = rank == 1 ? Bg[tt][g0] : 0.f;
        myA = rank == 2 ? A1 : myA; myB = rank == 2 ? B1 : myB; myA = rank == 3 ? A2 : myA; myB = rank == 3 ? B2 : myB;
        float hc = myA * H + myB;
#pragma unroll
        for (int ri = 0; ri < 4; ++ri) { const int r = REV ? 3 - ri : ri; hc = a[tt][r] * hc + bc[tt][r]; bc[tt][r] = hc; }
        H = A3 * H + B3;
    }
}
__device__ __forceinline__ void phase_rglru(const Ctx& c0, int l) {
    const Ctx c = fresh(c0);
    const bool lastl = (l == DEPTH - 1);
    LAS unsigned char* UC = c.lds; LAS unsigned char* HS = c.lds + 2 * 64 * RG_UP;
    const bf16* U = (const bf16*)(c.ws + WS_U); const bf16* GZ = (const bf16*)(c.ws + WS_GZ); bf16* REC = (bf16*)(c.ws + WS_REC); const bf16* LW = (const bf16*)(c.ws + WS_LW);
    const int tid = c.tid, lane = c.lane, w = c.wave, dir = w >> 2, cg = w & 3, chl = lane & 15, q = lane >> 4;
    for (int item = c.bid; item < 256; item += c.G) {
        const int b = item >> 4, nb = (item >> 1) & 7, half = item & 1, cbase = nb * 128, oc = 16 * cg + chl, och = half * 64 + oc, col = cbase + och;
        bf16x8 wf[2][4];
#pragma unroll
        for (int g = 0; g < 2; ++g)
#pragma unroll
            for (int ks = 0; ks < 4; ++ks) wf[g][ks] = *(const bf16x8*)(LW + (size_t)(((dir * 8 + nb) * 2 + g) * 128 + och) * 128 + 32 * ks + 8 * q);
        const float ba = c.in[I_LBA][(l * 2 + dir) * D + col], bx = c.in[I_LBX][(l * 2 + dir) * D + col];
        const float Kc = -8.0f * log1pf(expf(-c.in[I_LAM][(l * 2 + dir) * D + col])) * 1.4426950408889634f;
        f32x2 cw[4][4], cbias[4];
        const int c8 = tid & 15, tg = (tid >> 4) & 15, dcv = tid >> 8;
        {
#pragma unroll
            for (int p = 0; p < 4; ++p) { cbias[p] = (f32x2){c.in[I_CONVB][l * D + cbase + 8 * c8 + 2 * p], c.in[I_CONVB][l * D + cbase + 8 * c8 + 2 * p + 1]};
#pragma unroll
                for (int k = 0; k < 4; ++k) cw[k][p] = (f32x2){c.in[I_CONVW][(l * 4 + k) * D + cbase + 8 * c8 + 2 * p], c.in[I_CONVW][(l * 4 + k) * D + cbase + 8 * c8 + 2 * p + 1]}; } }
        float H = 0.f;
        int baddr[4];
#pragma unroll
        for (int qq = 0; qq < 4; ++qq) baddr[qq] = (chl + 16 * qq) * 4;
        u32x4 uraw[7];
#define RG_ULOAD(s_) do { const int tau_ = dcv == 0 ? (s_) : ((s_) < 4 ? 3 - (s_) : 39 - (s_)); const bool isc_ = tau_ < 4; const int T_ = isc_ ? CTXL : SEQ, ts0_ = (isc_ ? tau_ : tau_ - 4) * 64 + 4 * tg - 2; \
            const bf16* up_ = U + (size_t)((isc_ ? NLAT + b * CTXL : b * SEQ) + ts0_) * D + cbase + 8 * c8; \
            _Pragma("unroll") for (int i_ = 0; i_ < 7; ++i_) uraw[i_] = (ts0_ + i_ >= 0 && ts0_ + i_ < T_) ? *(const u32x4*)(up_ + (size_t)i_ * D) : (u32x4){0u, 0u, 0u, 0u}; } while (0)
        RG_ULOAD(0);
        for (int s = 0; s < 36; ++s) {
#pragma unroll
            for (int tk = 0; tk < 4; ++tk) {
                u32x4 pw;
#pragma unroll
                for (int p = 0; p < 4; ++p) {
                    f32x2 o = cbias[p];
#pragma unroll
                    for (int k = 0; k < 4; ++k) o = cw[k][p] * (f32x2){bf_lo(uraw[tk + k][p]), bf_hi(uraw[tk + k][p])} + o;
                    pw[p] = pk2(o.x, o.y); }
                *(LAS u32x4*)(UC + (dcv * 64 + 4 * tg + tk) * RG_UP + c8 * 16) = pw;
            }
            __syncthreads();
            if (s + 1 < 36) RG_ULOAD(s + 1);
            u32x4 rvp[2], zvp[2];
#pragma unroll
            for (int dc = 0; dc < 2; ++dc) {
                const int t = tid >> 3, o8 = tid & 7;
                const int tau = dc == 0 ? s : (s < 4 ? 3 - s : 39 - s);
                const int other = dc == 0 ? (tau < 4 ? 3 - tau : 39 - tau) : tau;
                rvp[dc] = (u32x4){0u, 0u, 0u, 0u}; zvp[dc] = (u32x4){0u, 0u, 0u, 0u};
                if (other < s && !(lastl && tau < 4)) { const int row = (tau < 4 ? NLAT + b * CTXL + tau * 64 : b * SEQ + (tau - 4) * 64) + t; const size_t o = (size_t)row * D + cbase + half * 64 + o8 * 8;
                    rvp[dc] = *(const u32x4*)(REC + o); zvp[dc] = *(const u32x4*)(GZ + o); }
            }
            f32x4 gr[4], gi[4];
#pragma unroll
            for (int tt = 0; tt < 4; ++tt) { gr[tt] = (f32x4){0.f, 0.f, 0.f, 0.f}; gi[tt] = (f32x4){0.f, 0.f, 0.f, 0.f}; }
#pragma unroll
            for (int tt = 0; tt < 4; ++tt)
#pragma unroll
                for (int ks = 0; ks < 4; ++ks) { const bf16x8 af = *(const LAS bf16x8*)(UC + (dir * 64 + 16 * tt + chl) * RG_UP + (32 * ks + 8 * q) * 2);
                    gr[tt] = __builtin_amdgcn_mfma_f32_16x16x32_bf16(af, wf[0][ks], gr[tt], 0, 0, 0); gi[tt] = __builtin_amdgcn_mfma_f32_16x16x32_bf16(af, wf[1][ks], gi[tt], 0, 0, 0); }
            float av[4][4], bv[4][4];
            { const float L2E = 1.4426950408889634f; const f32x2 nba = (f32x2){-L2E * ba, -L2E * ba}, nbx = (f32x2){-L2E * bx, -L2E * bx};
#pragma unroll
              for (int tt = 0; tt < 4; ++tt)
#pragma unroll
                for (int rp = 0; rp < 2; ++rp) { const int tok = 16 * tt + 4 * q + 2 * rp;
                    const LAS unsigned char* up = UC + (dir * 64 + tok) * RG_UP + och * 2;
                    const f32x2 ucv = (f32x2){bf2f(*(const LAS bf16*)up), bf2f(*(const LAS bf16*)(up + RG_UP))};
                    const f32x2 xr = (f32x2){gr[tt][2 * rp], gr[tt][2 * rp + 1]} * (-L2E) + nba, xi = (f32x2){gi[tt][2 * rp], gi[tt][2 * rp + 1]} * (-L2E) + nbx;
                    f32x2 er = (f32x2){__builtin_amdgcn_exp2f(xr.x), __builtin_amdgcn_exp2f(xr.y)} + 1.0f, ei = (f32x2){__builtin_amdgcn_exp2f(xi.x), __builtin_amdgcn_exp2f(xi.y)} + 1.0f;
                    const f32x2 rr = (f32x2){__builtin_amdgcn_rcpf(er.x), __builtin_amdgcn_rcpf(er.y)}, ii = (f32x2){__builtin_amdgcn_rcpf(ei.x), __builtin_amdgcn_rcpf(ei.y)};
                    const f32x2 la = rr * Kc; const f32x2 a2 = (f32x2){__builtin_amdgcn_exp2f(la.x), __builtin_amdgcn_exp2f(la.y)};
                    f32x2 om = 1.0f - a2 * a2; om.x = fmaxf(om.x, 0.f); om.y = fmaxf(om.y, 0.f);
                    const f32x2 b2 = (f32x2){__builtin_amdgcn_sqrtf(om.x), __builtin_amdgcn_sqrtf(om.y)} * (ii * ucv);
                    av[tt][2 * rp] = a2.x; av[tt][2 * rp + 1] = a2.y; bv[tt][2 * rp] = b2.x; bv[tt][2 * rp + 1] = b2.y; } }
            if (dir) rg_scan<true>(av, bv, H, q, baddr); else rg_scan<false>(av, bv, H, q, baddr);
#pragma unroll
            for (int tt = 0; tt < 4; ++tt)
#pragma unroll
                for (int rp = 0; rp < 2; ++rp) { const unsigned w2 = pk2(bv[tt][2 * rp], bv[tt][2 * rp + 1]); LAS unsigned char* hp = HS + (dir * 64 + 16 * tt + 4 * q + 2 * rp) * 128 + oc * 2;
                    *(LAS bf16*)hp = (bf16)(w2 & 0xffffu); *(LAS bf16*)(hp + 128) = (bf16)(w2 >> 16); }
            __syncthreads();
#pragma unroll
            for (int dc = 0; dc < 2; ++dc) {
                const int t = tid >> 3, o8 = tid & 7;
                const int tau = dc == 0 ? s : (s < 4 ? 3 - s : 39 - s);
                const int other = dc == 0 ? (tau < 4 ? 3 - tau : 39 - tau) : tau; const bool second = other < s;
                if (lastl && tau < 4) continue;
                const int row = (tau < 4 ? NLAT + b * CTXL + tau * 64 : b * SEQ + (tau - 4) * 64) + t;
                const u32x4 hv = *(const LAS u32x4*)(HS + (dc * 64 + t) * 128 + o8 * 16);
                const size_t o = (size_t)row * D + cbase + half * 64 + o8 * 8;
                if (!second) *(u32x4*)(REC + o) = hv;
                else { const u32x4 rv = rvp[dc], zv = zvp[dc]; u32x4 ov;
#pragma unroll
                    for (int p = 0; p < 4; ++p) { const f32x2 y = ((f32x2){bf_lo(rv[p]), bf_hi(rv[p])} + (f32x2){bf_lo(hv[p]), bf_hi(hv[p])}) * (f32x2){bf_lo(zv[p]), bf_hi(zv[p])}; ov[p] = pk2(y.x, y.y); }
                    *(u32x4*)(REC + o) = ov; }
            }
        }
#undef RG_ULOAD
        __syncthreads();
    }
}

constexpr int PH_PER_LAYER = 10, NPH = 1 + DEPTH * PH_PER_LAYER + 1;
#ifndef PHASE_MASK
#define PHASE_MASK 0xFFFFu
#endif
#define PM(j) ((PHASE_MASK >> (j)) & 1u)
#ifndef PROBE_DOUBLE
#define PROBE_DOUBLE (-1)
#endif
#define REP(k) for (int rep_ = 0; rep_ < ((PROBE_DOUBLE == (k)) ? 2 : 1); ++rep_)
#define IN(k) (lo <= (k) && (k) < hi)
#define SEAM(k) do { if (IN(k) && IN((k) + 1)) xcd_barrier(bar); } while (0)
template <int l> __device__ __forceinline__ void run_layer(const Ctx& c, const XcdBarrier& bar, int lo, int hi) {
    LAS unsigned char* ring = c.lds;
        const int pb = 1 + l * PH_PER_LAYER; const bool last = (l == DEPTH - 1);
        const int nMrows = last ? 128 : 144, Me = last ? 4096 : 4608;
        const bool ovl = (l == 0 && c.G == 256 && lo <= pb + 3 && pb + 4 < hi);
        if (PM(1) && IN(pb + 0)) { if (l > 0 && !(c.G == 256 && IN(pb - 1))) { REP(1) phase_convert_weights(c, l); } phase_norm1(c, l); }
        SEAM(pb + 0);
        if (PM(2) && IN(pb + 1)) {
            REP(2) { ProbIn P; P.ws = c.ws; P.G = c.G; P.c = c.bid; P.nM = nMrows; P.nLat = nMrows * 13; P.nCtx = last ? 80 : 0; pg8::gemm_phase<ProbIn, true>(ring, P); }
            { ProbIn8 P; P.ws = c.ws; P.G = c.G; P.c = c.bid; P.nM = nMrows; P.bal = last && c.G == 256; pg8::gemm_phase<ProbIn8, true>(ring, P); }
            { ProbVt P; P.ws = c.ws; P.G = c.G; P.c = c.bid; P.bal = last && c.G == 256; pg8::gemm_phase<ProbVt, true>(ring, P); }
        }
        SEAM(pb + 1);
        if (PM(3) && IN(pb + 2)) {
            const int cgrp = c.bid % 6;
            if (cgrp == 0) phase_convert_moe(c, l);
            REP(3) phase_rglru(c, l); __syncthreads();
            if (cgrp == 1) phase_convert_moe(c, l);
            REP(4) {
            phase_attn(c, l, 0, 1); if (cgrp == 2) phase_convert_moe(c, l);
            phase_attn(c, l, 1, 2); if (cgrp == 3) phase_convert_moe(c, l);
            phase_attn(c, l, 2, 3); if (cgrp == 4) phase_convert_moe(c, l);
            phase_attn(c, l, 3, 8); if (cgrp == 5) phase_convert_moe(c, l);
            }
        }
        SEAM(pb + 2);
        if (PM(4) && IN(pb + 3)) REP(5) {
            if (ovl) {
                unsigned* hw = (unsigned*)(c.ws + WS_CTL) + 8192;
                { ProbMerge01 P; P.ws = c.ws; P.G = c.G; P.c = c.bid; P.nM = nMrows; P.pbeg = 0; P.pend = 2; pg8::gemm_phase<ProbMerge01, true>(ring, P); }
                pg8::handoff_signal(bar, hw);
                if (c.bid < 64) { ProbMerge01 P; P.ws = c.ws; P.G = c.G; P.c = c.bid; P.nM = nMrows; P.pbeg = 2; P.pend = 3; pg8::gemm_phase<ProbMerge01, true>(ring, P); }
                else { pg8::handoff_wait(bar, hw);
                    ProbMerge<2> P; P.ws = c.ws; P.G = c.G; P.c = c.bid; P.nM = nMrows; P.l = l; P.xin = c.in[I_X]; P.cin = c.in[I_CTX]; P.ubeg = c.bid - 64; P.ustride = 192; P.ucnt = 2; pg8::gemm_phase<ProbMerge<2>, true>(ring, P); }
            } else { ProbMerge01 P; P.ws = c.ws; P.G = c.G; P.c = c.bid; P.nM = nMrows; P.pbeg = 0; P.pend = 1 << 20; pg8::gemm_phase<ProbMerge01, true>(ring, P); }
        }
        SEAM(pb + 3);
        if (PM(5) && IN(pb + 4)) { ProbMerge<2> P; P.ws = c.ws; P.G = c.G; P.c = c.bid; P.nM = nMrows; P.l = l; P.xin = c.in[I_X]; P.cin = c.in[I_CTX]; P.ubeg = c.bid; P.ustride = c.G; P.ucnt = 1 << 20;
            if (ovl) { P.ustride = 0; P.ucnt = c.bid < 192 ? 1 : 0; P.ubeg = c.bid < 128 ? 384 + c.bid : 512 + (c.bid - 128); }
            pg8::gemm_phase<ProbMerge<2>, true>(ring, P); }
        SEAM(pb + 4);
        if (PM(6) && IN(pb + 5)) REP(6) phase_norm2(c, l);
        SEAM(pb + 5);
        if (PM(7) && IN(pb + 6)) REP(7) { phase_topk(c, l); __syncthreads(); }
        SEAM(pb + 6);
        if (PM(9) && IN(pb + 8)) REP(9) { ProbUp P; P.ws = c.ws; P.G = c.G; P.c = c.bid; P.Me = Me; P.l = l; pg8::gemm_phase<ProbUp, true>(ring, P); }
        SEAM(pb + 8);
        if (PM(10) && IN(pb + 9)) { REP(10) { ProbDown P; P.ws = c.ws; P.G = c.G; P.c = c.bid; P.Me = Me; P.l = l; pg8::gemm_phase<ProbDown, true>(ring, P); }
            if (!last && c.G == 256 && IN(pb + 10) && c.bid >= 128) { __syncthreads(); phase_convert_weights(c, l + 1, 128, 128); __syncthreads(); } }
        SEAM(pb + 9);
}
__global__ void __launch_bounds__(NTHR, 2) fwd(Args args) {
    extern __shared__ __attribute__((aligned(16))) unsigned char lds_raw[];
    Ctx c;
    c.in = args.in;
    c.out = args.out; c.ws = args.ws; c.lds = (LAS unsigned char*)lds_raw;
    c.tid = threadIdx.x; c.lane = c.tid & 63; c.wave = __builtin_amdgcn_readfirstlane(c.tid >> 6); c.G = gridDim.x; c.bid = blockIdx.x;
    volatile LAS unsigned* MISC = (volatile LAS unsigned*)(c.lds + MISC_OFF);
    if (c.tid < 4) MISC[c.tid] = 0u;
    __syncthreads();
    const int lo = args.ph_lo, hi = args.ph_hi;
    XcdBarrier bar; bar.bar = (unsigned*)(c.ws + WS_CTL) + 1024; bar.x = 0; bar.st = MISC;
    if (hi - lo > 1) bar = xcd_barrier_post((unsigned*)(c.ws + WS_CTL) + 1024, MISC);
    if (PM(0) && IN(0)) { REP(0) { phase_mod(c); __syncthreads(); phase_convert_weights(c, 0); } }
    SEAM(0);
    run_layer<0>(c, bar, lo, hi);
    run_layer<1>(c, bar, lo, hi);
    if (PM(11) && IN(NPH - 1)) phase_norm1(c, DEPTH);
#undef IN
#undef SEAM
}

extern "C" void kernel_launch(void* const* d_in, const int* in_sizes, int n_in, void* d_out, int out_size, void* d_ws, size_t ws_size, hipStream_t stream) {
    static int grid = 0;
    if (grid == 0) {
        if (n_in != 25 || in_sizes[0] != NLAT * D || out_size != NLAT * D || ws_size < WS_END) { fprintf(stderr, "kernel_launch: unexpected problem (n_in %d, in0 %d, out %d, ws %zu < %zu)\n", n_in, n_in > 0 ? in_sizes[0] : -1, out_size, ws_size, (size_t)WS_END); grid = -1; return; }
        int dev = 0, cus = 0, per_cu = 0;
        if (hipGetDevice(&dev) != hipSuccess || hipDeviceGetAttribute(&cus, hipDeviceAttributeMultiprocessorCount, dev) != hipSuccess) { grid = -1; return; }
        if (hipFuncSetAttribute((const void*)fwd, hipFuncAttributeMaxDynamicSharedMemorySize, LDS_BYTES) != hipSuccess) { fprintf(stderr, "kernel_launch: hipFuncSetAttribute failed\n"); grid = -1; return; }
        if (hipOccupancyMaxActiveBlocksPerMultiprocessor(&per_cu, (const void*)fwd, NTHR, LDS_BYTES) != hipSuccess || per_cu < 1) fprintf(stderr, "kernel_launch: occupancy query says %d\n", per_cu);
        (void)hipGetLastError();
        grid = cus;
        if (grid % 8 != 0) grid -= grid % 8;
    }
    if (grid < 0) return;
    (void)hipMemsetAsync((char*)d_ws + WS_CTL, 0, CTL_ZERO_BYTES, stream);
    Args a{};
    for (int i = 0; i < 25; ++i) a.in[i] = (const float*)d_in[i];
    a.out = (float*)d_out; a.ws = (unsigned char*)d_ws;
#if MK_PER_PHASE
    for (int p = 0; p < NPH; ++p) { a.ph_lo = p; a.ph_hi = p + 1; hipLaunchKernelGGL(fwd, dim3(grid), dim3(NTHR), LDS_BYTES, stream, a); }
#else
    a.ph_lo = 0; a.ph_hi = NPH; hipLaunchKernelGGL(fwd, dim3(grid), dim3(NTHR), LDS_BYTES, stream, a);
#endif
    const hipError_t le = hipPeekAtLastError();
    if (le != hipSuccess) fprintf(stderr, "kernel_launch: launch failed: %s\n", hipGetErrorName(le));
}
```

```cpp
#include <hip/hip_runtime.h>
#include <cstdio>
#include <cstdint>

#ifndef MK_PER_PHASE
#define MK_PER_PHASE 0
#endif

#define LAS __attribute__((address_space(3)))
#define GAS __attribute__((address_space(1)))
typedef unsigned short bf16;
typedef short bf16x8 __attribute__((ext_vector_type(8)));
typedef float f32x4 __attribute__((ext_vector_type(4)));
typedef float f32x2 __attribute__((ext_vector_type(2)));
typedef unsigned u32x4 __attribute__((ext_vector_type(4)));
typedef unsigned u32x2 __attribute__((ext_vector_type(2)));

constexpr int D = 1024, NB = 16, SEQ = 2048, CTXL = 256, DEPTH = 2;
constexpr int NLAT = NB * SEQ, NCTX = NB * CTXL, NROW = NLAT + NCTX;
constexpr int INW = 5632, NE = 16, DE = 2048, CAPL = 256, CAPC = 32, NMOD = 6;
constexpr float EPS = 1e-6f;
constexpr int NWAVES = 8, NTHR = 512;

constexpr size_t MiB = 1u << 20;
constexpr size_t WS_CTL = 0, CTL_ZERO_BYTES = 64 * 1024;
constexpr size_t WS_MOD = 1 * MiB;
constexpr size_t WS_COS = 2 * MiB;
constexpr size_t WS_SIN = 2 * MiB + 16384;
constexpr size_t WS_ROWIDX = 3 * MiB;
constexpr size_t WS_GVAL = 4 * MiB;
constexpr size_t WS_SLOT = 5 * MiB;
constexpr size_t WS_AFF = 8 * MiB;
constexpr size_t WS_WIN8 = 12 * MiB;
constexpr size_t WS_WIN = 16 * MiB;
constexpr size_t WS_WA = 27 * MiB, WS_WR = 29 * MiB, WS_WO = 31 * MiB;
__host__ __device__ constexpr size_t ws_wgu(int l) { return (33 + 64 * l) * MiB; }
__host__ __device__ constexpr size_t ws_wdn(int l) { return (161 + 32 * l) * MiB; }
constexpr size_t WS_LW = 225 * MiB;
constexpr size_t WS_X = 226 * MiB;
constexpr size_t WS_H8 = 298 * MiB;
constexpr size_t WS_H = 370 * MiB;
constexpr size_t WS_Q = 442 * MiB;
constexpr size_t WS_U = 514 * MiB;
constexpr size_t WS_T1 = 442 * MiB;
constexpr size_t WS_K = 586 * MiB;
constexpr size_t WS_VT = 604 * MiB;
constexpr size_t WS_GZ = 622 * MiB;
constexpr size_t WS_SMA = 694 * MiB, WS_SMR = 766 * MiB, WS_REC = 838 * MiB;
constexpr size_t WS_HID = 442 * MiB;
constexpr size_t WS_YE = 730 * MiB;
constexpr size_t WS_END = 910 * MiB;

constexpr int LDS_BYTES = 147456;
constexpr int RING_BYTES = 131072;
constexpr int MISC_OFF = LDS_BYTES - 16;

__device__ __forceinline__ unsigned f2bf(float f) { unsigned u = __builtin_bit_cast(unsigned, f); return (u + 0x7fffu + ((u >> 16) & 1u)) >> 16; }
__device__ __forceinline__ unsigned pk2(float lo, float hi) { unsigned r; asm volatile("v_cvt_pk_bf16_f32 %0, %1, %2" : "=v"(r) : "v"(lo), "v"(hi)); return r; }
__device__ __forceinline__ float bf_lo(unsigned w) { return __builtin_bit_cast(float, w << 16); }
__device__ __forceinline__ float bf_hi(unsigned w) { return __builtin_bit_cast(float, w & 0xffff0000u); }
__device__ __forceinline__ float bf2f(bf16 b) { return __builtin_bit_cast(float, ((unsigned)b) << 16); }
__device__ __forceinline__ u32x2 pk4(f32x4 v) { u32x2 w; w.x = pk2(v[0], v[1]); w.y = pk2(v[2], v[3]); return w; }
__device__ __forceinline__ f32x4 unpk4(u32x2 w) { return (f32x4){bf_lo(w.x), bf_hi(w.x), bf_lo(w.y), bf_hi(w.y)}; }
__device__ __forceinline__ unsigned f8x4(f32x4 v) { int w = 0; w = __builtin_amdgcn_cvt_pk_fp8_f32(v[0], v[1], w, false); w = __builtin_amdgcn_cvt_pk_fp8_f32(v[2], v[3], w, true); return (unsigned)w; }
__device__ __forceinline__ float wave_sum(float v) {
#pragma unroll
    for (int o = 1; o < 64; o <<= 1) v += __shfl_xor(v, o);
    return v;
}
__device__ __forceinline__ float wave_max(float v) {
#pragma unroll
    for (int o = 1; o < 64; o <<= 1) v = fmaxf(v, __shfl_xor(v, o));
    return v;
}
__device__ __forceinline__ float bsel(unsigned m, float a0, float a1) { return __builtin_bit_cast(float, (__builtin_bit_cast(unsigned, a1) & m) | (__builtin_bit_cast(unsigned, a0) & ~m)); }
__device__ __forceinline__ float sigmoidf_(float x) { return __builtin_amdgcn_rcpf(1.0f + __expf(-x)); }
__device__ __forceinline__ f32x2 sigmoid2(f32x2 x) { const f32x2 t = x * (-1.4426950408889634f); const f32x2 e = (f32x2){__builtin_amdgcn_exp2f(t.x), __builtin_amdgcn_exp2f(t.y)} + 1.0f; return (f32x2){__builtin_amdgcn_rcpf(e.x), __builtin_amdgcn_rcpf(e.y)}; }
__device__ __forceinline__ f32x2 gelu2(f32x2 z) { const f32x2 y = (z * z * 0.044715f + 1.0f) * z * (-1.5957691216057308f * 1.4426950408889634f); const f32x2 e = (f32x2){__builtin_amdgcn_exp2f(y.x), __builtin_amdgcn_exp2f(y.y)} + 1.0f; return z * (f32x2){__builtin_amdgcn_rcpf(e.x), __builtin_amdgcn_rcpf(e.y)}; }
__device__ __forceinline__ float gelu_tanh(float z) { const float y = 1.5957691216057308f * (z + 0.044715f * z * z * z); return z * __builtin_amdgcn_rcpf(1.0f + __expf(-y)); }

#define XB_TMO      128
#define XB_XCNT(j)  (256  + 64 * (j))
#define XB_XSUB(j)  (1280 + 64 * (j))
#define XB_XGEN(j)  (2304 + 64 * (j))
#define XB_TOP      3328
#define XB_TOPGEN   3392
#define XCD_BAR_WORDS 3456
#define XB_SPIN_CAP (1u << 18)
__device__ __forceinline__ unsigned xb_ld(unsigned* p)              { return __hip_atomic_load(p, __ATOMIC_RELAXED, __HIP_MEMORY_SCOPE_AGENT); }
__device__ __forceinline__ unsigned xb_add(unsigned* p, unsigned v) { return __hip_atomic_fetch_add(p, v, __ATOMIC_RELAXED, __HIP_MEMORY_SCOPE_AGENT); }
__device__ __forceinline__ unsigned xb_xcc_id() { return (unsigned)__builtin_amdgcn_s_getreg((3 << 11) | 20) & 0xFu; }
#define XB_SPIN(cond, bar) do { unsigned _sp = 0; while (cond) { __builtin_amdgcn_s_sleep(1); \
    if ((++_sp & 255u) == 0u) { if (xb_ld(&(bar)[XB_TMO])) break; if (_sp > XB_SPIN_CAP) { atomicAdd(&(bar)[XB_TMO], 1u); break; } } } } while (0)
struct XcdBarrier { unsigned* bar; unsigned x; volatile LAS unsigned* st; };
__device__ __forceinline__ XcdBarrier xcd_barrier_post(unsigned* bar, volatile LAS unsigned* st) {
    XcdBarrier b; b.bar = bar; b.x = xb_xcc_id(); b.st = st;
    if (threadIdx.x == 0) (void)xb_add(&bar[XB_XCNT(b.x)], 1u);
    return b;
}
__device__ __forceinline__ void xcd_barrier_complete(unsigned* bar, unsigned x, unsigned& nloc, unsigned& nx) {
    const unsigned G = gridDim.x * gridDim.y * gridDim.z;
    unsigned sum, cnt, mine, sp = 0u;
    for (;;) {
        sum = 0u; cnt = 0u; mine = 0u;
#pragma unroll
        for (unsigned j = 0; j < 16; ++j) { const unsigned c = xb_ld(&bar[XB_XCNT(j)]); sum += c; cnt += (c > 0u) ? 1u : 0u; mine = (j == x) ? c : mine; }
        if (sum == G) break;
        __builtin_amdgcn_s_sleep(1);
        if ((++sp & 255u) == 0u) { if (xb_ld(&bar[XB_TMO])) break; if (sp > XB_SPIN_CAP) { atomicAdd(&bar[XB_TMO], 1u); break; } }
    }
    nloc = mine > 0u ? mine : 1u; nx = cnt > 0u ? cnt : 1u;
}
__device__ __forceinline__ void xcd_barrier(const XcdBarrier& b) {
    asm volatile("s_waitcnt vmcnt(0)" ::: "memory");
    __syncthreads();
    if (threadIdx.x == 0) {
        unsigned* bar = b.bar;
        __builtin_amdgcn_s_waitcnt(0);
        unsigned nloc = b.st[0], nx = b.st[1];
        if (nloc == 0u) { xcd_barrier_complete(bar, b.x, nloc, nx); b.st[0] = nloc; b.st[1] = nx; }
        const unsigned old = xb_add(&bar[XB_XSUB(b.x)], 1u);
        const unsigned gen = old / nloc;
        if (old + 1u == (gen + 1u) * nloc) {
            __builtin_amdgcn_fence(__ATOMIC_RELEASE, "agent");
            asm volatile("s_waitcnt vmcnt(0)" ::: "memory");
            const unsigned og = xb_add(&bar[XB_TOP], 1u);
            const unsigned tg = og / nx;
            if (og + 1u == (tg + 1u) * nx) xb_add(&bar[XB_TOPGEN], 1u);
            else XB_SPIN(xb_ld(&bar[XB_TOPGEN]) == tg, bar);
            __builtin_amdgcn_fence(__ATOMIC_ACQUIRE, "agent");
            xb_add(&bar[XB_XGEN(b.x)], 1u);
            asm volatile("s_waitcnt vmcnt(0)" ::: "memory");
        } else {
            XB_SPIN(xb_ld(&bar[XB_XGEN(b.x)]) == gen, bar);
            __builtin_amdgcn_fence(__ATOMIC_ACQUIRE, "agent");
            asm volatile("s_waitcnt vmcnt(0)" ::: "memory");
        }
    }
    __syncthreads();
}

namespace pg8 {
constexpr int BM = 256, BK = 64, HALF = 128, HTB = HALF * BK * 2, STAGE_BYTES = 8 * HTB, NXCD = 8, WGM = 8;
__host__ __device__ __forceinline__ int lds_byte(int r, int c) { const int st = (r >> 4) * 2 + (c >> 5), rr = r & 15, cc = c & 31, ob = rr * 64 + cc * 2; return st * 1024 + (ob ^ (((ob >> 9) & 1) << 5)); }
__host__ __device__ __forceinline__ void stage_rc(int b, int& R, int& C) { const int st = b / 1024, sb = b % 1024, swz = sb ^ (((sb >> 9) & 1) << 5); R = (st >> 1) * 16 + swz / 64; C = (st & 1) * 32 + (swz % 64) / 2; }
struct Unit { int pm, pn, e; };
typedef int v8i __attribute__((ext_vector_type(8)));
typedef int v4i __attribute__((ext_vector_type(4)));
#define HF_XSUB(j) (64 * (j))
#define HF_TOP     1024
__device__ __forceinline__ void handoff_signal(const XcdBarrier& b, unsigned* hw) {
    asm volatile("s_waitcnt vmcnt(0)" ::: "memory");
    __syncthreads();
    if (threadIdx.x == 0) {
        const unsigned nloc = b.st[0];
        const unsigned old = xb_add(&hw[HF_XSUB(b.x)], 1u);
        if (old + 1u == nloc) { __builtin_amdgcn_fence(__ATOMIC_RELEASE, "agent"); asm volatile("s_waitcnt vmcnt(0)" ::: "memory"); (void)xb_add(&hw[HF_TOP], 1u); }
    }
}
__device__ __forceinline__ void handoff_wait(const XcdBarrier& b, unsigned* hw) {
    if (threadIdx.x == 0) {
        const unsigned nx = b.st[1]; unsigned* bar = b.bar;
        XB_SPIN(xb_ld(&hw[HF_TOP]) < nx, bar);
        __builtin_amdgcn_fence(__ATOMIC_ACQUIRE, "agent");
        asm volatile("s_waitcnt vmcnt(0)" ::: "memory");
    }
    __syncthreads();
}
__device__ __forceinline__ void glds16_s(const char* gbase, unsigned voff, unsigned lds_dst) {
    unsigned keep;
    asm volatile("s_mov_b32 %0, m0\n\ts_mov_b32 m0, %3\n\ts_nop 0\n\tglobal_load_lds_dwordx4 %1, %2\n\ts_mov_b32 m0, %0" : "=&s"(keep) : "v"(voff), "s"(gbase), "s"(lds_dst) : "memory");
}
__device__ __forceinline__ void glds4_s(const void* gbase, unsigned voff, unsigned lds_dst) {
    unsigned keep;
    asm volatile("s_mov_b32 %0, m0\n\ts_mov_b32 m0, %3\n\ts_nop 0\n\tglobal_load_lds_dword %1, %2\n\ts_mov_b32 m0, %0" : "=&s"(keep) : "v"(voff), "s"(gbase), "s"(lds_dst) : "memory");
}
__device__ __forceinline__ v8i cat8(bf16x8 a, bf16x8 b) { const u32x4 x = __builtin_bit_cast(u32x4, a), y = __builtin_bit_cast(u32x4, b); return (v8i){(int)x.x, (int)x.y, (int)x.z, (int)x.w, (int)y.x, (int)y.y, (int)y.z, (int)y.w}; }
__device__ __forceinline__ void static_map(int L, int nM, int nN, int& pm, int& pn) {
    const int nwg = nM * nN; int wgid = L;
    { const int q = nwg / NXCD, r = nwg % NXCD, xcd = wgid % NXCD, off = wgid / NXCD; wgid = (xcd < r ? xcd * (q + 1) : r * (q + 1) + (xcd - r) * q) + off; }
    const int nig = WGM * nN, gid = wgid / nig, fm = gid * WGM, gsz = (nM - fm) < WGM ? (nM - fm) : WGM;
    pm = fm + ((wgid % nig) % gsz); pn = (wgid % nig) / gsz;
}
template <class Prob, bool ALIGN_EPI>
__device__ __forceinline__ void gemm_phase(LAS unsigned char* lds, const Prob& P) {
    constexpr int KB = Prob::KB, nt = KB / (BK * 2);
    int tid_ = threadIdx.x; asm volatile("" : "+v"(tid_));
    const int tid = tid_, wid = __builtin_amdgcn_readfirstlane(tid >> 6), lane = tid & 63, wr = wid >> 2, wc = wid & 3, fr = lane & 15, fq = lane >> 4;
    unsigned voffA[2];
#pragma unroll
    for (int i = 0; i < 2; ++i) { int R, C; stage_rc(tid * 16 + i * 8192, R, C); voffA[i] = (unsigned)(R * KB + C * 2); }
    unsigned gcur[2][2];
#define PG8_GLOAD(dst, u_) do { if constexpr (Prob::GATHER) { const int* ri_ = P.rowidx(u_); _Pragma("unroll") for (int h_ = 0; h_ < 2; ++h_) _Pragma("unroll") for (int i_ = 0; i_ < 2; ++i_) { int R_, C_; stage_rc(tid * 16 + i_ * 8192, R_, C_); \
        dst[h_][i_] = (unsigned)ri_[h_ * HALF + R_] * (unsigned)KB + (unsigned)(C_ * 2); } } } while (0)
    const size_t kstep = (size_t)(BK * 2);
    const size_t hstep = (size_t)HALF * KB;
    const unsigned gmail = (unsigned)(unsigned long long)lds + (unsigned)STAGE_BYTES + (unsigned)wid * 1024u;
    const unsigned ldsb = (unsigned)(unsigned long long)lds + (unsigned)wid * 1024u;
    const int aoff = lds_byte(wr * 64 + fr, fq * 8), boff = lds_byte(wc * 32 + fr, fq * 8);
#define PG8_SA(b, h) (((b) * 2 + (h)) * HTB)
#define PG8_SB(b, h) ((4 + (b) * 2 + (h)) * HTB)
#define PG8_STAGE(bufoff, gbase, voff) do { _Pragma("unroll") for (int _i = 0; _i < 2; ++_i) glds16_s((gbase), (voff)[_i], ldsb + (unsigned)((bufoff) + _i * 8192)); } while (0)
#define PG8_STAGE_A(bufoff, kbase_, h_, nx_) do { if constexpr (Prob::GATHER) { _Pragma("unroll") for (int _i = 0; _i < 2; ++_i) glds16_s((kbase_), gcur[h_][_i], ldsb + (unsigned)((bufoff) + _i * 8192)); } \
        else PG8_STAGE(bufoff, (kbase_) + (h_) * hstep, voffA); } while (0)
#define PG8_LD8(p_) __builtin_shufflevector(*(const LAS v4i*)(p_), *(const LAS v4i*)((p_) + 1024), 0, 1, 2, 3, 4, 5, 6, 7)
#define PG8_LDA(dst, b, h) do { _Pragma("unroll") for (int m = 0; m < 4; ++m) dst[m] = PG8_LD8(lds + PG8_SA(b, h) + aoff + m * 2048); } while (0)
#define PG8_LDB(dst, b, h) do { _Pragma("unroll") for (int n = 0; n < 2; ++n) dst[n] = PG8_LD8(lds + PG8_SB(b, h) + boff + n * 2048); } while (0)
#define PG8_LO(v_) __builtin_bit_cast(bf16x8, __builtin_shufflevector(v_, v_, 0, 1, 2, 3))
#define PG8_HI(v_) __builtin_bit_cast(bf16x8, __builtin_shufflevector(v_, v_, 4, 5, 6, 7))
#define PG8_MMA(ai, bj, At, Bt) do { __builtin_amdgcn_s_setprio(1); _Pragma("unroll") for (int m = 0; m < 4; ++m) _Pragma("unroll") for (int n = 0; n < 2; ++n) { \
        if constexpr (Prob::FP8) { acc[ai][bj][m][n] = __builtin_amdgcn_mfma_scale_f32_16x16x128_f8f6f4(Bt[n], At[m], acc[ai][bj][m][n], 0, 0, 0, 0x7F7F7F7F, 0, 0x7F7F7F7F); } \
        else { acc[ai][bj][m][n] = __builtin_amdgcn_mfma_f32_16x16x32_bf16(PG8_LO(Bt[n]), PG8_LO(At[m]), acc[ai][bj][m][n], 0, 0, 0); \
               acc[ai][bj][m][n] = __builtin_amdgcn_mfma_f32_16x16x32_bf16(PG8_HI(Bt[n]), PG8_HI(At[m]), acc[ai][bj][m][n], 0, 0, 0); } } __builtin_amdgcn_s_setprio(0); } while (0)
#define PG8_WAIT_V(n) asm volatile("s_waitcnt vmcnt(" #n ")" ::: "memory")
#define PG8_WAIT_L(n) asm volatile("s_waitcnt lgkmcnt(" #n ")" ::: "memory")
#define PG8_BAR __builtin_amdgcn_s_barrier()
#define PG8_SCHED __builtin_amdgcn_sched_barrier(0)
    Unit cur, nxt; int ui = 0;
    if (!P.next(0, cur)) return;
    f32x4 acc[2][2][4][2];
#pragma unroll
    for (int a = 0; a < 2; ++a)
#pragma unroll
        for (int b = 0; b < 2; ++b)
#pragma unroll
            for (int m = 0; m < 4; ++m)
#pragma unroll
                for (int n = 0; n < 2; ++n) acc[a][b][m][n] = (f32x4){0.f, 0.f, 0.f, 0.f};
    v8i At[4], B0[2], B1[2];
    const char* cA = P.aptr(cur); const char* cB = P.bptr(cur);
    PG8_GLOAD(gcur, cur);
    PG8_STAGE(PG8_SB(0, 0), cB, voffA); PG8_STAGE(PG8_SB(0, 1), cB + hstep, voffA); PG8_STAGE_A(PG8_SA(0, 0), cA, 0, false); PG8_STAGE_A(PG8_SA(0, 1), cA, 1, false);
    if (wr == 1) PG8_BAR;
    PG8_WAIT_V(2); PG8_BAR;
    PG8_STAGE(PG8_SB(1, 0), cB + kstep, voffA); PG8_STAGE_A(PG8_SA(1, 0), cA + kstep, 0, false); PG8_STAGE(PG8_SB(1, 1), cB + hstep + kstep, voffA);
    PG8_WAIT_V(6); PG8_BAR;
    for (;;) {
        const bool has_next = P.next(ui + 1, nxt);
        const char* nA = has_next ? P.aptr(nxt) : cA; const char* nB = has_next ? P.bptr(nxt) : cB;
        if constexpr (Prob::GATHER) { if (has_next) {
            const int* ri_ = P.rowidx(nxt);
#pragma unroll
            for (int h_ = 0; h_ < 2; ++h_)
#pragma unroll
                for (int i_ = 0; i_ < 2; ++i_) { int R_, C_; stage_rc(tid * 16 + i_ * 8192, R_, C_); glds4_s(ri_, (unsigned)((h_ * HALF + R_) * 4), gmail + (unsigned)((2 * h_ + i_) * 256)); } } }
#pragma nounroll
        for (int t = 0; t < nt; t += 2) {
            const bool last = (t == nt - 2);
            const char* a1 = cA + (size_t)(t + 1) * kstep;
            const char* a2 = last ? nA : cA + (size_t)(t + 2) * kstep; const char* b2 = last ? nB : cB + (size_t)(t + 2) * kstep;
            const char* a3 = a2 + kstep; const char* b3 = b2 + kstep;
            const bool nx = last && has_next;
            PG8_STAGE_A(PG8_SA(1, 1), a1, 1, false); PG8_SCHED; PG8_LDB(B0, 0, 0); PG8_LDB(B1, 0, 1); PG8_SCHED; PG8_LDA(At, 0, 0);
            if constexpr (Prob::GATHER) { if (nx) {
#pragma unroll
                for (int h_ = 0; h_ < 2; ++h_)
#pragma unroll
                    for (int i_ = 0; i_ < 2; ++i_) { int R_, C_; stage_rc(tid * 16 + i_ * 8192, R_, C_);
                        gcur[h_][i_] = *(volatile LAS unsigned*)(lds + STAGE_BYTES + wid * 1024 + (2 * h_ + i_) * 256 + lane * 4) * (unsigned)KB + (unsigned)(C_ * 2); } } }
            PG8_WAIT_V(8); PG8_WAIT_L(0); PG8_BAR; PG8_MMA(0, 0, At, B0); PG8_MMA(0, 1, At, B1); PG8_BAR; PG8_SCHED;
            PG8_STAGE(PG8_SB(0, 0), b2, voffA); PG8_STAGE(PG8_SB(0, 1), b2 + hstep, voffA); PG8_STAGE_A(PG8_SA(0, 0), a2, 0, nx); PG8_SCHED; PG8_LDA(At, 0, 1);
            PG8_WAIT_V(8); PG8_WAIT_L(0); PG8_BAR; PG8_MMA(1, 0, At, B0); PG8_MMA(1, 1, At, B1); PG8_BAR; PG8_SCHED;
            PG8_STAGE_A(PG8_SA(0, 1), a2, 1, nx); PG8_SCHED; PG8_LDB(B0, 1, 0); PG8_LDB(B1, 1, 1); PG8_SCHED; PG8_LDA(At, 1, 0);
            PG8_WAIT_V(8); PG8_WAIT_L(0); PG8_BAR; PG8_MMA(0, 0, At, B0); PG8_MMA(0, 1, At, B1); PG8_BAR; PG8_SCHED;
            PG8_STAGE(PG8_SB(1, 0), b3, voffA); PG8_STAGE(PG8_SB(1, 1), b3 + hstep, voffA); PG8_STAGE_A(PG8_SA(1, 0), a3, 0, nx); PG8_SCHED; PG8_LDA(At, 1, 1);
            PG8_WAIT_V(8); PG8_WAIT_L(0); PG8_BAR; PG8_MMA(1, 0, At, B0); PG8_MMA(1, 1, At, B1); PG8_BAR; PG8_SCHED;
        }
        if constexpr (ALIGN_EPI) { if (wr == 0) PG8_BAR; }
        bool keep = false;
        { int fr_ = fr, fq_ = fq; asm volatile("" : "+v"(fr_), "+v"(fq_));
          if constexpr (Prob::FUSED2) keep = P.epi2(acc, cur, wr, wc, fr_, fq_); else P.epi(acc, cur, wr, wc, fr_, fq_); }
        if (!has_next) break;
        if (!keep) {
#pragma unroll
        for (int a = 0; a < 2; ++a)
#pragma unroll
            for (int b = 0; b < 2; ++b)
#pragma unroll
                for (int m = 0; m < 4; ++m)
#pragma unroll
                    for (int n = 0; n < 2; ++n) acc[a][b][m][n] = (f32x4){0.f, 0.f, 0.f, 0.f};
        }
        cur = nxt; cA = nA; cB = nB; ++ui;
        if constexpr (ALIGN_EPI) { if (wr == 1) PG8_BAR; }
    }
    PG8_WAIT_V(0);
    if constexpr (!ALIGN_EPI) { if (wr == 0) PG8_BAR; }
    PG8_BAR;
#undef PG8_SA
#undef PG8_SB
#undef PG8_STAGE
#undef PG8_STAGE_A
#undef PG8_GLOAD
#undef PG8_LDA
#undef PG8_LDB
#undef PG8_LD8
#undef PG8_LO
#undef PG8_HI
#undef PG8_MMA
#undef PG8_WAIT_V
#undef PG8_WAIT_L
#undef PG8_BAR
#undef PG8_SCHED
}
}
using pg8::Unit;

struct Args { const float* in[25]; float* out; unsigned char* ws; int ph_lo, ph_hi; };
struct Ctx {
    const float* const* in; float* out; unsigned char* ws;
    LAS unsigned char* lds; int tid, lane, wave, G, bid;
};
__device__ __forceinline__ Ctx fresh(const Ctx& c0) {
    Ctx c = c0; int t = threadIdx.x; asm volatile("" : "+v"(t)); c.tid = t; c.lane = t & 63; c.wave = __builtin_amdgcn_readfirstlane(t >> 6); return c;
}
enum { I_X = 0, I_C, I_CTX, I_CCTX, I_ADAW, I_ADAB, I_NMG, I_WIN, I_SINK, I_CONVW, I_CONVB, I_LWA, I_LBA, I_LWX, I_LBX, I_LAM, I_WABR, I_WRBR, I_WOUT, I_NFG, I_WROUTER, I_WGATE, I_WUP, I_WDOWN, I_FNG };

#define EPI_LOOP_ROWS _Pragma("unroll") for (int ai = 0; ai < 2; ++ai) _Pragma("unroll") for (int m = 0; m < 4; ++m)

__host__ __device__ __forceinline__ int ropedim(int s) { const int wc = s >> 5, n = (s >> 4) & 1, fq = (s >> 2) & 3, i = s & 3, p = 16 * wc + 4 * fq + i; return 64 * (p >> 5) + (p & 31) + 32 * n; }

#define FENCE() asm volatile("" ::: "memory")
constexpr float W8_SCALE = 64.0f, W8_INV = 1.0f / 64.0f, YE_SCALE = 16.0f, YE_INV = 1.0f / 16.0f;
struct ProbIn {
    static constexpr int K = 1024, KB = 2048; static constexpr bool FP8 = false, GATHER = false, FUSED2 = false;
    unsigned char* ws; int G, c, nM, nLat, nCtx;
    __device__ __forceinline__ bool next(int i, Unit& u) const {
        long L = (long)i * G + c; u.e = 0;
        if (L < nLat) { int pm, pn; pg8::static_map((int)L, nM, 13, pm, pn); u.pm = pm; u.pn = pn < 5 ? pn : pn + 1; return true; }
        L -= nLat; if (L >= nCtx) return false;
        u.pm = 128 + (int)(L % 16); const int idx = (int)(L / 16); u.pn = idx == 0 ? 4 : 5 + idx; return true;
    }
    __device__ __forceinline__ const char* aptr(const Unit& u) const { return (const char*)(ws + WS_H) + (size_t)u.pm * 256 * K * 2; }
    __device__ __forceinline__ const char* bptr(const Unit& u) const { return (const char*)(ws + WS_WIN) + (size_t)u.pn * 256 * K * 2; }
    __device__ __forceinline__ void epi(const f32x4 (&acc)[2][2][4][2], const Unit& u, int wr, int wc, int fr, int fq) const {
        const int pn = u.pn; const int row0 = u.pm * 256 + wr * 64 + fr, lc = wc * 32 + 4 * fq;
        if (pn <= 4) {
            bf16* base = (bf16*)(ws + (pn < 4 ? WS_Q : WS_K)); const int ldc = pn < 4 ? 1024 : 256, cb = (pn < 4 ? pn * 256 : 0) + lc;
            const bool lat = u.pm < 128; const int i0 = 16 * (wc & 1) + 4 * fq;
            const float* COS = (const float*)(ws + WS_COS); const float* SIN = (const float*)(ws + WS_SIN);
            EPI_LOOP_ROWS {
                const int row = row0 + ai * 128 + m * 16;
                f32x4 cs = (f32x4){1.f, 1.f, 1.f, 1.f}, sn = (f32x4){0.f, 0.f, 0.f, 0.f};
                if (lat) { const int t = row & 2047, pos = wc < 2 ? (t >> 6) : (t & 63); cs = *(const f32x4*)(COS + pos * 32 + i0); sn = *(const f32x4*)(SIN + pos * 32 + i0); }
#pragma unroll
                for (int bj = 0; bj < 2; ++bj) {
                    const f32x4 x1 = acc[ai][bj][m][0], x2 = acc[ai][bj][m][1];
                    const f32x4 o1 = x1 * cs - x2 * sn, o2 = x1 * sn + x2 * cs;
                    bf16* p = base + (size_t)row * ldc + cb + bj * 128;
                    *(u32x2*)p = pk4(o1); *(u32x2*)(p + 16) = pk4(o2);
                }
                FENCE();
            }
        } else {
            size_t off; int cb; int mode;
            if (pn <= 9) { off = WS_U; cb = (pn - 6) * 256; mode = 0; }
            else { off = WS_GZ; cb = (pn - 10) * 256; mode = 1; }
            bf16* base = (bf16*)(ws + off);
            cb += wc * 64 + 16 * fq;
            EPI_LOOP_ROWS {
                const int row = row0 + ai * 128 + m * 16;
#pragma unroll
                for (int bj = 0; bj < 2; ++bj) { f32x4 v0 = acc[ai][bj][m][0], v1 = acc[ai][bj][m][1];
                    if (mode == 1) { const f32x2 a = gelu2((f32x2){v0[0], v0[1]}), b = gelu2((f32x2){v0[2], v0[3]}), c2 = gelu2((f32x2){v1[0], v1[1]}), d = gelu2((f32x2){v1[2], v1[3]}); v0 = (f32x4){a.x, a.y, b.x, b.y}; v1 = (f32x4){c2.x, c2.y, d.x, d.y}; }
                    const u32x2 a = pk4(v0), b = pk4(v1);
                    *(u32x4*)(base + (size_t)row * 1024 + cb + bj * 8) = (u32x4){a.x, a.y, b.x, b.y}; }
                FENCE();
            }
        }
    }
};
struct ProbIn8 {
    static constexpr int KB = 1024; static constexpr bool FP8 = true, GATHER = false, FUSED2 = false;
    unsigned char* ws; int G, c, nM; bool bal;
    __device__ __forceinline__ bool next(int i, Unit& u) const { long L = (long)i * G + c;
        if (bal) { if (i >= 3) { if (c < 96 || i > 4 || (i == 4 && c >= 192)) return false; L = (i == 3 ? 768 : 928) + (c - 96); } }
        if (L >= nM * 8) return false; int pm, pn; pg8::static_map((int)L, nM, 8, pm, pn); u.pm = pm; u.pn = pn; u.e = 0; return true; }
    __device__ __forceinline__ const char* aptr(const Unit& u) const { return (const char*)(ws + WS_H8) + (size_t)u.pm * 256 * KB; }
    __device__ __forceinline__ const char* bptr(const Unit& u) const { return (const char*)(ws + WS_WIN8) + (size_t)u.pn * 256 * KB; }
    __device__ __forceinline__ void epi(const f32x4 (&acc)[2][2][4][2], const Unit& u, int wr, int wc, int fr, int fq) const {
        const int row0 = u.pm * 256 + wr * 64 + fr; const int cb = (u.pn & 3) * 256 + wc * 64 + 16 * fq;
        bf16* base = (bf16*)(ws + (u.pn < 4 ? WS_SMA : WS_SMR));
        EPI_LOOP_ROWS {
            const int row = row0 + ai * 128 + m * 16;
#pragma unroll
            for (int bj = 0; bj < 2; ++bj) { const f32x4 v0 = acc[ai][bj][m][0] * W8_INV, v1 = acc[ai][bj][m][1] * W8_INV;
                const f32x2 a = sigmoid2((f32x2){v0[0], v0[1]}), b = sigmoid2((f32x2){v0[2], v0[3]}), c2 = sigmoid2((f32x2){v1[0], v1[1]}), d = sigmoid2((f32x2){v1[2], v1[3]});
                const u32x2 p = pk4((f32x4){a.x, a.y, b.x, b.y}), q = pk4((f32x4){c2.x, c2.y, d.x, d.y});
                *(u32x4*)(base + (size_t)row * 1024 + cb + bj * 8) = (u32x4){p.x, p.y, q.x, q.y}; }
            FENCE();
        }
    }
};
struct ProbVt {
    static constexpr int K = 1024, KB = 2048; static constexpr bool FP8 = false, GATHER = false, FUSED2 = false;
    unsigned char* ws; int G, c; bool bal;
    __device__ __forceinline__ bool next(int i, Unit& u) const { int L = i * G + (G - 1 - c); if (bal) L = i > 0 ? 144 : (c >= 208 ? c - 208 : (c < 96 ? 48 + c : 144)); if (L >= 144) return false; u.pm = 0; u.pn = L; u.e = 0; return true; }
    __device__ __forceinline__ const char* aptr(const Unit&) const { return (const char*)(ws + WS_WIN) + (size_t)1280 * 1024 * 2; }
    __device__ __forceinline__ const char* bptr(const Unit& u) const { return (const char*)(ws + WS_H) + (size_t)u.pn * 256 * K * 2; }
    __device__ __forceinline__ void epi(const f32x4 (&acc)[2][2][4][2], const Unit& u, int wr, int wc, int fr, int fq) const {
        const int row0 = wr * 64 + fr, cb = u.pn * 256 + wc * 32 + 4 * fq; bf16* Vt = (bf16*)(ws + WS_VT);
        EPI_LOOP_ROWS { const int row = row0 + ai * 128 + m * 16;
#pragma unroll
            for (int bj = 0; bj < 2; ++bj)
#pragma unroll
                for (int n = 0; n < 2; ++n) *(u32x2*)(Vt + (size_t)row * NROW + cb + bj * 128 + n * 16) = pk4(acc[ai][bj][m][n]); }
    }
};
template <int MODE> struct ProbMerge {
    static constexpr int K = 1024, KB = 2048; static constexpr bool FP8 = false, GATHER = false, FUSED2 = false;
    unsigned char* ws; int G, c, nM, l; const float* xin; const float* cin;
    int ubeg, ustride, ucnt;
    __device__ __forceinline__ bool next(int i, Unit& u) const { if (i >= ucnt) return false; const int L = ubeg + i * ustride; if (L >= nM * 4) return false;
        int pm, pn; if (L < 512) pg8::static_map(L, 128, 4, pm, pn); else { pm = 128 + ((L - 512) & 15); pn = (L - 512) >> 4; } u.pm = pm; u.pn = pn; u.e = 0; return true; }
    __device__ __forceinline__ const char* aptr(const Unit& u) const { return (const char*)(ws + (MODE == 0 ? WS_H : MODE == 1 ? WS_REC : WS_GZ)) + (size_t)u.pm * 256 * K * 2; }
    __device__ __forceinline__ const char* bptr(const Unit& u) const { return (const char*)(ws + (MODE == 0 ? WS_WA : MODE == 1 ? WS_WR : WS_WO)) + (size_t)u.pn * 256 * K * 2; }
    __device__ __forceinline__ void epi(const f32x4 (&acc)[2][2][4][2], const Unit& u, int wr, int wc, int fr, int fq) const {
        const int row0 = u.pm * 256 + wr * 64 + fr, cb = u.pn * 256 + wc * 64 + 16 * fq;
        const int r = u.pm < 128 ? (u.pm >> 3) : 16;
        const bf16* S = (const bf16*)(ws + (MODE == 0 ? WS_SMA : WS_SMR)); bf16* T1 = (bf16*)(ws + WS_T1); bf16* MRG = (bf16*)(ws + WS_GZ); bf16* X = (bf16*)(ws + WS_X);
        const float* gate = (const float*)(ws + WS_MOD) + (size_t)(l * 17 + r) * 6144 + 2048;
        const float* RB = (u.pm < 128 ? xin : cin - (size_t)NLAT * D);
        u32x4 svn[2], tvn[2]; f32x4 rbn[2][2];
#define MG_LOAD(g_) do { const int row_ = row0 + ((g_) >> 2) * 128 + ((g_) & 3) * 16; _Pragma("unroll") for (int bj_ = 0; bj_ < 2; ++bj_) { const size_t o_ = (size_t)row_ * 1024 + cb + bj_ * 8; \
            if (MODE != 2) svn[bj_] = *(const u32x4*)(S + o_); if (MODE == 1) tvn[bj_] = *(const u32x4*)(T1 + o_); \
            if (MODE == 2) { if (l == 0) { rbn[bj_][0] = *(const f32x4*)(RB + o_); rbn[bj_][1] = *(const f32x4*)(RB + o_ + 4); } \
                             else { const u32x4 xb_ = *(const u32x4*)(X + o_); rbn[bj_][0] = unpk4((u32x2){xb_.x, xb_.y}); rbn[bj_][1] = unpk4((u32x2){xb_.z, xb_.w}); } } } } while (0)
        f32x4 gt[2][2];
        if (MODE == 2) {
#pragma unroll
            for (int bj = 0; bj < 2; ++bj) { gt[bj][0] = *(const f32x4*)(gate + cb + bj * 8); gt[bj][1] = *(const f32x4*)(gate + cb + bj * 8 + 4); } }
        MG_LOAD(0);
#pragma unroll
        for (int g = 0; g < 8; ++g) { const int ai = g >> 2, m = g & 3; const int row = row0 + ai * 128 + m * 16;
            u32x4 sv[2], tv[2]; f32x4 rb[2][2];
#pragma unroll
            for (int bj = 0; bj < 2; ++bj) { sv[bj] = svn[bj]; tv[bj] = tvn[bj]; rb[bj][0] = rbn[bj][0]; rb[bj][1] = rbn[bj][1]; }
            if (g + 1 < 8) MG_LOAD(g + 1);
#pragma unroll
            for (int bj = 0; bj < 2; ++bj) {
                const size_t o = (size_t)row * 1024 + cb + bj * 8; const f32x4 a0 = acc[ai][bj][m][0], a1 = acc[ai][bj][m][1];
                if (MODE == 0) { const u32x2 p = pk4(a0 * unpk4((u32x2){sv[bj].x, sv[bj].y})), q = pk4(a1 * unpk4((u32x2){sv[bj].z, sv[bj].w})); *(u32x4*)(T1 + o) = (u32x4){p.x, p.y, q.x, q.y}; }
                else if (MODE == 1) { const u32x2 p = pk4(unpk4((u32x2){tv[bj].x, tv[bj].y}) + a0 * unpk4((u32x2){sv[bj].x, sv[bj].y})), q = pk4(unpk4((u32x2){tv[bj].z, tv[bj].w}) + a1 * unpk4((u32x2){sv[bj].z, sv[bj].w})); *(u32x4*)(MRG + o) = (u32x4){p.x, p.y, q.x, q.y}; }
                else { const u32x2 p = pk4(rb[bj][0] + gt[bj][0] * a0), q = pk4(rb[bj][1] + gt[bj][1] * a1); *(u32x4*)(X + o) = (u32x4){p.x, p.y, q.x, q.y}; }
            }
            FENCE();
        }
#undef MG_LOAD
    }
};
struct ProbMerge01 {
    static constexpr int K = 1024, KB = 2048; static constexpr bool FP8 = false, GATHER = false, FUSED2 = true;
    unsigned char* ws; int G, c, nM, pbeg, pend;
    __device__ __forceinline__ bool next(int i, Unit& u) const { const int p = pbeg + (i >> 1); if (p >= pend) return false; const int L = p * G + c; if (L >= nM * 4) return false;
        int pm, pn; if (L < 512) pg8::static_map(L, 128, 4, pm, pn); else { pm = 128 + ((L - 512) & 15); pn = (L - 512) >> 4; } u.pm = pm; u.pn = pn; u.e = i & 1; return true; }
    __device__ __forceinline__ const char* aptr(const Unit& u) const { return (const char*)(ws + (u.e == 0 ? WS_H : WS_REC)) + (size_t)u.pm * 256 * K * 2; }
    __device__ __forceinline__ const char* bptr(const Unit& u) const { return (const char*)(ws + (u.e == 0 ? WS_WA : WS_WR)) + (size_t)u.pn * 256 * K * 2; }
    static __device__ __forceinline__ f32x4 clampsr(u32x2 w) { const f32x4 v = unpk4(w); return (f32x4){__builtin_fmaxf(v[0], 1e-18f), __builtin_fmaxf(v[1], 1e-18f), __builtin_fmaxf(v[2], 1e-18f), __builtin_fmaxf(v[3], 1e-18f)}; }
    __device__ __forceinline__ bool epi2(f32x4 (&acc)[2][2][4][2], const Unit& u, int wr, int wc, int fr, int fq) const {
        const int row0 = u.pm * 256 + wr * 64 + fr, cb = u.pn * 256 + wc * 64 + 16 * fq;
        const bf16* SA = (const bf16*)(ws + WS_SMA); const bf16* SR = (const bf16*)(ws + WS_SMR); bf16* MRG = (bf16*)(ws + WS_GZ);
        const bool first = (u.e == 0);
        u32x4 san[2], srn[2];
#define MG_LOAD(g_) do { const int row_ = row0 + ((g_) >> 2) * 128 + ((g_) & 3) * 16; _Pragma("unroll") for (int bj_ = 0; bj_ < 2; ++bj_) { const size_t o_ = (size_t)row_ * 1024 + cb + bj_ * 8; \
            srn[bj_] = *(const u32x4*)(SR + o_); if (first) san[bj_] = *(const u32x4*)(SA + o_); } } while (0)
        MG_LOAD(0);
#pragma unroll
        for (int g = 0; g < 8; ++g) { const int ai = g >> 2, m = g & 3; const int row = row0 + ai * 128 + m * 16;
            u32x4 sa[2], sr[2];
#pragma unroll
            for (int bj = 0; bj < 2; ++bj) { sa[bj] = san[bj]; sr[bj] = srn[bj]; }
            if (g + 1 < 8) MG_LOAD(g + 1);
#pragma unroll
            for (int bj = 0; bj < 2; ++bj) {
                const f32x4 r0 = clampsr((u32x2){sr[bj].x, sr[bj].y}), r1 = clampsr((u32x2){sr[bj].z, sr[bj].w});
                if (first) {
                    const f32x4 q0 = (f32x4){__builtin_amdgcn_rcpf(r0[0]), __builtin_amdgcn_rcpf(r0[1]), __builtin_amdgcn_rcpf(r0[2]), __builtin_amdgcn_rcpf(r0[3])};
                    const f32x4 q1 = (f32x4){__builtin_amdgcn_rcpf(r1[0]), __builtin_amdgcn_rcpf(r1[1]), __builtin_amdgcn_rcpf(r1[2]), __builtin_amdgcn_rcpf(r1[3])};
                    acc[ai][bj][m][0] = acc[ai][bj][m][0] * (unpk4((u32x2){sa[bj].x, sa[bj].y}) * q0);
                    acc[ai][bj][m][1] = acc[ai][bj][m][1] * (unpk4((u32x2){sa[bj].z, sa[bj].w}) * q1);
                } else {
                    const u32x2 p = pk4(acc[ai][bj][m][0] * r0), q = pk4(acc[ai][bj][m][1] * r1);
                    *(u32x4*)(MRG + (size_t)row * 1024 + cb + bj * 8) = (u32x4){p.x, p.y, q.x, q.y};
                }
            }
            FENCE();
        }
#undef MG_LOAD
        return first;
    }
};
__device__ __forceinline__ bool grouped_next(int i, int G, int c, int nPM, int nPN, Unit& u) {
    const int nloc = G / 8, x = c & 7, loc = c >> 3; const int per = nPM * nPN; const long L = (long)i * nloc + loc;
    if (L >= 2 * per) return false;
    u.e = 2 * x + (int)(L / per); const int rem = (int)(L % per);
    const int nig = 8 * nPN, gid = rem / nig, fm = gid * 8, gsz = (nPM - fm) < 8 ? (nPM - fm) : 8;
    u.pm = fm + ((rem % nig) % gsz); u.pn = (rem % nig) / gsz; return true;
}
struct ProbUp {
    static constexpr int KB = 1024; static constexpr bool FP8 = true, GATHER = true, FUSED2 = false;
    unsigned char* ws; int G, c, Me, l;
    __device__ __forceinline__ bool next(int i, Unit& u) const { return grouped_next(i, G, c, Me / 256, 16, u); }
    __device__ __forceinline__ const char* aptr(const Unit&) const { return (const char*)(ws + WS_H); }
    __device__ __forceinline__ const int* rowidx(const Unit& u) const { return (const int*)(ws + WS_ROWIDX) + (size_t)u.e * Me + (size_t)u.pm * 256; }
    __device__ __forceinline__ const char* bptr(const Unit& u) const { return (const char*)(ws + ws_wgu(l)) + ((size_t)u.e * 4096 + (size_t)u.pn * 256) * KB; }
    __device__ __forceinline__ void epi(const f32x4 (&acc)[2][2][4][2], const Unit& u, int wr, int wc, int fr, int fq) const {
        const size_t row0 = (size_t)u.e * Me + u.pm * 256 + wr * 64 + fr; const int cb = u.pn * 128 + wc * 32 + 8 * fq; unsigned char* HID = ws + WS_HID;
        EPI_LOOP_ROWS { const size_t row = row0 + ai * 128 + m * 16; u32x2 wv;
#pragma unroll
            for (int bj = 0; bj < 2; ++bj) { const f32x4 g = acc[ai][bj][m][0] * W8_INV, up = acc[ai][bj][m][1] * W8_INV; f32x4 h;
#pragma unroll
                for (int i = 0; i < 4; i += 2) { const f32x2 g2 = (f32x2){g[i], g[i + 1]}, hh = g2 * sigmoid2(g2) * (f32x2){up[i], up[i + 1]}; h[i] = hh.x; h[i + 1] = hh.y; }
                int w = 0; w = __builtin_amdgcn_cvt_pk_fp8_f32(h[0], h[1], w, false); w = __builtin_amdgcn_cvt_pk_fp8_f32(h[2], h[3], w, true);
                if (bj == 0) wv.x = (unsigned)w; else wv.y = (unsigned)w; }
            *(u32x2*)(HID + row * 2048 + cb) = wv; }
    }
};
struct ProbDown {
    static constexpr int KB = 2048; static constexpr bool FP8 = true, GATHER = false, FUSED2 = false;
    unsigned char* ws; int G, c, Me, l;
    __device__ __forceinline__ bool next(int i, Unit& u) const { return grouped_next(i, G, c, Me / 256, 4, u); }
    __device__ __forceinline__ const char* aptr(const Unit& u) const { return (const char*)(ws + WS_HID) + ((size_t)u.e * Me + (size_t)u.pm * 256) * KB; }
    __device__ __forceinline__ const char* bptr(const Unit& u) const { return (const char*)(ws + ws_wdn(l)) + ((size_t)u.e * 1024 + (size_t)u.pn * 256) * KB; }
    __device__ __forceinline__ void epi(const f32x4 (&acc)[2][2][4][2], const Unit& u, int wr, int wc, int fr, int fq) const {
        const size_t row0 = (size_t)u.e * Me + u.pm * 256 + wr * 64 + fr; const int cb = u.pn * 256 + wc * 64 + 16 * fq; unsigned char* YE = ws + WS_YE; const float* GV = (const float*)(ws + WS_GVAL);
        float gv[8];
#pragma unroll
        for (int g8 = 0; g8 < 8; ++g8) gv[g8] = GV[row0 + (g8 >> 2) * 128 + (g8 & 3) * 16];
        EPI_LOOP_ROWS { const size_t row = row0 + ai * 128 + m * 16; const float g = gv[ai * 4 + m] * (W8_INV * YE_SCALE); u32x4 wv;
#pragma unroll
            for (int bj = 0; bj < 2; ++bj)
#pragma unroll
                for (int n = 0; n < 2; ++n) { const f32x4 v = acc[ai][bj][m][n] * g; int w = 0; w = __builtin_amdgcn_cvt_pk_fp8_f32(v[0], v[1], w, false); w = __builtin_amdgcn_cvt_pk_fp8_f32(v[2], v[3], w, true); wv[2 * bj + n] = (unsigned)w; }
            *(u32x4*)(YE + row * 1024 + cb) = wv; }
    }
};

template <class ColPtr>
__device__ __forceinline__ void tr_item(const ColPtr& cp, int K, bf16* WT, int item, int nblk, LAS float* scr, int lane) {
    const int kb = item / nblk, nb = item % nblk, k0 = 64 * kb, n0 = 32 * nb;
    size_t stride; const float* src = cp(n0 + (lane & 31), stride) + (size_t)k0 * stride;
    float tv[32];
#pragma unroll
    for (int i = 0; i < 32; ++i) tv[i] = src[(size_t)(2 * i + (lane >> 5)) * stride];
#pragma unroll
    for (int i = 0; i < 32; ++i) scr[(2 * i + (lane >> 5)) * 33 + (lane & 31)] = tv[i];
    asm volatile("s_waitcnt lgkmcnt(0)" ::: "memory");
    const int c = lane & 7;
#pragma unroll
    for (int j = 0; j < 4; ++j) { const int n = (lane >> 3) + 8 * j; const LAS float* s = scr + (8 * c) * 33 + n;
        u32x4 o; o.x = pk2(s[0 * 33], s[1 * 33]); o.y = pk2(s[2 * 33], s[3 * 33]); o.z = pk2(s[4 * 33], s[5 * 33]); o.w = pk2(s[6 * 33], s[7 * 33]);
        *(u32x4*)(WT + (size_t)(n0 + n) * K + k0 + 8 * c) = o; }
    asm volatile("s_waitcnt lgkmcnt(0)" ::: "memory");
}
template <class ColPtr>
__device__ __forceinline__ void tr_item8(const ColPtr& cp, int K, unsigned char* WT, int item, int nblk, LAS float* scr, int lane, float scale) {
    const int kb = item / nblk, nb = item % nblk, k0 = 128 * kb, n0 = 32 * nb;
    size_t stride; const float* src = cp(n0 + (lane & 31), stride) + (size_t)k0 * stride;
    const float* rp = src + (size_t)(lane >> 5) * stride;
#pragma unroll
    for (int hb = 0; hb < 2; ++hb) { float tv[32];
#pragma unroll
        for (int i = 0; i < 32; ++i) { tv[i] = *rp; rp += 2 * stride; }
#pragma unroll
        for (int i = 0; i < 32; ++i) scr[(64 * hb + 2 * i + (lane >> 5)) * 33 + (lane & 31)] = tv[i];
        asm volatile("" ::: "memory"); }
    asm volatile("s_waitcnt lgkmcnt(0)" ::: "memory");
    const int c = lane & 7;
#pragma unroll
    for (int j = 0; j < 4; ++j) { const int n = (lane >> 3) + 8 * j; const LAS float* s = scr + (16 * c) * 33 + n; u32x4 o;
#pragma unroll
        for (int q = 0; q < 4; ++q) { int w = 0; w = __builtin_amdgcn_cvt_pk_fp8_f32(s[(4 * q) * 33] * scale, s[(4 * q + 1) * 33] * scale, w, false); w = __builtin_amdgcn_cvt_pk_fp8_f32(s[(4 * q + 2) * 33] * scale, s[(4 * q + 3) * 33] * scale, w, true); o[q] = (unsigned)w; }
        *(u32x4*)(WT + (size_t)(n0 + n) * K + k0 + 16 * c) = o; asm volatile("" ::: "memory"); }
    asm volatile("s_waitcnt lgkmcnt(0)" ::: "memory");
}
__host__ __device__ __forceinline__ int sig16(int s) { return 64 * ((s >> 5) & 3) + 16 * ((s >> 2) & 3) + 8 * (s >> 7) + 4 * ((s >> 4) & 1) + (s & 3); }
struct ColIn { const float* W; __device__ __forceinline__ const float* operator()(int n, size_t& stride) const { stride = INW; int col = n; if (n < 1280) col = (n & ~127) + ropedim(n & 127); else if (n >= 1536) col = (n & ~255) + sig16(n & 255); return W + col; } };
struct ColIn8 { const float* W; __device__ __forceinline__ const float* operator()(int n, size_t& stride) const { stride = INW; return W + 3584 + (n & ~255) + sig16(n & 255); } };
struct ColPlain { const float* W; int N; __device__ __forceinline__ const float* operator()(int n, size_t& stride) const { stride = (size_t)N; return W + n; } };
struct ColP16 { const float* W; int N; __device__ __forceinline__ const float* operator()(int n, size_t& stride) const { stride = (size_t)N; return W + (n & ~255) + sig16(n & 255); } };
struct ColGU { const float* Wg; const float* Wu; __device__ __forceinline__ const float* operator()(int n, size_t& stride) const { stride = DE;
    const int hc = 128 * (n >> 8) + 32 * ((n >> 5) & 3) + 8 * ((n >> 2) & 3) + 4 * ((n >> 7) & 1) + (n & 3);
    const unsigned long long d = (unsigned long long)Wu - (unsigned long long)Wg; return (const float*)((unsigned long long)Wg + (((n >> 4) & 1) ? d : 0ull)) + hc; } };

constexpr int CT_P = 257;
__device__ __forceinline__ void convert_moe_tiles(const Ctx& c, int l, int wg_first = 0, int wg_count = 0) {
    LAS float* T = (LAS float*)c.lds;
    constexpr int T_GU = NE * 8 * 16, T_DN = NE * 16 * 4;
    const int nwg_ = wg_count ? wg_count : c.G;
    for (int tile = c.bid - wg_first; tile < T_GU + T_DN; tile += nwg_) {
        const bool gu = tile < T_GU; const int tt = gu ? tile : tile - T_GU;
        const int e = gu ? tt >> 7 : tt >> 6, kt = gu ? (tt >> 4) & 7 : (tt >> 2) & 15, pn = gu ? tt & 15 : tt & 3;
        const int K = gu ? D : DE, N = gu ? DE : D, k0 = 128 * kt;
        const float* W0 = gu ? c.in[I_WGATE] + ((size_t)l * NE + e) * D * DE : c.in[I_WDOWN] + ((size_t)l * NE + e) * DE * D;
        const float* W1 = gu ? c.in[I_WUP] + ((size_t)l * NE + e) * D * DE : W0;
        f32x4 ld[16];
#pragma unroll
        for (int i = 0; i < 16; ++i) { const int g = c.tid + 512 * i, k = g >> 6, c4 = g & 63;
            const float* src = gu ? ((c4 < 32 ? W0 : W1) + (size_t)(k0 + k) * N + 128 * pn + 4 * (c4 & 31)) : (W0 + (size_t)(k0 + k) * N + 256 * pn + 4 * c4);
            ld[i] = *(const f32x4*)src; }
#pragma unroll
        for (int i = 0; i < 16; ++i) { const int g = c.tid + 512 * i, k = g >> 6, c4 = g & 63; LAS float* t = T + k * CT_P + 4 * c4; t[0] = ld[i][0]; t[1] = ld[i][1]; t[2] = ld[i][2]; t[3] = ld[i][3]; }
        __syncthreads();
        unsigned char* WT = gu ? c.ws + ws_wgu(l) + ((size_t)e * 4096 + 256 * pn) * D : c.ws + ws_wdn(l) + ((size_t)e * 1024 + 256 * pn) * DE;
#pragma unroll
        for (int j = 0; j < 4; ++j) { const int q = c.tid + 512 * j, n = q >> 3, ch = q & 7;
            const int sc = gu ? 128 * ((n >> 4) & 1) + 32 * ((n >> 5) & 3) + 8 * ((n >> 2) & 3) + 4 * (n >> 7) + (n & 3) : sig16(n);
            const LAS float* t = T + (16 * ch) * CT_P + sc; u32x4 o;
#pragma unroll
            for (int w4 = 0; w4 < 4; ++w4) { int w = 0; w = __builtin_amdgcn_cvt_pk_fp8_f32(t[(4 * w4) * CT_P] * W8_SCALE, t[(4 * w4 + 1) * CT_P] * W8_SCALE, w, false); w = __builtin_amdgcn_cvt_pk_fp8_f32(t[(4 * w4 + 2) * CT_P] * W8_SCALE, t[(4 * w4 + 3) * CT_P] * W8_SCALE, w, true); o[w4] = (unsigned)w; }
            *(u32x4*)(WT + (size_t)n * K + k0 + 16 * ch) = o; }
        __syncthreads();
    }
}
__device__ __forceinline__ void phase_convert_weights(const Ctx& c0, int l, int wg_first = 0, int wg_count = 0) {
    const Ctx c = fresh(c0);
    LAS float* scr = (LAS float*)(c.lds + c.wave * 17408);
    const int gw = (c.bid - wg_first) * NWAVES + c.wave, NGW = (wg_count ? wg_count : c.G) * NWAVES;
    constexpr int I_IN = 16 * 112, I_IN8 = 8 * 64, I_SQ = 16 * 32;
    constexpr int I_LW = 32 * 8;
    constexpr int NITEMS = I_IN + I_IN8 + 3 * I_SQ + I_LW;
    for (int it = gw; it < NITEMS; it += NGW) {
        int r = it;
        if (r < I_IN) { ColIn cp{c.in[I_WIN] + (size_t)l * D * INW}; tr_item(cp, D, (bf16*)(c.ws + WS_WIN), r, 112, scr, c.lane); continue; } r -= I_IN;
        if (r < I_IN8) { ColIn8 cp{c.in[I_WIN] + (size_t)l * D * INW}; tr_item8(cp, D, c.ws + WS_WIN8, r, 64, scr, c.lane, W8_SCALE); continue; } r -= I_IN8;
        if (r < I_SQ) { ColP16 cp{c.in[I_WABR] + (size_t)l * D * D, D}; tr_item(cp, D, (bf16*)(c.ws + WS_WA), r, 32, scr, c.lane); continue; } r -= I_SQ;
        if (r < I_SQ) { ColP16 cp{c.in[I_WRBR] + (size_t)l * D * D, D}; tr_item(cp, D, (bf16*)(c.ws + WS_WR), r, 32, scr, c.lane); continue; } r -= I_SQ;
        if (r < I_SQ) { ColP16 cp{c.in[I_WOUT] + (size_t)l * D * D, D}; tr_item(cp, D, (bf16*)(c.ws + WS_WO), r, 32, scr, c.lane); continue; } r -= I_SQ;
        { const int mat = r >> 3, g = mat & 1, dn = mat >> 1;
          ColPlain cp{c.in[g ? I_LWX : I_LWA] + ((size_t)l * 16 + dn) * 16384, 128}; tr_item(cp, 128, (bf16*)(c.ws + WS_LW) + (size_t)mat * 16384, r & 7, 4, scr, c.lane); }
    }
}
__device__ __forceinline__ void phase_convert_moe(const Ctx& c0, int l, int wg_first = 0, int wg_count = 0) { const Ctx c = fresh(c0); __syncthreads(); convert_moe_tiles(c, l, wg_first, wg_count); __syncthreads(); }
__device__ __forceinline__ void phase_mod(const Ctx& c0) {
    const Ctx c = fresh(c0);
    LAS float* sc = (LAS float*)c.lds; LAS float* red = (LAS float*)(c.lds + 17 * 1024 * 4);
    for (int i = c.tid; i < 17 * 1024; i += NTHR) { const int r = i >> 10, k = i & 1023; const float v = r < 16 ? c.in[I_C][r * 1024 + k] : c.in[I_CCTX][k]; sc[i] = v / (1.0f + expf(-v)); }
    __syncthreads();
    float* MOD = (float*)(c.ws + WS_MOD);
    for (int item = c.bid; item < 2 * 96; item += c.G) {
        const int l = item / 96, n0 = (item % 96) * 64;
        const float* w = c.in[I_ADAW] + (size_t)l * D * 6144 + n0 + c.lane;
        float acc[17];
#pragma unroll
        for (int r = 0; r < 17; ++r) acc[r] = 0.f;
        const int k0 = c.wave * 128;
        for (int kb = 0; kb < 128; kb += 32) {
            float wv[32];
#pragma unroll
            for (int k = 0; k < 32; ++k) wv[k] = w[(size_t)(k0 + kb + k) * 6144];
#pragma unroll
            for (int k = 0; k < 32; ++k) {
#pragma unroll
                for (int r = 0; r < 17; ++r) acc[r] += sc[r * 1024 + k0 + kb + k] * wv[k]; }
        }
#pragma unroll
        for (int r = 0; r < 17; ++r) red[(c.wave * 17 + r) * 64 + c.lane] = acc[r];
        __syncthreads();
        for (int i = c.tid; i < 17 * 64; i += NTHR) { const int r = i >> 6, ln = i & 63; float s = 0.f;
#pragma unroll
            for (int w8 = 0; w8 < 8; ++w8) s += red[(w8 * 17 + r) * 64 + ln];
            MOD[(size_t)(l * 17 + r) * 6144 + n0 + ln] = s + c.in[I_ADAB][l * 6144 + n0 + ln]; }
        __syncthreads();
    }
    float* COS = (float*)(c.ws + WS_COS); float* SIN = (float*)(c.ws + WS_SIN);
    for (int i = c.bid * NTHR + c.tid; i < 64 * 32; i += c.G * NTHR) { const int pos = i >> 5, k = i & 31; const float fr = powf(10000.0f, -(float)k / 32.0f), ang = (float)pos * fr; COS[i] = cosf(ang); SIN[i] = sinf(ang); }
}

__device__ __forceinline__ void phase_norm1(const Ctx& c0, int l) {
    const Ctx c = fresh(c0);
    const bool fin = (l == DEPTH);
    const int gw = c.bid * NWAVES + c.wave, NGW = c.G * NWAVES, nrows = fin ? NLAT : NROW;
    const float* MOD = (const float*)(c.ws + WS_MOD); bf16* X = (bf16*)(c.ws + WS_X); bf16* H = (bf16*)(c.ws + WS_H);
    const short* SLOT = (const short*)(c.ws + WS_SLOT); const unsigned char* YE = c.ws + WS_YE;
    int cur_r = -1; f32x4 al[4], be[4];
    if (l == 0) {
        const f32x4* g = (const f32x4*)(c.in[I_NMG]);
        const int npair = NROW / 2, ppw = (npair + NGW - 1) / NGW, pbeg = gw * ppw, pend = (pbeg + ppw < npair) ? pbeg + ppw : npair;
        for (int rp = pbeg; rp < pend; ++rp) {
            f32x4 v[2][4];
#pragma unroll
            for (int k = 0; k < 2; ++k) { const int row = 2 * rp + k; const f32x4* src = (const f32x4*)(row < NLAT ? c.in[I_X] + (size_t)row * D : c.in[I_CTX] + (size_t)(row - NLAT) * D);
#pragma unroll
                for (int j = 0; j < 4; ++j) v[k][j] = src[c.lane + 64 * j]; }
            { const int row = 2 * rp, r = row < NLAT ? (row >> 11) : 16;
              if (r != cur_r) { cur_r = r; const float* mp = MOD + (size_t)r * 6144; const f32x4* sh = (const f32x4*)mp; const f32x4* scl = (const f32x4*)(mp + 1024);
#pragma unroll
                  for (int j = 0; j < 4; ++j) { const int q = c.lane + 64 * j; al[j] = g[q] * (scl[q] + 1.0f); be[j] = sh[q]; } } }
#pragma unroll
            for (int k = 0; k < 2; ++k) { const int row = 2 * rp + k; float ss = 0.f;
#pragma unroll
                for (int j = 0; j < 4; ++j) ss += (v[k][j][0] * v[k][j][0] + v[k][j][1] * v[k][j][1]) + (v[k][j][2] * v[k][j][2] + v[k][j][3] * v[k][j][3]);
                const float rstd = 1.0f / sqrtf(wave_sum(ss) * (1.0f / D) + EPS);
                u32x2* o = (u32x2*)(H + (size_t)row * D); unsigned* o8 = (unsigned*)(c.ws + WS_H8 + (size_t)row * D);
#pragma unroll
                for (int j = 0; j < 4; ++j) { const f32x4 hv = v[k][j] * rstd * al[j] + be[j]; o[c.lane + 64 * j] = pk4(hv); o8[c.lane + 64 * j] = f8x4(hv); } }
        }
        return;
    }
    const int MeP = (l - 1 == DEPTH - 1) ? 4096 : 4608;
    const int rpw = (nrows + NGW - 1) / NGW, rbeg = gw * rpw, rend = (rbeg + rpw < nrows) ? rbeg + rpw : nrows;
    f32x4 vn[4], g2v[4]; int slotn = -1;
    if (rbeg < rend) { const u32x2* src = (const u32x2*)(X + (size_t)rbeg * D);
#pragma unroll
        for (int j = 0; j < 4; ++j) vn[j] = unpk4(src[c.lane + 64 * j]);
        slotn = (int)SLOT[(size_t)rbeg * 16 + (c.lane & 15)]; }
    for (int row = rbeg; row < rend; ++row) {
        const int r = row < NLAT ? (row >> 11) : 16;
        f32x4 v[4];
#pragma unroll
        for (int j = 0; j < 4; ++j) v[j] = vn[j];
        const int myslot = slotn;
        { const int nr = row + 1; if (nr < rend) { const u32x2* src = (const u32x2*)(X + (size_t)nr * D);
#pragma unroll
            for (int j = 0; j < 4; ++j) vn[j] = unpk4(src[c.lane + 64 * j]);
            slotn = (int)SLOT[(size_t)nr * 16 + (c.lane & 15)]; } }
        if (r != cur_r) { cur_r = r; const f32x4* g2 = (const f32x4*)(MOD + (size_t)((l - 1) * 17 + r) * 6144 + 5120);
#pragma unroll
            for (int j = 0; j < 4; ++j) g2v[j] = g2[c.lane + 64 * j] * YE_INV;
            if (!fin) { const f32x4* g = (const f32x4*)(c.in[I_NMG] + l * D); const float* mp = MOD + (size_t)(l * 17 + r) * 6144; const f32x4* sh = (const f32x4*)mp; const f32x4* scl = (const f32x4*)(mp + 1024);
#pragma unroll
                for (int j = 0; j < 4; ++j) { const int q = c.lane + 64 * j; al[j] = g[q] * (scl[q] + 1.0f); be[j] = sh[q]; } }
            else { const f32x4* g = (const f32x4*)c.in[I_FNG];
#pragma unroll
                for (int j = 0; j < 4; ++j) al[j] = g[c.lane + 64 * j]; } }
        f32x4 a[4];
#pragma unroll
        for (int j = 0; j < 4; ++j) a[j] = (f32x4){0.f, 0.f, 0.f, 0.f};
        const int ybase = row < NLAT ? (row >> 11) * CAPL : 4096 + ((row - NLAT) >> 8) * CAPC;
        unsigned long long sel = __builtin_amdgcn_ballot_w64(myslot >= 0) & 0xFFFFull;
        while (sel) {
            const int e0 = __builtin_ctzll(sel); sel &= sel - 1; const bool two = sel != 0; const int e1 = two ? __builtin_ctzll(sel) : e0; if (two) sel &= sel - 1;
            const int s0 = __builtin_amdgcn_readlane(myslot, e0), s1 = __builtin_amdgcn_readlane(myslot, e1);
            const int* y0 = (const int*)(YE + ((size_t)e0 * MeP + ybase + s0) * D); const int* y1 = (const int*)(YE + ((size_t)e1 * MeP + ybase + s1) * D);
            int w0[4], w1[4];
#pragma unroll
            for (int j = 0; j < 4; ++j) { w0[j] = y0[c.lane + 64 * j]; w1[j] = y1[c.lane + 64 * j]; }
            const float k1 = two ? 1.0f : 0.0f;
#pragma unroll
            for (int j = 0; j < 4; ++j) { const f32x2 lo0 = __builtin_amdgcn_cvt_pk_f32_fp8(w0[j], false), hi0 = __builtin_amdgcn_cvt_pk_f32_fp8(w0[j], true), lo1 = __builtin_amdgcn_cvt_pk_f32_fp8(w1[j], false), hi1 = __builtin_amdgcn_cvt_pk_f32_fp8(w1[j], true);
                a[j] += (f32x4){lo0.x, lo0.y, hi0.x, hi0.y} + (f32x4){lo1.x, lo1.y, hi1.x, hi1.y} * k1; }
        }
#pragma unroll
        for (int j = 0; j < 4; ++j) v[j] += g2v[j] * a[j];
        if (!fin) { u32x2* dst = (u32x2*)(X + (size_t)row * D);
#pragma unroll
            for (int j = 0; j < 4; ++j) dst[c.lane + 64 * j] = pk4(v[j]); }
        float ss = 0.f;
#pragma unroll
        for (int j = 0; j < 4; ++j) ss += (v[j][0] * v[j][0] + v[j][1] * v[j][1]) + (v[j][2] * v[j][2] + v[j][3] * v[j][3]);
        const float rstd = 1.0f / sqrtf(wave_sum(ss) * (1.0f / D) + EPS);
        if (fin) { f32x4* o = (f32x4*)(c.out + (size_t)row * D);
#pragma unroll
            for (int j = 0; j < 4; ++j) o[c.lane + 64 * j] = v[j] * rstd * al[j];
        } else { u32x2* o = (u32x2*)(H + (size_t)row * D); unsigned* o8 = (unsigned*)(c.ws + WS_H8 + (size_t)row * D);
#pragma unroll
            for (int j = 0; j < 4; ++j) { const f32x4 hv = v[j] * rstd * al[j] + be[j]; o[c.lane + 64 * j] = pk4(hv); o8[c.lane + 64 * j] = f8x4(hv); } }
    }
}
constexpr int F1_P = 1028;
__device__ __forceinline__ void phase_norm2(const Ctx& c0, int l) {
    const Ctx c = fresh(c0);
    LAS float* T = (LAS float*)c.lds;
    LAS float* PART = T + 16 * F1_P;
    LAS float* RS = PART + 8 * 256;
    LAS float* CP = RS + 16;
    const int nrows = (l == DEPTH - 1) ? NLAT : NROW, ntile = nrows / 16;
    const int tpw = (ntile + c.G - 1) / c.G, tbeg = c.bid * tpw, tend = (tbeg + tpw < ntile) ? tbeg + tpw : ntile;
    const float* MOD = (const float*)(c.ws + WS_MOD); const bf16* X = (const bf16*)(c.ws + WS_X); unsigned char* H = c.ws + WS_H; float* AFF = (float*)(c.ws + WS_AFF);
    const float* WR = c.in[I_WROUTER] + (size_t)l * 16384; const float* GF = c.in[I_NFG] + l * D;
    const int tid = c.tid, lane = c.lane, w = c.wave, e16 = lane & 15, kk = lane >> 4;
    u32x4 ld[4];
#define F1_LOAD(t_, tq_) do { const u32x4* src_ = (const u32x4*)(X + (size_t)(t_) * 16 * D) + (tq_); _Pragma("unroll") for (int i_ = 0; i_ < 4; ++i_) ld[i_] = src_[512 * i_]; } while (0)
    if (tbeg < tend) F1_LOAD(tbeg, tid);
    float Breg[32]; float creg = 0.f; int cur_r = -1;
    for (int t = tbeg; t < tend; ++t) {
        int tq = tid; asm volatile("" : "+v"(tq));
        const int row0 = t * 16, r = row0 < NLAT ? (row0 >> 11) : 16;
#pragma unroll
        for (int i = 0; i < 4; ++i) { const int g = tq + 512 * i; LAS f32x4* tp = (LAS f32x4*)(T + (g >> 7) * F1_P + 8 * (g & 127)); tp[0] = unpk4((u32x2){ld[i].x, ld[i].y}); tp[1] = unpk4((u32x2){ld[i].z, ld[i].w}); }
        if (t + 1 < tend) F1_LOAD(t + 1, tq);
        const float* mp = MOD + (size_t)(l * 17 + r) * 6144;
        if (r != cur_r) { cur_r = r;
            float cpart = 0.f;
#pragma unroll
            for (int s4 = 0; s4 < 32; ++s4) { const int k = 128 * w + 4 * s4 + kk; const float wv = WR[k * 16 + e16]; Breg[s4] = GF[k] * (mp[4096 + k] + 1.0f) * wv; cpart += mp[3072 + k] * wv; if ((s4 & 3) == 3) asm volatile("" ::: "memory"); }
            CP[(w * 4 + kk) * 16 + e16] = cpart; }
        __syncthreads();
#pragma unroll
        for (int k2 = 0; k2 < 2; ++k2) { const int row = 2 * w + k2; float ss = 0.f;
#pragma unroll
            for (int j = 0; j < 4; ++j) { const f32x4 x = *(const LAS f32x4*)(T + row * F1_P + 4 * (lane + 64 * j)); ss += (x[0] * x[0] + x[1] * x[1]) + (x[2] * x[2] + x[3] * x[3]); }
            ss = wave_sum(ss); if (lane == 0) RS[row] = 1.0f / sqrtf(ss * (1.0f / D) + EPS); }
        f32x4 acc = (f32x4){0.f, 0.f, 0.f, 0.f};
#pragma unroll
        for (int s4 = 0; s4 < 32; ++s4) { acc = __builtin_amdgcn_mfma_f32_16x16x4f32(T[e16 * F1_P + 128 * w + 4 * s4 + kk], Breg[s4], acc, 0, 0, 0);
            if ((s4 & 7) == 7) asm volatile("" ::: "memory"); }
#pragma unroll
        for (int i = 0; i < 4; ++i) PART[w * 256 + (4 * kk + i) * 16 + e16] = acc[i];
        __syncthreads();
        if (tq < 256) { const int row = tq >> 4, e = tq & 15; float sum = 0.f, cc = 0.f;
#pragma unroll
            for (int w8 = 0; w8 < 8; ++w8) sum += PART[w8 * 256 + row * 16 + e];
#pragma unroll
            for (int q = 0; q < 32; ++q) cc += CP[q * 16 + e];
            const float lg = RS[row] * sum + cc;
            float mx = lg; mx = fmaxf(mx, __shfl_xor(mx, 1)); mx = fmaxf(mx, __shfl_xor(mx, 2)); mx = fmaxf(mx, __shfl_xor(mx, 4)); mx = fmaxf(mx, __shfl_xor(mx, 8));
            const float ex = expf(lg - mx); float sm = ex; sm += __shfl_xor(sm, 1); sm += __shfl_xor(sm, 2); sm += __shfl_xor(sm, 4); sm += __shfl_xor(sm, 8);
            AFF[(size_t)(row0 + row) * 16 + e] = ex / sm; }
#pragma unroll
        for (int i = 0; i < 8; ++i) { const int g = tq + 512 * i, row = g >> 8, c4 = g & 255; const f32x4 x = *(const LAS f32x4*)(T + row * F1_P + 4 * c4);
            const f32x4 gf = *(const f32x4*)(GF + 4 * c4), sc = *(const f32x4*)(mp + 4096 + 4 * c4), sh = *(const f32x4*)(mp + 3072 + 4 * c4);
            const f32x4 hv = x * RS[row] * gf * (sc + 1.0f) + sh;
            int wv = 0; wv = __builtin_amdgcn_cvt_pk_fp8_f32(hv[0], hv[1], wv, false); wv = __builtin_amdgcn_cvt_pk_fp8_f32(hv[2], hv[3], wv, true);
            *(int*)(H + (size_t)(row0 + row) * D + 4 * c4) = wv; if (i & 1) asm volatile("" ::: "memory"); }
        __syncthreads();
    }
#undef F1_LOAD
}
__device__ __forceinline__ void phase_topk(const Ctx& c0, int l) {
    const Ctx c = fresh(c0);
    LAS unsigned long long* keys = (LAS unsigned long long*)c.lds;
    const float* AFF = (const float*)(c.ws + WS_AFF); int* ROWIDX = (int*)(c.ws + WS_ROWIDX); float* GVAL = (float*)(c.ws + WS_GVAL); short* SLOT = (short*)(c.ws + WS_SLOT);
    const bool last = (l == DEPTH - 1); const int Me = last ? 4096 : 4608; const int nitems = last ? 256 : 512;
    for (int item = c.bid; item < nitems; item += c.G) {
        const bool isctx = item >= 256; const int b = (item & 255) >> 4, e = item & 15;
        const int n = isctx ? CTXL : SEQ, cap = isctx ? CAPC : CAPL, rbase = isctx ? NLAT + b * CTXL : b * SEQ;
        for (int t = c.tid; t < n; t += NTHR) { const unsigned a = __builtin_bit_cast(unsigned, AFF[(size_t)(rbase + t) * 16 + e]); keys[t] = ((unsigned long long)a << 32) | (unsigned long long)(0xFFFFFFFFu - (unsigned)t); }
        __syncthreads();
        for (int k = 2; k <= n; k <<= 1) {
            if ((k >> 1) > 32) __syncthreads();
            for (int lj = 31 - __builtin_clz(k >> 1); lj >= 0; --lj) { const int j = 1 << lj;
                for (int i = c.tid; i < n / 2; i += NTHR) { const int ix = ((i >> lj) << (lj + 1)) | (i & (j - 1)), iy = ix + j; const unsigned long long a = keys[ix], bb = keys[iy]; const bool up = (ix & k) == 0;
                    if (up ? (a < bb) : (a > bb)) { keys[ix] = bb; keys[iy] = a; } }
                if (j > 32) __syncthreads(); else asm volatile("s_waitcnt lgkmcnt(0)" ::: "memory");
            } }
        __syncthreads();
        const int ybase = e * Me + (isctx ? 4096 + b * CAPC : b * CAPL);
        for (int p = c.tid; p < n; p += NTHR) { const unsigned long long kv = keys[p]; const int t = (int)(0xFFFFFFFFu - (unsigned)(kv & 0xFFFFFFFFull));
            SLOT[(size_t)(rbase + t) * 16 + e] = (short)(p < cap ? p : -1);
            if (p < cap) { ROWIDX[ybase + p] = rbase + t; GVAL[ybase + p] = __builtin_bit_cast(float, (unsigned)(kv >> 32)); } }
        __syncthreads();
    }
}
typedef float f32x16 __attribute__((ext_vector_type(16)));
constexpr int AT_KP = 272, AT_VP = 144, AT_KB = 64 * AT_KP, AT_VB = 128 * AT_VP;
__device__ __forceinline__ void phase_attn(const Ctx& c0, int l, int r_lo, int r_hi) {
    const Ctx c = fresh(c0);
    const bool lastl = (l == DEPTH - 1); const int nitems = lastl ? 1024 : 1152;
    const bf16* Q = (const bf16*)(c.ws + WS_Q); const bf16* Kb = (const bf16*)(c.ws + WS_K); const bf16* Vt = (const bf16*)(c.ws + WS_VT); bf16* ATT = (bf16*)(c.ws + WS_H);
    const int w = c.wave, lane = c.lane, lq = lane & 31, h = lane >> 5, tid = c.tid;
    const float scale2 = 0.08838834764831845f * 1.4426950408889634f;
    for (int item = c.bid + c.G * r_lo; item < nitems && item < c.bid + c.G * r_hi; item += c.G) {
        int b, n, kvh, hp; bool isctx;
        if (item < 1024) { b = item >> 6; n = (item >> 2) & 15; kvh = (item >> 1) & 1; hp = item & 1; isctx = false; }
        else { const int it = item - 1024; b = it >> 3; kvh = (it >> 2) & 1; hp = (it >> 1) & 1; n = it & 1; isctx = true; }
        const int qw = (w & 3) ^ ((w >> 2) << 1);
        const int head = kvh * 4 + hp * 2 + (w >> 2), qi = qw * 32 + lq;
        const int qrow = (isctx ? NLAT + b * CTXL : b * SEQ) + n * 128 + qi;
        const int tlo = isctx ? 0 : (n == 0 ? 2 : 0), nband = isctx ? 0 : ((n == 15 ? 4 : 6) - tlo), ntile = nband + 4;
        bf16x8 qf[8];
        { const u32x4* qp = (const u32x4*)(Q + (size_t)qrow * 1024 + head * 128 + 8 * h);
#pragma unroll
            for (int ks = 0; ks < 8; ++ks) qf[ks] = __builtin_bit_cast(bf16x8, qp[2 * ks]); }
        f32x16 O[4];
#pragma unroll
        for (int dt = 0; dt < 4; ++dt)
#pragma unroll
            for (int r = 0; r < 16; ++r) O[dt][r] = 0.f;
        float mrun = c.in[I_SINK][l * 8 + head] * (1.4426950408889634f / scale2), lsum = (h == 0) ? 1.0f : 0.0f;
        u32x4 kreg[2], vreg[2];
        auto tile_row0 = [&](int i) -> int { return i < nband ? b * SEQ + (n - 1) * 128 + (tlo + i) * 64 : NLAT + b * CTXL + (i - nband) * 64; };
#define AT_LOAD(i_) do { const int r0_ = tile_row0(i_); _Pragma("unroll") for (int i2 = 0; i2 < 2; ++i2) { const int cidx = tid + 512 * i2; \
            kreg[i2] = *(const u32x4*)(Kb + (size_t)(r0_ + (cidx >> 4)) * 256 + kvh * 128 + (cidx & 15) * 8); \
            vreg[i2] = *(const u32x4*)(Vt + (size_t)(kvh * 128 + (cidx >> 3)) * NROW + r0_ + (cidx & 7) * 8); } } while (0)
#define AT_STORE(buf_) do { _Pragma("unroll") for (int i2 = 0; i2 < 2; ++i2) { const int cidx = tid + 512 * i2; \
            *(LAS u32x4*)(c.lds + (buf_) * AT_KB + (cidx >> 4) * AT_KP + (cidx & 15) * 16) = kreg[i2]; \
            LAS u32x2* vp_ = (LAS u32x2*)(c.lds + 2 * AT_KB + (buf_) * AT_VB + (cidx >> 3) * AT_VP + ((cidx & 7) >> 1) * 32 + (cidx & 1) * 8); \
            vp_[0] = (u32x2){vreg[i2].x, vreg[i2].y}; vp_[2] = (u32x2){vreg[i2].z, vreg[i2].w}; } } while (0)
        AT_LOAD(0); AT_STORE(0);
        __syncthreads();
        for (int i = 0; i < ntile; ++i) {
            const int buf = i & 1;
            if (i + 1 < ntile) AT_LOAD(i + 1);
            const int tau = i < nband ? tlo + i : 2;
            const int mtype = tau >> 1, kbase = (tau & 1) * 64;
            const LAS unsigned char* Kl = c.lds + buf * AT_KB; const LAS unsigned char* Vl = c.lds + 2 * AT_KB + buf * AT_VB;
            const int ks0 = (tau & 1) * 2;
            const bool d0 = (mtype == 0 && ks0 < qw) || (mtype == 2 && ks0 > qw), d1 = (mtype == 0 && ks0 + 1 < qw) || (mtype == 2 && ks0 + 1 > qw);
            if (!(d0 && d1)) {
            f32x16 S[2];
#pragma unroll
            for (int sub = 0; sub < 2; ++sub) { if (sub ? d1 : d0) continue;
#pragma unroll
                for (int r = 0; r < 16; ++r) S[sub][r] = 0.f;
#pragma unroll
                for (int ks = 0; ks < 8; ++ks) { const bf16x8 kf = *(const LAS bf16x8*)(Kl + (sub * 32 + lq) * AT_KP + ks * 32 + h * 16);
                    S[sub] = __builtin_amdgcn_mfma_f32_32x32x16_bf16(kf, qf[ks], S[sub], 0, 0, 0); }
            }
            float mx = -INFINITY;
            if (mtype != 1) {
#pragma unroll
                for (int sub = 0; sub < 2; ++sub) if (ks0 + sub == qw)
#pragma unroll
                    for (int r = 0; r < 16; ++r) { const int kj = kbase + sub * 32 + (r & 3) + 8 * (r >> 2) + 4 * h; const bool valid = (mtype == 0) ? (kj >= qi) : (kj <= qi); S[sub][r] = valid ? S[sub][r] : -INFINITY; } }
#pragma unroll
            for (int sub = 0; sub < 2; ++sub) if (!(sub ? d1 : d0))
#pragma unroll
                for (int r = 0; r < 16; r += 2) mx = fmaxf(mx, fmaxf(S[sub][r], S[sub][r + 1]));
            mx = fmaxf(mx, __shfl_xor(mx, 32));
            const float mnew = fmaxf(mrun, mx), alpha = __builtin_amdgcn_exp2f((mrun - mnew) * scale2); mrun = mnew;
            const f32x2 nms = (f32x2){-mnew * scale2, -mnew * scale2};
            f32x2 ps2 = (f32x2){0.f, 0.f};
#pragma unroll
            for (int sub = 0; sub < 2; ++sub) if (!(sub ? d1 : d0))
#pragma unroll
                for (int r = 0; r < 16; r += 2) { const f32x2 a2 = (f32x2){S[sub][r], S[sub][r + 1]} * scale2 + nms; const f32x2 p2 = (f32x2){__builtin_amdgcn_exp2f(a2.x), __builtin_amdgcn_exp2f(a2.y)}; S[sub][r] = p2.x; S[sub][r + 1] = p2.y; ps2 += p2; }
            const float psum = ps2.x + ps2.y;
            lsum = lsum * alpha + psum;
#pragma unroll
            for (int dt = 0; dt < 4; ++dt) O[dt] = O[dt] * alpha;
#pragma unroll
            for (int sub = 0; sub < 2; ++sub) if (!(sub ? d1 : d0))
#pragma unroll
                for (int s2 = 0; s2 < 2; ++s2) {
                    u32x4 pw; pw.x = pk2(S[sub][8 * s2 + 0], S[sub][8 * s2 + 1]); pw.y = pk2(S[sub][8 * s2 + 2], S[sub][8 * s2 + 3]); pw.z = pk2(S[sub][8 * s2 + 4], S[sub][8 * s2 + 5]); pw.w = pk2(S[sub][8 * s2 + 6], S[sub][8 * s2 + 7]);
                    const bf16x8 pf = __builtin_bit_cast(bf16x8, pw);
                    const int kb2 = (sub * 2 + s2) * 32 + h * 16;
#pragma unroll
                    for (int dt = 0; dt < 4; ++dt) { const bf16x8 vf = *(const LAS bf16x8*)(Vl + (32 * dt + lq) * AT_VP + kb2);
                        O[dt] = __builtin_amdgcn_mfma_f32_32x32x16_bf16(vf, pf, O[dt], 0, 0, 0); }
                }
            }
            if (i + 1 < ntile) AT_STORE(buf ^ 1);
            __syncthreads();
        }
#undef AT_LOAD
#undef AT_STORE
        const float inv = 1.0f / (lsum + __shfl_xor(lsum, 32));
        bf16* op = ATT + (size_t)qrow * 1024 + head * 128 + 4 * h;
#pragma unroll
        for (int dt = 0; dt < 4; ++dt)
#pragma unroll
            for (int g = 0; g < 4; ++g) { u32x2 wv; wv.x = pk2(O[dt][4 * g] * inv, O[dt][4 * g + 1] * inv); wv.y = pk2(O[dt][4 * g + 2] * inv, O[dt][4 * g + 3] * inv); *(u32x2*)(op + 32 * dt + 8 * g) = wv; }
    }
}

constexpr int RG_UP = 272;
template <bool REV> __device__ __forceinline__ void rg_scan(const float (&a)[4][4], float (&bc)[4][4], float& H, int q, const int (&baddr)[4]) {
    float A4[4], B4[4];
#pragma unroll
    for (int tt = 0; tt < 4; ++tt) { float A = 1.f, B = 0.f;
#pragma unroll
        for (int ri = 0; ri < 4; ++ri) { const int r = REV ? 3 - ri : ri; B = a[tt][r] * B + bc[tt][r]; A *= a[tt][r]; }
        A4[tt] = A; B4[tt] = B; }
    float Ag[4][4], Bg[4][4];
#pragma unroll
    for (int tt = 0; tt < 4; ++tt)
#pragma unroll
        for (int qq = 0; qq < 4; ++qq) { Ag[tt][qq] = __builtin_bit_cast(float, __builtin_amdgcn_ds_bpermute(baddr[qq], __builtin_bit_cast(int, A4[tt]))); Bg[tt][qq] = __builtin_bit_cast(float, __builtin_amdgcn_ds_bpermute(baddr[qq], __builtin_bit_cast(int, B4[tt]))); }
    const int g0 = REV ? 3 : 0, g1 = REV ? 2 : 1, g2 = REV ? 1 : 2, g3 = REV ? 0 : 3;
    const int rank = REV ? 3 - q : q;
#pragma unroll
    for (int tti = 0; tti < 4; ++tti) { const int tt = REV ? 3 - tti : tti;
        const float A1 = Ag[tt][g1] * Ag[tt][g0], B1 = Ag[tt][g1] * Bg[tt][g0] + Bg[tt][g1];
        const float A2 = Ag[tt][g2] * A1, B2 = Ag[tt][g2] * B1 + Bg[tt][g2];
        const float A3 = Ag[tt][g3] * A2, B3 = Ag[tt][g3] * B2 + Bg[tt][g3];
        float myA = rank == 1 ? Ag[tt][g0] : 1.f, myB = rank == 1 ? Bg[tt][g0] : 0.f;
        myA = rank == 2 ? A1 : myA; myB = rank == 2 ? B1 : myB; myA = rank == 3 ? A2 : myA; myB = rank == 3 ? B2 : myB;
        float hc = myA * H + myB;
#pragma unroll
        for (int ri = 0; ri < 4; ++ri) { const int r = REV ? 3 - ri : ri; hc = a[tt][r] * hc + bc[tt][r]; bc[tt][r] = hc; }
        H = A3 * H + B3;
    }
}
__device__ __forceinline__ void phase_rglru(const Ctx& c0, int l) {
    const Ctx c = fresh(c0);
    const bool lastl = (l == DEPTH - 1);
    LAS unsigned char* UC = c.lds; LAS unsigned char* HS = c.lds + 2 * 64 * RG_UP;
    const bf16* U = (const bf16*)(c.ws + WS_U); const bf16* GZ = (const bf16*)(c.ws + WS_GZ); bf16* REC = (bf16*)(c.ws + WS_REC); const bf16* LW = (const bf16*)(c.ws + WS_LW);
    const int tid = c.tid, lane = c.lane, w = c.wave, dir = w >> 2, cg = w & 3, chl = lane & 15, q = lane >> 4;
    for (int item = c.bid; item < 256; item += c.G) {
        const int b = item >> 4, nb = (item >> 1) & 7, half = item & 1, cbase = nb * 128, oc = 16 * cg + chl, och = half * 64 + oc, col = cbase + och;
        bf16x8 wf[2][4];
#pragma unroll
        for (int g = 0; g < 2; ++g)
#pragma unroll
            for (int ks = 0; ks < 4; ++ks) wf[g][ks] = *(const bf16x8*)(LW + (size_t)(((dir * 8 + nb) * 2 + g) * 128 + och) * 128 + 32 * ks + 8 * q);
        const float ba = c.in[I_LBA][(l * 2 + dir) * D + col], bx = c.in[I_LBX][(l * 2 + dir) * D + col];
        const float Kc = -8.0f * log1pf(expf(-c.in[I_LAM][(l * 2 + dir) * D + col])) * 1.4426950408889634f;
        f32x2 cw[4][4], cbias[4];
        const int c8 = tid & 15, tg = (tid >> 4) & 15, dcv = tid >> 8;
        {
#pragma unroll
            for (int p = 0; p < 4; ++p) { cbias[p] = (f32x2){c.in[I_CONVB][l * D + cbase + 8 * c8 + 2 * p], c.in[I_CONVB][l * D + cbase + 8 * c8 + 2 * p + 1]};
#pragma unroll
                for (int k = 0; k < 4; ++k) cw[k][p] = (f32x2){c.in[I_CONVW][(l * 4 + k) * D + cbase + 8 * c8 + 2 * p], c.in[I_CONVW][(l * 4 + k) * D + cbase + 8 * c8 + 2 * p + 1]}; } }
        float H = 0.f;
        int baddr[4];
#pragma unroll
        for (int qq = 0; qq < 4; ++qq) baddr[qq] = (chl + 16 * qq) * 4;
        u32x4 uraw[7];
#define RG_ULOAD(s_) do { const int tau_ = dcv == 0 ? (s_) : ((s_) < 4 ? 3 - (s_) : 39 - (s_)); const bool isc_ = tau_ < 4; const int T_ = isc_ ? CTXL : SEQ, ts0_ = (isc_ ? tau_ : tau_ - 4) * 64 + 4 * tg - 2; \
            const bf16* up_ = U + (size_t)((isc_ ? NLAT + b * CTXL : b * SEQ) + ts0_) * D + cbase + 8 * c8; \
            _Pragma("unroll") for (int i_ = 0; i_ < 7; ++i_) uraw[i_] = (ts0_ + i_ >= 0 && ts0_ + i_ < T_) ? *(const u32x4*)(up_ + (size_t)i_ * D) : (u32x4){0u, 0u, 0u, 0u}; } while (0)
        RG_ULOAD(0);
        for (int s = 0; s < 36; ++s) {
#pragma unroll
            for (int tk = 0; tk < 4; ++tk) {
                u32x4 pw;
#pragma unroll
                for (int p = 0; p < 4; ++p) {
                    f32x2 o = cbias[p];
#pragma unroll
                    for (int k = 0; k < 4; ++k) o = cw[k][p] * (f32x2){bf_lo(uraw[tk + k][p]), bf_hi(uraw[tk + k][p])} + o;
                    pw[p] = pk2(o.x, o.y); }
                *(LAS u32x4*)(UC + (dcv * 64 + 4 * tg + tk) * RG_UP + c8 * 16) = pw;
            }
            __syncthreads();
            if (s + 1 < 36) RG_ULOAD(s + 1);
            u32x4 rvp[2], zvp[2];
#pragma unroll
            for (int dc = 0; dc < 2; ++dc) {
                const int t = tid >> 3, o8 = tid & 7;
                const int tau = dc == 0 ? s : (s < 4 ? 3 - s : 39 - s);
                const int other = dc == 0 ? (tau < 4 ? 3 - tau : 39 - tau) : tau;
                rvp[dc] = (u32x4){0u, 0u, 0u, 0u}; zvp[dc] = (u32x4){0u, 0u, 0u, 0u};
                if (other < s && !(lastl && tau < 4)) { const int row = (tau < 4 ? NLAT + b * CTXL + tau * 64 : b * SEQ + (tau - 4) * 64) + t; const size_t o = (size_t)row * D + cbase + half * 64 + o8 * 8;
                    rvp[dc] = *(const u32x4*)(REC + o); zvp[dc] = *(const u32x4*)(GZ + o); }
            }
            f32x4 gr[4], gi[4];
#pragma unroll
            for (int tt = 0; tt < 4; ++tt) { gr[tt] = (f32x4){0.f, 0.f, 0.f, 0.f}; gi[tt] = (f32x4){0.f, 0.f, 0.f, 0.f}; }
#pragma unroll
            for (int tt = 0; tt < 4; ++tt)
#pragma unroll
                for (int ks = 0; ks < 4; ++ks) { const bf16x8 af = *(const LAS bf16x8*)(UC + (dir * 64 + 16 * tt + chl) * RG_UP + (32 * ks + 8 * q) * 2);
                    gr[tt] = __builtin_amdgcn_mfma_f32_16x16x32_bf16(af, wf[0][ks], gr[tt], 0, 0, 0); gi[tt] = __builtin_amdgcn_mfma_f32_16x16x32_bf16(af, wf[1][ks], gi[tt], 0, 0, 0); }
            float av[4][4], bv[4][4];
            { const float L2E = 1.4426950408889634f; const f32x2 nba = (f32x2){-L2E * ba, -L2E * ba}, nbx = (f32x2){-L2E * bx, -L2E * bx};
#pragma unroll
              for (int tt = 0; tt < 4; ++tt)
#pragma unroll
                for (int rp = 0; rp < 2; ++rp) { const int tok = 16 * tt + 4 * q + 2 * rp;
                    const LAS unsigned char* up = UC + (dir * 64 + tok) * RG_UP + och * 2;
                    const f32x2 ucv = (f32x2){bf2f(*(const LAS bf16*)up), bf2f(*(const LAS bf16*)(up + RG_UP))};
                    const f32x2 xr = (f32x2){gr[tt][2 * rp], gr[tt][2 * rp + 1]} * (-L2E) + nba, xi = (f32x2){gi[tt][2 * rp], gi[tt][2 * rp + 1]} * (-L2E) + nbx;
                    f32x2 er = (f32x2){__builtin_amdgcn_exp2f(xr.x), __builtin_amdgcn_exp2f(xr.y)} + 1.0f, ei = (f32x2){__builtin_amdgcn_exp2f(xi.x), __builtin_amdgcn_exp2f(xi.y)} + 1.0f;
                    const f32x2 rr = (f32x2){__builtin_amdgcn_rcpf(er.x), __builtin_amdgcn_rcpf(er.y)}, ii = (f32x2){__builtin_amdgcn_rcpf(ei.x), __builtin_amdgcn_rcpf(ei.y)};
                    const f32x2 la = rr * Kc; const f32x2 a2 = (f32x2){__builtin_amdgcn_exp2f(la.x), __builtin_amdgcn_exp2f(la.y)};
                    f32x2 om = 1.0f - a2 * a2; om.x = fmaxf(om.x, 0.f); om.y = fmaxf(om.y, 0.f);
                    const f32x2 b2 = (f32x2){__builtin_amdgcn_sqrtf(om.x), __builtin_amdgcn_sqrtf(om.y)} * (ii * ucv);
                    av[tt][2 * rp] = a2.x; av[tt][2 * rp + 1] = a2.y; bv[tt][2 * rp] = b2.x; bv[tt][2 * rp + 1] = b2.y; } }
            if (dir) rg_scan<true>(av, bv, H, q, baddr); else rg_scan<false>(av, bv, H, q, baddr);
#pragma unroll
            for (int tt = 0; tt < 4; ++tt)
#pragma unroll
                for (int rp = 0; rp < 2; ++rp) { const unsigned w2 = pk2(bv[tt][2 * rp], bv[tt][2 * rp + 1]); LAS unsigned char* hp = HS + (dir * 64 + 16 * tt + 4 * q + 2 * rp) * 128 + oc * 2;
                    *(LAS bf16*)hp = (bf16)(w2 & 0xffffu); *(LAS bf16*)(hp + 128) = (bf16)(w2 >> 16); }
            __syncthreads();
#pragma unroll
            for (int dc = 0; dc < 2; ++dc) {
                const int t = tid >> 3, o8 = tid & 7;
                const int tau = dc == 0 ? s : (s < 4 ? 3 - s : 39 - s);
                const int other = dc == 0 ? (tau < 4 ? 3 - tau : 39 - tau) : tau; const bool second = other < s;
                if (lastl && tau < 4) continue;
                const int row = (tau < 4 ? NLAT + b * CTXL + tau * 64 : b * SEQ + (tau - 4) * 64) + t;
                const u32x4 hv = *(const LAS u32x4*)(HS + (dc * 64 + t) * 128 + o8 * 16);
                const size_t o = (size_t)row * D + cbase + half * 64 + o8 * 8;
                if (!second) *(u32x4*)(REC + o) = hv;
                else { const u32x4 rv = rvp[dc], zv = zvp[dc]; u32x4 ov;
#pragma unroll
                    for (int p = 0; p < 4; ++p) { const f32x2 y = ((f32x2){bf_lo(rv[p]), bf_hi(rv[p])} + (f32x2){bf_lo(hv[p]), bf_hi(hv[p])}) * (f32x2){bf_lo(zv[p]), bf_hi(zv[p])}; ov[p] = pk2(y.x, y.y); }
                    *(u32x4*)(REC + o) = ov; }
            }
        }
#undef RG_ULOAD
        __syncthreads();
    }
}

constexpr int PH_PER_LAYER = 10, NPH = 1 + DEPTH * PH_PER_LAYER + 1;
#ifndef PHASE_MASK
#define PHASE_MASK 0xFFFFu
#endif
#define PM(j) ((PHASE_MASK >> (j)) & 1u)
#ifndef PROBE_DOUBLE
#define PROBE_DOUBLE (-1)
#endif
#define REP(k) for (int rep_ = 0; rep_ < ((PROBE_DOUBLE == (k)) ? 2 : 1); ++rep_)
#define IN(k) (lo <= (k) && (k) < hi)
#define SEAM(k) do { if (IN(k) && IN((k) + 1)) xcd_barrier(bar); } while (0)
template <int l> __device__ __forceinline__ void run_layer(const Ctx& c, const XcdBarrier& bar, int lo, int hi) {
    LAS unsigned char* ring = c.lds;
        const int pb = 1 + l * PH_PER_LAYER; const bool last = (l == DEPTH - 1);
        const int nMrows = last ? 128 : 144, Me = last ? 4096 : 4608;
        const bool ovl = (l == 0 && c.G == 256 && lo <= pb + 3 && pb + 4 < hi);
        if (PM(1) && IN(pb + 0)) { if (l > 0 && !(c.G == 256 && IN(pb - 1))) { REP(1) phase_convert_weights(c, l); } phase_norm1(c, l); }
        SEAM(pb + 0);
        if (PM(2) && IN(pb + 1)) {
            REP(2) { ProbIn P; P.ws = c.ws; P.G = c.G; P.c = c.bid; P.nM = nMrows; P.nLat = nMrows * 13; P.nCtx = last ? 80 : 0; pg8::gemm_phase<ProbIn, true>(ring, P); }
            { ProbIn8 P; P.ws = c.ws; P.G = c.G; P.c = c.bid; P.nM = nMrows; P.bal = last && c.G == 256; pg8::gemm_phase<ProbIn8, true>(ring, P); }
            { ProbVt P; P.ws = c.ws; P.G = c.G; P.c = c.bid; P.bal = last && c.G == 256; pg8::gemm_phase<ProbVt, true>(ring, P); }
        }
        SEAM(pb + 1);
        if (PM(3) && IN(pb + 2)) {
            const int cgrp = c.bid % 6;
            if (cgrp == 0) phase_convert_moe(c, l);
            REP(3) phase_rglru(c, l); __syncthreads();
            if (cgrp == 1) phase_convert_moe(c, l);
            REP(4) {
            phase_attn(c, l, 0, 1); if (cgrp == 2) phase_convert_moe(c, l);
            phase_attn(c, l, 1, 2); if (cgrp == 3) phase_convert_moe(c, l);
            phase_attn(c, l, 2, 3); if (cgrp == 4) phase_convert_moe(c, l);
            phase_attn(c, l, 3, 8); if (cgrp == 5) phase_convert_moe(c, l);
            }
        }
        SEAM(pb + 2);
        if (PM(4) && IN(pb + 3)) REP(5) {
            if (ovl) {
                unsigned* hw = (unsigned*)(c.ws + WS_CTL) + 8192;
                { ProbMerge01 P; P.ws = c.ws; P.G = c.G; P.c = c.bid; P.nM = nMrows; P.pbeg = 0; P.pend = 2; pg8::gemm_phase<ProbMerge01, true>(ring, P); }
                pg8::handoff_signal(bar, hw);
                if (c.bid < 64) { ProbMerge01 P; P.ws = c.ws; P.G = c.G; P.c = c.bid; P.nM = nMrows; P.pbeg = 2; P.pend = 3; pg8::gemm_phase<ProbMerge01, true>(ring, P); }
                else { pg8::handoff_wait(bar, hw);
                    ProbMerge<2> P; P.ws = c.ws; P.G = c.G; P.c = c.bid; P.nM = nMrows; P.l = l; P.xin = c.in[I_X]; P.cin = c.in[I_CTX]; P.ubeg = c.bid - 64; P.ustride = 192; P.ucnt = 2; pg8::gemm_phase<ProbMerge<2>, true>(ring, P); }
            } else { ProbMerge01 P; P.ws = c.ws; P.G = c.G; P.c = c.bid; P.nM = nMrows; P.pbeg = 0; P.pend = 1 << 20; pg8::gemm_phase<ProbMerge01, true>(ring, P); }
        }
        SEAM(pb + 3);
        if (PM(5) && IN(pb + 4)) { ProbMerge<2> P; P.ws = c.ws; P.G = c.G; P.c = c.bid; P.nM = nMrows; P.l = l; P.xin = c.in[I_X]; P.cin = c.in[I_CTX]; P.ubeg = c.bid; P.ustride = c.G; P.ucnt = 1 << 20;
            if (ovl) { P.ustride = 0; P.ucnt = c.bid < 192 ? 1 : 0; P.ubeg = c.bid < 128 ? 384 + c.bid : 512 + (c.bid - 128); }
            pg8::gemm_phase<ProbMerge<2>, true>(ring, P); }
        SEAM(pb + 4);
        if (PM(6) && IN(pb + 5)) REP(6) phase_norm2(c, l);
        SEAM(pb + 5);
        if (PM(7) && IN(pb + 6)) REP(7) { phase_topk(c, l); __syncthreads(); }
        SEAM(pb + 6);
        if (PM(9) && IN(pb + 8)) REP(9) { ProbUp P; P.ws = c.ws; P.G = c.G; P.c = c.bid; P.Me = Me; P.l = l; pg8::gemm_phase<ProbUp, true>(ring, P); }
        SEAM(pb + 8);
        if (PM(10) && IN(pb + 9)) { REP(10) { ProbDown P; P.ws = c.ws; P.G = c.G; P.c = c.bid; P.Me = Me; P.l = l; pg8::gemm_phase<ProbDown, true>(ring, P); }
            if (!last && c.G == 256 && IN(pb + 10) && c.bid >= 128) { __syncthreads(); phase_convert_weights(c, l + 1, 128, 128); __syncthreads(); } }
        SEAM(pb + 9);
}
__global__ void __launch_bounds__(NTHR, 2) fwd(Args args) {
    extern __shared__ __attribute__((aligned(16))) unsigned char lds_raw[];
    Ctx c;
    c.in = args.in;
    c.out = args.out; c.ws = args.ws; c.lds = (LAS unsigned char*)lds_raw;
    c.tid = threadIdx.x; c.lane = c.tid & 63; c.wave = __builtin_amdgcn_readfirstlane(c.tid >> 6); c.G = gridDim.x; c.bid = blockIdx.x;
    volatile LAS unsigned* MISC = (volatile LAS unsigned*)(c.lds + MISC_OFF);
    if (c.tid < 4) MISC[c.tid] = 0u;
    __syncthreads();
    const int lo = args.ph_lo, hi = args.ph_hi;
    XcdBarrier bar; bar.bar = (unsigned*)(c.ws + WS_CTL) + 1024; bar.x = 0; bar.st = MISC;
    if (hi - lo > 1) bar = xcd_barrier_post((unsigned*)(c.ws + WS_CTL) + 1024, MISC);
    if (PM(0) && IN(0)) { REP(0) { phase_mod(c); __syncthreads(); phase_convert_weights(c, 0); } }
    SEAM(0);
    run_layer<0>(c, bar, lo, hi);
    run_layer<1>(c, bar, lo, hi);
    if (PM(11) && IN(NPH - 1)) phase_norm1(c, DEPTH);
#undef IN
#undef SEAM
}

extern "C" void kernel_launch(void* const* d_in, const int* in_sizes, int n_in, void* d_out, int out_size, void* d_ws, size_t ws_size, hipStream_t stream) {
    static int grid = 0;
    if (grid == 0) {
        if (n_in != 25 || in_sizes[0] != NLAT * D || out_size != NLAT * D || ws_size < WS_END) { fprintf(stderr, "kernel_launch: unexpected problem (n_in %d, in0 %d, out %d, ws %zu < %zu)\n", n_in, n_in > 0 ? in_sizes[0] : -1, out_size, ws_size, (size_t)WS_END); grid = -1; return; }
        int dev = 0, cus = 0, per_cu = 0;
        if (hipGetDevice(&dev) != hipSuccess || hipDeviceGetAttribute(&cus, hipDeviceAttributeMultiprocessorCount, dev) != hipSuccess) { grid = -1; return; }
        if (hipFuncSetAttribute((const void*)fwd, hipFuncAttributeMaxDynamicSharedMemorySize, LDS_BYTES) != hipSuccess) { fprintf(stderr, "kernel_launch: hipFuncSetAttribute failed\n"); grid = -1; return; }
        if (hipOccupancyMaxActiveBlocksPerMultiprocessor(&per_cu, (const void*)fwd, NTHR, LDS_BYTES) != hipSuccess || per_cu < 1) fprintf(stderr, "kernel_launch: occupancy query says %d\n", per_cu);
        (void)hipGetLastError();
        grid = cus;
        if (grid % 8 != 0) grid -= grid % 8;
    }
    if (grid < 0) return;
    (void)hipMemsetAsync((char*)d_ws + WS_CTL, 0, CTL_ZERO_BYTES, stream);
    Args a{};
    for (int i = 0; i < 25; ++i) a.in[i] = (const float*)d_in[i];
    a.out = (float*)d_out; a.ws = (unsigned char*)d_ws;
#if MK_PER_PHASE
    for (int p = 0; p < NPH; ++p) { a.ph_lo = p; a.ph_hi = p + 1; hipLaunchKernelGGL(fwd, dim3(grid), dim3(NTHR), LDS_BYTES, stream, a); }
#else
    a.ph_lo = 0; a.ph_hi = NPH; hipLaunchKernelGGL(fwd, dim3(grid), dim3(NTHR), LDS_BYTES, stream, a);
#endif
    const hipError_t le = hipPeekAtLastError();
    if (le != hipSuccess) fprintf(stderr, "kernel_launch: launch failed: %s\n", hipGetErrorName(le));
}
```

```cpp
#include <hip/hip_runtime.h>
#include <cstdio>
#include <cstdint>

#ifndef MK_PER_PHASE
#define MK_PER_PHASE 0
#endif

#define LAS __attribute__((address_space(3)))
#define GAS __attribute__((address_space(1)))
typedef unsigned short bf16;
typedef short bf16x8 __attribute__((ext_vector_type(8)));
typedef float f32x4 __attribute__((ext_vector_type(4)));
typedef float f32x2 __attribute__((ext_vector_type(2)));
typedef unsigned u32x4 __attribute__((ext_vector_type(4)));
typedef unsigned u32x2 __attribute__((ext_vector_type(2)));

constexpr int D = 1024, NB = 16, SEQ = 2048, CTXL = 256, DEPTH = 2;
constexpr int NLAT = NB * SEQ, NCTX = NB * CTXL, NROW = NLAT + NCTX;
constexpr int INW = 5632, NE = 16, DE = 2048, CAPL = 256, CAPC = 32, NMOD = 6;
constexpr float EPS = 1e-6f;
constexpr int NWAVES = 8, NTHR = 512;

constexpr size_t MiB = 1u << 20;
constexpr size_t WS_CTL = 0, CTL_ZERO_BYTES = 64 * 1024;
constexpr size_t WS_MOD = 1 * MiB;
constexpr size_t WS_COS = 2 * MiB;
constexpr size_t WS_SIN = 2 * MiB + 16384;
constexpr size_t WS_ROWIDX = 3 * MiB;
constexpr size_t WS_GVAL = 4 * MiB;
constexpr size_t WS_SLOT = 5 * MiB;
constexpr size_t WS_AFF = 8 * MiB;
constexpr size_t WS_WIN8 = 12 * MiB;
constexpr size_t WS_WIN = 16 * MiB;
constexpr size_t WS_WA = 27 * MiB, WS_WR = 29 * MiB, WS_WO = 31 * MiB;
__host__ __device__ constexpr size_t ws_wgu(int l) { return (33 + 64 * l) * MiB; }
__host__ __device__ constexpr size_t ws_wdn(int l) { return (161 + 32 * l) * MiB; }
constexpr size_t WS_LW = 225 * MiB;
constexpr size_t WS_X = 226 * MiB;
constexpr size_t WS_H8 = 298 * MiB;
constexpr size_t WS_H = 370 * MiB;
constexpr size_t WS_Q = 442 * MiB;
constexpr size_t WS_U = 514 * MiB;
constexpr size_t WS_T1 = 442 * MiB;
constexpr size_t WS_K = 586 * MiB;
constexpr size_t WS_VT = 604 * MiB;
constexpr size_t WS_GZ = 622 * MiB;
constexpr size_t WS_SMA = 694 * MiB, WS_SMR = 766 * MiB, WS_REC = 838 * MiB;
constexpr size_t WS_HID = 442 * MiB;
constexpr size_t WS_YE = 730 * MiB;
constexpr size_t WS_END = 910 * MiB;

constexpr int LDS_BYTES = 147456;
constexpr int RING_BYTES = 131072;
constexpr int MISC_OFF = LDS_BYTES - 16;

__device__ __forceinline__ unsigned f2bf(float f) { unsigned u = __builtin_bit_cast(unsigned, f); return (u + 0x7fffu + ((u >> 16) & 1u)) >> 16; }
__device__ __forceinline__ unsigned pk2(float lo, float hi) { unsigned r; asm volatile("v_cvt_pk_bf16_f32 %0, %1, %2" : "=v"(r) : "v"(lo), "v"(hi)); return r; }
__device__ __forceinline__ float bf_lo(unsigned w) { return __builtin_bit_cast(float, w << 16); }
__device__ __forceinline__ float bf_hi(unsigned w) { return __builtin_bit_cast(float, w & 0xffff0000u); }
__device__ __forceinline__ float bf2f(bf16 b) { return __builtin_bit_cast(float, ((unsigned)b) << 16); }
__device__ __forceinline__ u32x2 pk4(f32x4 v) { u32x2 w; w.x = pk2(v[0], v[1]); w.y = pk2(v[2], v[3]); return w; }
__device__ __forceinline__ f32x4 unpk4(u32x2 w) { return (f32x4){bf_lo(w.x), bf_hi(w.x), bf_lo(w.y), bf_hi(w.y)}; }
__device__ __forceinline__ unsigned f8x4(f32x4 v) { int w = 0; w = __builtin_amdgcn_cvt_pk_fp8_f32(v[0], v[1], w, false); w = __builtin_amdgcn_cvt_pk_fp8_f32(v[2], v[3], w, true); return (unsigned)w; }
__device__ __forceinline__ float wave_sum(float v) {
#pragma unroll
    for (int o = 1; o < 64; o <<= 1) v += __shfl_xor(v, o);
    return v;
}
__device__ __forceinline__ float wave_max(float v) {
#pragma unroll
    for (int o = 1; o < 64; o <<= 1) v = fmaxf(v, __shfl_xor(v, o));
    return v;
}
__device__ __forceinline__ float bsel(unsigned m, float a0, float a1) { return __builtin_bit_cast(float, (__builtin_bit_cast(unsigned, a1) & m) | (__builtin_bit_cast(unsigned, a0) & ~m)); }
__device__ __forceinline__ float sigmoidf_(float x) { return __builtin_amdgcn_rcpf(1.0f + __expf(-x)); }
__device__ __forceinline__ f32x2 sigmoid2(f32x2 x) { const f32x2 t = x * (-1.4426950408889634f); const f32x2 e = (f32x2){__builtin_amdgcn_exp2f(t.x), __builtin_amdgcn_exp2f(t.y)} + 1.0f; return (f32x2){__builtin_amdgcn_rcpf(e.x), __builtin_amdgcn_rcpf(e.y)}; }
__device__ __forceinline__ f32x2 sigmoid2k(f32x2 x, float k) { const f32x2 t = x * k; const f32x2 e = (f32x2){__builtin_amdgcn_exp2f(t.x), __builtin_amdgcn_exp2f(t.y)} + 1.0f; return (f32x2){__builtin_amdgcn_rcpf(e.x), __builtin_amdgcn_rcpf(e.y)}; }
__device__ __forceinline__ f32x2 gelu2(f32x2 z) { const f32x2 y = (z * z * 0.044715f + 1.0f) * z * (-1.5957691216057308f * 1.4426950408889634f); const f32x2 e = (f32x2){__builtin_amdgcn_exp2f(y.x), __builtin_amdgcn_exp2f(y.y)} + 1.0f; return z * (f32x2){__builtin_amdgcn_rcpf(e.x), __builtin_amdgcn_rcpf(e.y)}; }
__device__ __forceinline__ float gelu_tanh(float z) { const float y = 1.5957691216057308f * (z + 0.044715f * z * z * z); return z * __builtin_amdgcn_rcpf(1.0f + __expf(-y)); }

#define XB_TMO      128
#define XB_XCNT(j)  (256  + 64 * (j))
#define XB_XSUB(j)  (1280 + 64 * (j))
#define XB_XGEN(j)  (2304 + 64 * (j))
#define XB_TOP      3328
#define XB_TOPGEN   3392
#define XCD_BAR_WORDS 3456
#define XB_SPIN_CAP (1u << 18)
__device__ __forceinline__ unsigned xb_ld(unsigned* p)              { return __hip_atomic_load(p, __ATOMIC_RELAXED, __HIP_MEMORY_SCOPE_AGENT); }
__device__ __forceinline__ unsigned xb_add(unsigned* p, unsigned v) { return __hip_atomic_fetch_add(p, v, __ATOMIC_RELAXED, __HIP_MEMORY_SCOPE_AGENT); }
__device__ __forceinline__ unsigned xb_xcc_id() { return (unsigned)__builtin_amdgcn_s_getreg((3 << 11) | 20) & 0xFu; }
#define XB_SPIN(cond, bar) do { unsigned _sp = 0; while (cond) { __builtin_amdgcn_s_sleep(1); \
    if ((++_sp & 255u) == 0u) { if (xb_ld(&(bar)[XB_TMO])) break; if (_sp > XB_SPIN_CAP) { atomicAdd(&(bar)[XB_TMO], 1u); break; } } } } while (0)
struct XcdBarrier { unsigned* bar; unsigned x; volatile LAS unsigned* st; };
__device__ __forceinline__ XcdBarrier xcd_barrier_post(unsigned* bar, volatile LAS unsigned* st) {
    XcdBarrier b; b.bar = bar; b.x = xb_xcc_id(); b.st = st;
    if (threadIdx.x == 0) (void)xb_add(&bar[XB_XCNT(b.x)], 1u);
    return b;
}
__device__ __forceinline__ void xcd_barrier_complete(unsigned* bar, unsigned x, unsigned& nloc, unsigned& nx) {
    const unsigned G = gridDim.x * gridDim.y * gridDim.z;
    unsigned sum, cnt, mine, sp = 0u;
    for (;;) {
        sum = 0u; cnt = 0u; mine = 0u;
#pragma unroll
        for (unsigned j = 0; j < 16; ++j) { const unsigned c = xb_ld(&bar[XB_XCNT(j)]); sum += c; cnt += (c > 0u) ? 1u : 0u; mine = (j == x) ? c : mine; }
        if (sum == G) break;
        __builtin_amdgcn_s_sleep(1);
        if ((++sp & 255u) == 0u) { if (xb_ld(&bar[XB_TMO])) break; if (sp > XB_SPIN_CAP) { atomicAdd(&bar[XB_TMO], 1u); break; } }
    }
    nloc = mine > 0u ? mine : 1u; nx = cnt > 0u ? cnt : 1u;
}
__device__ __forceinline__ void xcd_barrier(const XcdBarrier& b) {
    asm volatile("s_waitcnt vmcnt(0)" ::: "memory");
    __syncthreads();
    if (threadIdx.x == 0) {
        unsigned* bar = b.bar;
        __builtin_amdgcn_s_waitcnt(0);
        unsigned nloc = b.st[0], nx = b.st[1];
        if (nloc == 0u) { xcd_barrier_complete(bar, b.x, nloc, nx); b.st[0] = nloc; b.st[1] = nx; }
        const unsigned old = xb_add(&bar[XB_XSUB(b.x)], 1u);
        const unsigned gen = old / nloc;
        if (old + 1u == (gen + 1u) * nloc) {
            __builtin_amdgcn_fence(__ATOMIC_RELEASE, "agent");
            asm volatile("s_waitcnt vmcnt(0)" ::: "memory");
            const unsigned og = xb_add(&bar[XB_TOP], 1u);
            const unsigned tg = og / nx;
            if (og + 1u == (tg + 1u) * nx) xb_add(&bar[XB_TOPGEN], 1u);
            else XB_SPIN(xb_ld(&bar[XB_TOPGEN]) == tg, bar);
            __builtin_amdgcn_fence(__ATOMIC_ACQUIRE, "agent");
            xb_add(&bar[XB_XGEN(b.x)], 1u);
            asm volatile("s_waitcnt vmcnt(0)" ::: "memory");
        } else {
            XB_SPIN(xb_ld(&bar[XB_XGEN(b.x)]) == gen, bar);
            __builtin_amdgcn_fence(__ATOMIC_ACQUIRE, "agent");
            asm volatile("s_waitcnt vmcnt(0)" ::: "memory");
        }
    }
    __syncthreads();
}

namespace pg8 {
constexpr int BM = 256, BK = 64, HALF = 128, HTB = HALF * BK * 2, STAGE_BYTES = 8 * HTB, NXCD = 8, WGM = 8;
__host__ __device__ __forceinline__ int lds_byte(int r, int c) { const int st = (r >> 4) * 2 + (c >> 5), rr = r & 15, cc = c & 31, ob = rr * 64 + cc * 2; return st * 1024 + (ob ^ (((ob >> 9) & 1) << 5)); }
__host__ __device__ __forceinline__ void stage_rc(int b, int& R, int& C) { const int st = b / 1024, sb = b % 1024, swz = sb ^ (((sb >> 9) & 1) << 5); R = (st >> 1) * 16 + swz / 64; C = (st & 1) * 32 + (swz % 64) / 2; }
struct Unit { int pm, pn, e; };
typedef int v8i __attribute__((ext_vector_type(8)));
typedef int v4i __attribute__((ext_vector_type(4)));
#define HF_XSUB(j) (64 * (j))
#define HF_TOP     1024
__device__ __forceinline__ void handoff_signal(const XcdBarrier& b, unsigned* hw) {
    asm volatile("s_waitcnt vmcnt(0)" ::: "memory");
    __syncthreads();
    if (threadIdx.x == 0) {
        const unsigned nloc = b.st[0];
        const unsigned old = xb_add(&hw[HF_XSUB(b.x)], 1u);
        if (old + 1u == nloc) { __builtin_amdgcn_fence(__ATOMIC_RELEASE, "agent"); asm volatile("s_waitcnt vmcnt(0)" ::: "memory"); (void)xb_add(&hw[HF_TOP], 1u); }
    }
}
__device__ __forceinline__ void handoff_wait(const XcdBarrier& b, unsigned* hw) {
    if (threadIdx.x == 0) {
        const unsigned nx = b.st[1]; unsigned* bar = b.bar;
        XB_SPIN(xb_ld(&hw[HF_TOP]) < nx, bar);
        __builtin_amdgcn_fence(__ATOMIC_ACQUIRE, "agent");
        asm volatile("s_waitcnt vmcnt(0)" ::: "memory");
    }
    __syncthreads();
}
__device__ __forceinline__ void glds16_s(const char* gbase, unsigned voff, unsigned lds_dst) {
    asm volatile("s_mov_b32 m0, %2\n\ts_nop 0\n\tglobal_load_lds_dwordx4 %0, %1" : : "v"(voff), "s"(gbase), "s"(lds_dst) : "memory");
}
__device__ __forceinline__ void glds4_s(const void* gbase, unsigned voff, unsigned lds_dst) {
    unsigned keep;
    asm volatile("s_mov_b32 %0, m0\n\ts_mov_b32 m0, %3\n\ts_nop 0\n\tglobal_load_lds_dword %1, %2\n\ts_mov_b32 m0, %0" : "=&s"(keep) : "v"(voff), "s"(gbase), "s"(lds_dst) : "memory");
}
__device__ __forceinline__ v8i cat8(bf16x8 a, bf16x8 b) { const u32x4 x = __builtin_bit_cast(u32x4, a), y = __builtin_bit_cast(u32x4, b); return (v8i){(int)x.x, (int)x.y, (int)x.z, (int)x.w, (int)y.x, (int)y.y, (int)y.z, (int)y.w}; }
__device__ __forceinline__ void static_map(int L, int nM, int nN, int& pm, int& pn) {
    const int nwg = nM * nN; int wgid = L;
    { const int q = nwg / NXCD, r = nwg % NXCD, xcd = wgid % NXCD, off = wgid / NXCD; wgid = (xcd < r ? xcd * (q + 1) : r * (q + 1) + (xcd - r) * q) + off; }
    const int nig = WGM * nN, gid = wgid / nig, fm = gid * WGM, gsz = (nM - fm) < WGM ? (nM - fm) : WGM;
    pm = fm + ((wgid % nig) % gsz); pn = (wgid % nig) / gsz;
}
template <class Prob, bool ALIGN_EPI>
__device__ __forceinline__ void gemm_phase(LAS unsigned char* lds, const Prob& P) {
    constexpr int PEELQ = (Prob::FUSED2 || Prob::GATHER) ? 0 : 2;
    constexpr int KB = Prob::KB, nt = KB / (BK * 2);
    int tid_ = threadIdx.x; asm volatile("" : "+v"(tid_));
    const int tid = tid_, wid = __builtin_amdgcn_readfirstlane(tid >> 6), lane = tid & 63, wr = wid >> 2, wc = wid & 3, fr = lane & 15, fq = lane >> 4;
    unsigned voffA[2];
#pragma unroll
    for (int i = 0; i < 2; ++i) { int R, C; stage_rc(tid * 16 + i * 8192, R, C); voffA[i] = (unsigned)(R * KB + C * 2); }
    unsigned gcur[2][2];
#define PG8_GLOAD(dst, u_) do { if constexpr (Prob::GATHER) { const int* ri_ = P.rowidx(u_); _Pragma("unroll") for (int h_ = 0; h_ < 2; ++h_) _Pragma("unroll") for (int i_ = 0; i_ < 2; ++i_) { int R_, C_; stage_rc(tid * 16 + i_ * 8192, R_, C_); \
        dst[h_][i_] = (unsigned)ri_[h_ * HALF + R_] * (unsigned)KB + (unsigned)(C_ * 2); } } } while (0)
    const size_t kstep = (size_t)(BK * 2);
    const size_t hstep = (size_t)HALF * KB;
    const unsigned gmail = (unsigned)(unsigned long long)lds + (unsigned)STAGE_BYTES + (unsigned)wid * 1024u;
    const unsigned ldsb = (unsigned)(unsigned long long)lds + (unsigned)wid * 1024u;
    const int aoff = lds_byte(wr * 64 + fr, fq * 8), boff = lds_byte(wc * 32 + fr, fq * 8);
#define PG8_SA(b, h) (((b) * 2 + (h)) * HTB)
#define PG8_SB(b, h) ((4 + (b) * 2 + (h)) * HTB)
#define PG8_STAGE(bufoff, gbase, voff) do { _Pragma("unroll") for (int _i = 0; _i < 2; ++_i) glds16_s((gbase), (voff)[_i], ldsb + (unsigned)((bufoff) + _i * 8192)); } while (0)
#define PG8_STAGE_A(bufoff, kbase_, h_, nx_) do { if constexpr (Prob::GATHER) { _Pragma("unroll") for (int _i = 0; _i < 2; ++_i) glds16_s((kbase_), gcur[h_][_i], ldsb + (unsigned)((bufoff) + _i * 8192)); } \
        else PG8_STAGE(bufoff, (kbase_) + (h_) * hstep, voffA); } while (0)
#define PG8_LD8(p_) __builtin_shufflevector(*(const LAS v4i*)(p_), *(const LAS v4i*)((p_) + 1024), 0, 1, 2, 3, 4, 5, 6, 7)
#define PG8_LDA(dst, b, h) do { _Pragma("unroll") for (int m = 0; m < 4; ++m) dst[m] = PG8_LD8(lds + PG8_SA(b, h) + aoff + m * 2048); } while (0)
#define PG8_LDB(dst, b, h) do { _Pragma("unroll") for (int n = 0; n < 2; ++n) dst[n] = PG8_LD8(lds + PG8_SB(b, h) + boff + n * 2048); } while (0)
#define PG8_LO(v_) __builtin_bit_cast(bf16x8, __builtin_shufflevector(v_, v_, 0, 1, 2, 3))
#define PG8_HI(v_) __builtin_bit_cast(bf16x8, __builtin_shufflevector(v_, v_, 4, 5, 6, 7))
#define PG8_MMA(ai, bj, At, Bt) do { __builtin_amdgcn_s_setprio(1); _Pragma("unroll") for (int m = 0; m < 4; ++m) _Pragma("unroll") for (int n = 0; n < 2; ++n) { \
        if constexpr (Prob::FP8) { acc[ai][bj][m][n] = __builtin_amdgcn_mfma_scale_f32_16x16x128_f8f6f4(Bt[n], At[m], acc[ai][bj][m][n], 0, 0, 0, 0x7F7F7F7F, 0, 0x7F7F7F7F); } \
        else { acc[ai][bj][m][n] = __builtin_amdgcn_mfma_f32_16x16x32_bf16(PG8_LO(Bt[n]), PG8_LO(At[m]), acc[ai][bj][m][n], 0, 0, 0); \
               acc[ai][bj][m][n] = __builtin_amdgcn_mfma_f32_16x16x32_bf16(PG8_HI(Bt[n]), PG8_HI(At[m]), acc[ai][bj][m][n], 0, 0, 0); } } __builtin_amdgcn_s_setprio(0); } while (0)
#define PG8_MMAZ(ai, bj, At, Bt) do { const f32x4 z4_ = (f32x4){0.f, 0.f, 0.f, 0.f}; __builtin_amdgcn_s_setprio(1); _Pragma("unroll") for (int m = 0; m < 4; ++m) _Pragma("unroll") for (int n = 0; n < 2; ++n) { \
        if constexpr (Prob::FP8) { acc[ai][bj][m][n] = __builtin_amdgcn_mfma_scale_f32_16x16x128_f8f6f4(Bt[n], At[m], z4_, 0, 0, 0, 0x7F7F7F7F, 0, 0x7F7F7F7F); } \
        else { acc[ai][bj][m][n] = __builtin_amdgcn_mfma_f32_16x16x32_bf16(PG8_LO(Bt[n]), PG8_LO(At[m]), z4_, 0, 0, 0); \
               acc[ai][bj][m][n] = __builtin_amdgcn_mfma_f32_16x16x32_bf16(PG8_HI(Bt[n]), PG8_HI(At[m]), acc[ai][bj][m][n], 0, 0, 0); } } __builtin_amdgcn_s_setprio(0); } while (0)
#define PG8_WAIT_V(n) asm volatile("s_waitcnt vmcnt(" #n ")" ::: "memory")
#define PG8_WAIT_L(n) asm volatile("s_waitcnt lgkmcnt(" #n ")" ::: "memory")
#define PG8_BAR __builtin_amdgcn_s_barrier()
#define PG8_SCHED __builtin_amdgcn_sched_barrier(0)
    Unit cur, nxt; int ui = 0;
    if (!P.next(0, cur)) return;
    f32x4 acc[2][2][4][2];
#pragma unroll
    for (int a = 0; a < 2; ++a)
#pragma unroll
        for (int b = 0; b < 2; ++b)
#pragma unroll
            for (int m = 0; m < 4; ++m)
#pragma unroll
                for (int n = 0; n < 2; ++n) acc[a][b][m][n] = (f32x4){0.f, 0.f, 0.f, 0.f};
    v8i At[4], B0[2], B1[2];
    const char* cA = P.aptr(cur); const char* cB = P.bptr(cur);
    PG8_GLOAD(gcur, cur);
    PG8_STAGE(PG8_SB(0, 0), cB, voffA); PG8_STAGE(PG8_SB(0, 1), cB + hstep, voffA); PG8_STAGE_A(PG8_SA(0, 0), cA, 0, false); PG8_STAGE_A(PG8_SA(0, 1), cA, 1, false);
    if (wr == 1) PG8_BAR;
    PG8_WAIT_V(2); PG8_BAR;
    PG8_STAGE(PG8_SB(1, 0), cB + kstep, voffA); PG8_STAGE_A(PG8_SA(1, 0), cA + kstep, 0, false); PG8_STAGE(PG8_SB(1, 1), cB + hstep + kstep, voffA);
    PG8_WAIT_V(6); PG8_BAR;
    for (;;) {
        const bool has_next = P.next(ui + 1, nxt);
        const char* nA = has_next ? P.aptr(nxt) : cA; const char* nB = has_next ? P.bptr(nxt) : cB;
        if constexpr (Prob::GATHER) { if (has_next) {
            const int* ri_ = P.rowidx(nxt);
#pragma unroll
            for (int h_ = 0; h_ < 2; ++h_)
#pragma unroll
                for (int i_ = 0; i_ < 2; ++i_) { int R_, C_; stage_rc(tid * 16 + i_ * 8192, R_, C_); glds4_s(ri_, (unsigned)((h_ * HALF + R_) * 4), gmail + (unsigned)((2 * h_ + i_) * 256)); } } }
#define PG8_ITER(MM1_, MM2_) { \
            const bool last = (t == nt - 2); \
            const char* a1 = cA + (size_t)(t + 1) * kstep; \
            const char* a2 = last ? nA : cA + (size_t)(t + 2) * kstep; const char* b2 = last ? nB : cB + (size_t)(t + 2) * kstep; \
            const char* a3 = a2 + kstep; const char* b3 = b2 + kstep; \
            const bool nx = last && has_next; \
            PG8_STAGE_A(PG8_SA(1, 1), a1, 1, false); PG8_SCHED; PG8_LDB(B0, 0, 0); PG8_LDB(B1, 0, 1); PG8_SCHED; PG8_LDA(At, 0, 0); \
            if constexpr (Prob::GATHER) { if (nx) { \
            _Pragma("unroll") \
                for (int h_ = 0; h_ < 2; ++h_) \
            _Pragma("unroll") \
                    for (int i_ = 0; i_ < 2; ++i_) { int R_, C_; stage_rc(tid * 16 + i_ * 8192, R_, C_); \
                        gcur[h_][i_] = *(volatile LAS unsigned*)(lds + STAGE_BYTES + wid * 1024 + (2 * h_ + i_) * 256 + lane * 4) * (unsigned)KB + (unsigned)(C_ * 2); } } } \
            PG8_WAIT_V(8); PG8_WAIT_L(0); PG8_BAR; MM1_(0, 0, At, B0); MM1_(0, 1, At, B1); PG8_BAR; PG8_SCHED; \
            PG8_STAGE(PG8_SB(0, 0), b2, voffA); PG8_STAGE(PG8_SB(0, 1), b2 + hstep, voffA); PG8_STAGE_A(PG8_SA(0, 0), a2, 0, nx); PG8_SCHED; PG8_LDA(At, 0, 1); \
            PG8_WAIT_V(8); PG8_WAIT_L(0); PG8_BAR; MM2_(1, 0, At, B0); MM2_(1, 1, At, B1); PG8_BAR; PG8_SCHED; \
            PG8_STAGE_A(PG8_SA(0, 1), a2, 1, nx); PG8_SCHED; PG8_LDB(B0, 1, 0); PG8_LDB(B1, 1, 1); PG8_SCHED; PG8_LDA(At, 1, 0); \
            PG8_WAIT_V(8); PG8_WAIT_L(0); PG8_BAR; PG8_MMA(0, 0, At, B0); PG8_MMA(0, 1, At, B1); PG8_BAR; PG8_SCHED; \
            PG8_STAGE(PG8_SB(1, 0), b3, voffA); PG8_STAGE(PG8_SB(1, 1), b3 + hstep, voffA); PG8_STAGE_A(PG8_SA(1, 0), a3, 0, nx); PG8_SCHED; PG8_LDA(At, 1, 1); \
            PG8_WAIT_V(8); PG8_WAIT_L(0); PG8_BAR; PG8_MMA(1, 0, At, B0); PG8_MMA(1, 1, At, B1); PG8_BAR; PG8_SCHED; \
        }
        if constexpr (PEELQ == 2) {
            { constexpr int t = 0; PG8_ITER(PG8_MMAZ, PG8_MMAZ) }
#pragma nounroll
            for (int t = 2; t < nt; t += 2) PG8_ITER(PG8_MMA, PG8_MMA)
        } else if constexpr (PEELQ == 1) {
            { constexpr int t = 0; PG8_ITER(PG8_MMAZ, PG8_MMA) }
#pragma nounroll
            for (int t = 2; t < nt; t += 2) PG8_ITER(PG8_MMA, PG8_MMA)
        } else {
#pragma nounroll
            for (int t = 0; t < nt; t += 2) PG8_ITER(PG8_MMA, PG8_MMA)
        }
#undef PG8_ITER
        if constexpr (ALIGN_EPI) { if (wr == 0) PG8_BAR; }
        bool keep = false;
        { int fr_ = fr, fq_ = fq; asm volatile("" : "+v"(fr_), "+v"(fq_));
          if constexpr (Prob::FUSED2) keep = P.epi2(acc, cur, wr, wc, fr_, fq_); else P.epi(acc, cur, wr, wc, fr_, fq_); }
        if (!has_next) break;
        if (PEELQ < 2 && !keep) {
#pragma unroll
        for (int a = PEELQ; a < 2; ++a)
#pragma unroll
            for (int b = 0; b < 2; ++b)
#pragma unroll
                for (int m = 0; m < 4; ++m)
#pragma unroll
                    for (int n = 0; n < 2; ++n) acc[a][b][m][n] = (f32x4){0.f, 0.f, 0.f, 0.f};
        }
        cur = nxt; cA = nA; cB = nB; ++ui;
        if constexpr (ALIGN_EPI) { if (wr == 1) PG8_BAR; }
    }
    PG8_WAIT_V(0);
    if constexpr (!ALIGN_EPI) { if (wr == 0) PG8_BAR; }
    PG8_BAR;
#undef PG8_SA
#undef PG8_SB
#undef PG8_STAGE
#undef PG8_STAGE_A
#undef PG8_GLOAD
#undef PG8_LDA
#undef PG8_LDB
#undef PG8_LD8
#undef PG8_LO
#undef PG8_HI
#undef PG8_MMA
#undef PG8_MMAZ
#undef PG8_WAIT_V
#undef PG8_WAIT_L
#undef PG8_BAR
#undef PG8_SCHED
}
}
using pg8::Unit;

struct Args { const float* in[25]; float* out; unsigned char* ws; int ph_lo, ph_hi; };
struct Ctx {
    const float* const* in; float* out; unsigned char* ws;
    LAS unsigned char* lds; int tid, lane, wave, G, bid;
};
__device__ __forceinline__ Ctx fresh(const Ctx& c0) {
    Ctx c = c0; int t = threadIdx.x; asm volatile("" : "+v"(t)); c.tid = t; c.lane = t & 63; c.wave = __builtin_amdgcn_readfirstlane(t >> 6); return c;
}
enum { I_X = 0, I_C, I_CTX, I_CCTX, I_ADAW, I_ADAB, I_NMG, I_WIN, I_SINK, I_CONVW, I_CONVB, I_LWA, I_LBA, I_LWX, I_LBX, I_LAM, I_WABR, I_WRBR, I_WOUT, I_NFG, I_WROUTER, I_WGATE, I_WUP, I_WDOWN, I_FNG };

#define EPI_LOOP_ROWS _Pragma("unroll") for (int ai = 0; ai < 2; ++ai) _Pragma("unroll") for (int m = 0; m < 4; ++m)

__host__ __device__ __forceinline__ int ropedim(int s) { const int wc = s >> 5, n = (s >> 4) & 1, fq = (s >> 2) & 3, i = s & 3, p = 16 * wc + 4 * fq + i; return 64 * (p >> 5) + (p & 31) + 32 * n; }

#define FENCE() asm volatile("" ::: "memory")
constexpr float W8_SCALE = 64.0f, W8_INV = 1.0f / 64.0f, YE_SCALE = 16.0f, YE_INV = 1.0f / 16.0f;
struct ProbIn {
    static constexpr int K = 1024, KB = 2048; static constexpr bool FP8 = false, GATHER = false, FUSED2 = false;
    unsigned char* ws; int G, c, nM, nLat, nCtx;
    __device__ __forceinline__ bool next(int i, Unit& u) const {
        long L = (long)i * G + c; u.e = 0;
        if (L < nLat) { int pm, pn; pg8::static_map((int)L, nM, 13, pm, pn); u.pm = pm; u.pn = pn < 5 ? pn : pn + 1; return true; }
        L -= nLat; if (L >= nCtx) return false;
        u.pm = 128 + (int)(L % 16); const int idx = (int)(L / 16); u.pn = idx == 0 ? 4 : 5 + idx; return true;
    }
    __device__ __forceinline__ const char* aptr(const Unit& u) const { return (const char*)(ws + WS_H) + (size_t)u.pm * 256 * K * 2; }
    __device__ __forceinline__ const char* bptr(const Unit& u) const { return (const char*)(ws + WS_WIN) + (size_t)u.pn * 256 * K * 2; }
    __device__ __forceinline__ void epi(const f32x4 (&acc)[2][2][4][2], const Unit& u, int wr, int wc, int fr, int fq) const {
        const int pn = u.pn; const int row0 = u.pm * 256 + wr * 64 + fr, lc = wc * 32 + 4 * fq;
        if (pn <= 4) {
            bf16* base = (bf16*)(ws + (pn < 4 ? WS_Q : WS_K)); const int ldc = pn < 4 ? 1024 : 256, cb = (pn < 4 ? pn * 256 : 0) + lc;
            const bool lat = u.pm < 128; const int i0 = 16 * (wc & 1) + 4 * fq;
            const float* COS = (const float*)(ws + WS_COS); const float* SIN = (const float*)(ws + WS_SIN);
            EPI_LOOP_ROWS {
                const int row = row0 + ai * 128 + m * 16;
                f32x4 cs = (f32x4){1.f, 1.f, 1.f, 1.f}, sn = (f32x4){0.f, 0.f, 0.f, 0.f};
                if (lat) { const int t = row & 2047, pos = wc < 2 ? (t >> 6) : (t & 63); cs = *(const f32x4*)(COS + pos * 32 + i0); sn = *(const f32x4*)(SIN + pos * 32 + i0); }
#pragma unroll
                for (int bj = 0; bj < 2; ++bj) {
                    const f32x4 x1 = acc[ai][bj][m][0], x2 = acc[ai][bj][m][1];
                    const f32x4 o1 = x1 * cs - x2 * sn, o2 = x1 * sn + x2 * cs;
                    bf16* p = base + (size_t)row * ldc + cb + bj * 128;
                    *(u32x2*)p = pk4(o1); *(u32x2*)(p + 16) = pk4(o2);
                }
                FENCE();
            }
        } else {
            size_t off; int cb; int mode;
            if (pn <= 9) { off = WS_U; cb = (pn - 6) * 256; mode = 0; }
            else { off = WS_GZ; cb = (pn - 10) * 256; mode = 1; }
            bf16* base = (bf16*)(ws + off);
            cb += wc * 64 + 16 * fq;
            EPI_LOOP_ROWS {
                const int row = row0 + ai * 128 + m * 16;
#pragma unroll
                for (int bj = 0; bj < 2; ++bj) { f32x4 v0 = acc[ai][bj][m][0], v1 = acc[ai][bj][m][1];
                    if (mode == 1) { const f32x2 a = gelu2((f32x2){v0[0], v0[1]}), b = gelu2((f32x2){v0[2], v0[3]}), c2 = gelu2((f32x2){v1[0], v1[1]}), d = gelu2((f32x2){v1[2], v1[3]}); v0 = (f32x4){a.x, a.y, b.x, b.y}; v1 = (f32x4){c2.x, c2.y, d.x, d.y}; }
                    const u32x2 a = pk4(v0), b = pk4(v1);
                    *(u32x4*)(base + (size_t)row * 1024 + cb + bj * 8) = (u32x4){a.x, a.y, b.x, b.y}; }
                FENCE();
            }
        }
    }
};
struct ProbIn8 {
    static constexpr int KB = 1024; static constexpr bool FP8 = true, GATHER = false, FUSED2 = false;
    unsigned char* ws; int G, c, nM; bool bal;
    __device__ __forceinline__ bool next(int i, Unit& u) const { long L = (long)i * G + c;
        if (bal) { if (i >= 3) { if (c < 96 || i > 4 || (i == 4 && c >= 192)) return false; L = (i == 3 ? 768 : 928) + (c - 96); } }
        if (L >= nM * 8) return false; int pm, pn; pg8::static_map((int)L, nM, 8, pm, pn); u.pm = pm; u.pn = pn; u.e = 0; return true; }
    __device__ __forceinline__ const char* aptr(const Unit& u) const { return (const char*)(ws + WS_H8) + (size_t)u.pm * 256 * KB; }
    __device__ __forceinline__ const char* bptr(const Unit& u) const { return (const char*)(ws + WS_WIN8) + (size_t)u.pn * 256 * KB; }
    __device__ __forceinline__ void epi(const f32x4 (&acc)[2][2][4][2], const Unit& u, int wr, int wc, int fr, int fq) const {
        const int row0 = u.pm * 256 + wr * 64 + fr; const int cb = (u.pn & 3) * 256 + wc * 64 + 16 * fq;
        bf16* base = (bf16*)(ws + (u.pn < 4 ? WS_SMA : WS_SMR));
        EPI_LOOP_ROWS {
            const int row = row0 + ai * 128 + m * 16;
#pragma unroll
            for (int bj = 0; bj < 2; ++bj) { const f32x4 v0 = acc[ai][bj][m][0], v1 = acc[ai][bj][m][1]; const float ks = -1.4426950408889634f * W8_INV;
                const f32x2 a = sigmoid2k((f32x2){v0[0], v0[1]}, ks), b = sigmoid2k((f32x2){v0[2], v0[3]}, ks), c2 = sigmoid2k((f32x2){v1[0], v1[1]}, ks), d = sigmoid2k((f32x2){v1[2], v1[3]}, ks);
                const u32x2 p = pk4((f32x4){a.x, a.y, b.x, b.y}), q = pk4((f32x4){c2.x, c2.y, d.x, d.y});
                *(u32x4*)(base + (size_t)row * 1024 + cb + bj * 8) = (u32x4){p.x, p.y, q.x, q.y}; }
            FENCE();
        }
    }
};
struct ProbVt {
    static constexpr int K = 1024, KB = 2048; static constexpr bool FP8 = false, GATHER = false, FUSED2 = false;
    unsigned char* ws; int G, c; bool bal;
    __device__ __forceinline__ bool next(int i, Unit& u) const { int L = i * G + (G - 1 - c); if (bal) L = i > 0 ? 144 : (c >= 208 ? c - 208 : (c < 96 ? 48 + c : 144)); if (L >= 144) return false; u.pm = 0; u.pn = L; u.e = 0; return true; }
    __device__ __forceinline__ const char* aptr(const Unit&) const { return (const char*)(ws + WS_WIN) + (size_t)1280 * 1024 * 2; }
    __device__ __forceinline__ const char* bptr(const Unit& u) const { return (const char*)(ws + WS_H) + (size_t)u.pn * 256 * K * 2; }
    __device__ __forceinline__ void epi(const f32x4 (&acc)[2][2][4][2], const Unit& u, int wr, int wc, int fr, int fq) const {
        const int row0 = wr * 64 + fr, cb = u.pn * 256 + wc * 32 + 4 * fq; bf16* Vt = (bf16*)(ws + WS_VT);
        EPI_LOOP_ROWS { const int row = row0 + ai * 128 + m * 16;
#pragma unroll
            for (int bj = 0; bj < 2; ++bj)
#pragma unroll
                for (int n = 0; n < 2; ++n) *(u32x2*)(Vt + (size_t)row * NROW + cb + bj * 128 + n * 16) = pk4(acc[ai][bj][m][n]); }
    }
};
template <int MODE> struct ProbMerge {
    static constexpr int K = 1024, KB = 2048; static constexpr bool FP8 = false, GATHER = false, FUSED2 = false;
    unsigned char* ws; int G, c, nM, l; const float* xin; const float* cin;
    int ubeg, ustride, ucnt;
    __device__ __forceinline__ bool next(int i, Unit& u) const { if (i >= ucnt) return false; const int L = ubeg + i * ustride; if (L >= nM * 4) return false;
        int pm, pn; if (L < 512) pg8::static_map(L, 128, 4, pm, pn); else { pm = 128 + ((L - 512) & 15); pn = (L - 512) >> 4; } u.pm = pm; u.pn = pn; u.e = 0; return true; }
    __device__ __forceinline__ const char* aptr(const Unit& u) const { return (const char*)(ws + (MODE == 0 ? WS_H : MODE == 1 ? WS_REC : WS_GZ)) + (size_t)u.pm * 256 * K * 2; }
    __device__ __forceinline__ const char* bptr(const Unit& u) const { return (const char*)(ws + (MODE == 0 ? WS_WA : MODE == 1 ? WS_WR : WS_WO)) + (size_t)u.pn * 256 * K * 2; }
    __device__ __forceinline__ void epi(const f32x4 (&acc)[2][2][4][2], const Unit& u, int wr, int wc, int fr, int fq) const {
        const int row0 = u.pm * 256 + wr * 64 + fr, cb = u.pn * 256 + wc * 64 + 16 * fq;
        const int r = u.pm < 128 ? (u.pm >> 3) : 16;
        const bf16* S = (const bf16*)(ws + (MODE == 0 ? WS_SMA : WS_SMR)); bf16* T1 = (bf16*)(ws + WS_T1); bf16* MRG = (bf16*)(ws + WS_GZ); bf16* X = (bf16*)(ws + WS_X);
        const float* gate = (const float*)(ws + WS_MOD) + (size_t)(l * 17 + r) * 6144 + 2048;
        const float* RB = (u.pm < 128 ? xin : cin - (size_t)NLAT * D);
        u32x4 svn[2], tvn[2]; f32x4 rbn[2][2];
#define MG_LOAD(g_) do { const int row_ = row0 + ((g_) >> 2) * 128 + ((g_) & 3) * 16; _Pragma("unroll") for (int bj_ = 0; bj_ < 2; ++bj_) { const size_t o_ = (size_t)row_ * 1024 + cb + bj_ * 8; \
            if (MODE != 2) svn[bj_] = *(const u32x4*)(S + o_); if (MODE == 1) tvn[bj_] = *(const u32x4*)(T1 + o_); \
            if (MODE == 2) { if (l == 0) { rbn[bj_][0] = *(const f32x4*)(RB + o_); rbn[bj_][1] = *(const f32x4*)(RB + o_ + 4); } \
                             else { const u32x4 xb_ = *(const u32x4*)(X + o_); rbn[bj_][0] = unpk4((u32x2){xb_.x, xb_.y}); rbn[bj_][1] = unpk4((u32x2){xb_.z, xb_.w}); } } } } while (0)
        f32x4 gt[2][2];
        if (MODE == 2) {
#pragma unroll
            for (int bj = 0; bj < 2; ++bj) { gt[bj][0] = *(const f32x4*)(gate + cb + bj * 8); gt[bj][1] = *(const f32x4*)(gate + cb + bj * 8 + 4); } }
        MG_LOAD(0);
#pragma unroll
        for (int g = 0; g < 8; ++g) { const int ai = g >> 2, m = g & 3; const int row = row0 + ai * 128 + m * 16;
            u32x4 sv[2], tv[2]; f32x4 rb[2][2];
#pragma unroll
            for (int bj = 0; bj < 2; ++bj) { sv[bj] = svn[bj]; tv[bj] = tvn[bj]; rb[bj][0] = rbn[bj][0]; rb[bj][1] = rbn[bj][1]; }
            if (g + 1 < 8) MG_LOAD(g + 1);
#pragma unroll
            for (int bj = 0; bj < 2; ++bj) {
                const size_t o = (size_t)row * 1024 + cb + bj * 8; const f32x4 a0 = acc[ai][bj][m][0], a1 = acc[ai][bj][m][1];
                if (MODE == 0) { const u32x2 p = pk4(a0 * unpk4((u32x2){sv[bj].x, sv[bj].y})), q = pk4(a1 * unpk4((u32x2){sv[bj].z, sv[bj].w})); *(u32x4*)(T1 + o) = (u32x4){p.x, p.y, q.x, q.y}; }
                else if (MODE == 1) { const u32x2 p = pk4(unpk4((u32x2){tv[bj].x, tv[bj].y}) + a0 * unpk4((u32x2){sv[bj].x, sv[bj].y})), q = pk4(unpk4((u32x2){tv[bj].z, tv[bj].w}) + a1 * unpk4((u32x2){sv[bj].z, sv[bj].w})); *(u32x4*)(MRG + o) = (u32x4){p.x, p.y, q.x, q.y}; }
                else { const u32x2 p = pk4(rb[bj][0] + gt[bj][0] * a0), q = pk4(rb[bj][1] + gt[bj][1] * a1); *(u32x4*)(X + o) = (u32x4){p.x, p.y, q.x, q.y}; }
            }
            FENCE();
        }
#undef MG_LOAD
    }
};
struct ProbMerge01 {
    static constexpr int K = 1024, KB = 2048; static constexpr bool FP8 = false, GATHER = false, FUSED2 = true;
    unsigned char* ws; int G, c, nM, pbeg, pend;
    __device__ __forceinline__ bool next(int i, Unit& u) const { const int p = pbeg + (i >> 1); if (p >= pend) return false; const int L = p * G + c; if (L >= nM * 4) return false;
        int pm, pn; if (L < 512) pg8::static_map(L, 128, 4, pm, pn); else { pm = 128 + ((L - 512) & 15); pn = (L - 512) >> 4; } u.pm = pm; u.pn = pn; u.e = i & 1; return true; }
    __device__ __forceinline__ const char* aptr(const Unit& u) const { return (const char*)(ws + (u.e == 0 ? WS_H : WS_REC)) + (size_t)u.pm * 256 * K * 2; }
    __device__ __forceinline__ const char* bptr(const Unit& u) const { return (const char*)(ws + (u.e == 0 ? WS_WA : WS_WR)) + (size_t)u.pn * 256 * K * 2; }
    static __device__ __forceinline__ f32x4 clampsr(u32x2 w) { const f32x4 v = unpk4(w); return (f32x4){__builtin_fmaxf(v[0], 1e-18f), __builtin_fmaxf(v[1], 1e-18f), __builtin_fmaxf(v[2], 1e-18f), __builtin_fmaxf(v[3], 1e-18f)}; }
    __device__ __forceinline__ bool epi2(f32x4 (&acc)[2][2][4][2], const Unit& u, int wr, int wc, int fr, int fq) const {
        const int row0 = u.pm * 256 + wr * 64 + fr, cb = u.pn * 256 + wc * 64 + 16 * fq;
        const bf16* SA = (const bf16*)(ws + WS_SMA); const bf16* SR = (const bf16*)(ws + WS_SMR); bf16* MRG = (bf16*)(ws + WS_GZ);
        const bool first = (u.e == 0);
        u32x4 san[2], srn[2];
#define MG_LOAD(g_) do { const int row_ = row0 + ((g_) >> 2) * 128 + ((g_) & 3) * 16; _Pragma("unroll") for (int bj_ = 0; bj_ < 2; ++bj_) { const size_t o_ = (size_t)row_ * 1024 + cb + bj_ * 8; \
            srn[bj_] = *(const u32x4*)(SR + o_); if (first) san[bj_] = *(const u32x4*)(SA + o_); } } while (0)
        MG_LOAD(0);
#pragma unroll
        for (int g = 0; g < 8; ++g) { const int ai = g >> 2, m = g & 3; const int row = row0 + ai * 128 + m * 16;
            u32x4 sa[2], sr[2];
#pragma unroll
            for (int bj = 0; bj < 2; ++bj) { sa[bj] = san[bj]; sr[bj] = srn[bj]; }
            if (g + 1 < 8) MG_LOAD(g + 1);
#pragma unroll
            for (int bj = 0; bj < 2; ++bj) {
                const f32x4 r0 = clampsr((u32x2){sr[bj].x, sr[bj].y}), r1 = clampsr((u32x2){sr[bj].z, sr[bj].w});
                if (first) {
                    const f32x4 q0 = (f32x4){__builtin_amdgcn_rcpf(r0[0]), __builtin_amdgcn_rcpf(r0[1]), __builtin_amdgcn_rcpf(r0[2]), __builtin_amdgcn_rcpf(r0[3])};
                    const f32x4 q1 = (f32x4){__builtin_amdgcn_rcpf(r1[0]), __builtin_amdgcn_rcpf(r1[1]), __builtin_amdgcn_rcpf(r1[2]), __builtin_amdgcn_rcpf(r1[3])};
                    acc[ai][bj][m][0] = acc[ai][bj][m][0] * (unpk4((u32x2){sa[bj].x, sa[bj].y}) * q0);
                    acc[ai][bj][m][1] = acc[ai][bj][m][1] * (unpk4((u32x2){sa[bj].z, sa[bj].w}) * q1);
                } else {
                    const u32x2 p = pk4(acc[ai][bj][m][0] * r0), q = pk4(acc[ai][bj][m][1] * r1);
                    *(u32x4*)(MRG + (size_t)row * 1024 + cb + bj * 8) = (u32x4){p.x, p.y, q.x, q.y};
                }
            }
            FENCE();
        }
#undef MG_LOAD
        return first;
    }
};
__device__ __forceinline__ bool grouped_next(int i, int G, int c, int nPM, int nPN, Unit& u) {
    const int nloc = G / 8, x = c & 7, loc = c >> 3; const int per = nPM * nPN; const long L = (long)i * nloc + loc;
    if (L >= 2 * per) return false;
    u.e = 2 * x + (int)(L / per); const int rem = (int)(L % per);
    const int nig = 8 * nPN, gid = rem / nig, fm = gid * 8, gsz = (nPM - fm) < 8 ? (nPM - fm) : 8;
    u.pm = fm + ((rem % nig) % gsz); u.pn = (rem % nig) / gsz; return true;
}
struct ProbUp {
    static constexpr int KB = 1024; static constexpr bool FP8 = true, GATHER = true, FUSED2 = false;
    unsigned char* ws; int G, c, Me, l;
    __device__ __forceinline__ bool next(int i, Unit& u) const { return grouped_next(i, G, c, Me / 256, 16, u); }
    __device__ __forceinline__ const char* aptr(const Unit&) const { return (const char*)(ws + WS_H); }
    __device__ __forceinline__ const int* rowidx(const Unit& u) const { return (const int*)(ws + WS_ROWIDX) + (size_t)u.e * Me + (size_t)u.pm * 256; }
    __device__ __forceinline__ const char* bptr(const Unit& u) const { return (const char*)(ws + ws_wgu(l)) + ((size_t)u.e * 4096 + (size_t)u.pn * 256) * KB; }
    __device__ __forceinline__ void epi(const f32x4 (&acc)[2][2][4][2], const Unit& u, int wr, int wc, int fr, int fq) const {
        const size_t row0 = (size_t)u.e * Me + u.pm * 256 + wr * 64 + fr; const int cb = u.pn * 128 + wc * 32 + 8 * fq; unsigned char* HID = ws + WS_HID;
        EPI_LOOP_ROWS { const size_t row = row0 + ai * 128 + m * 16; u32x2 wv;
#pragma unroll
            for (int bj = 0; bj < 2; ++bj) { const f32x4 g = acc[ai][bj][m][0], up = acc[ai][bj][m][1]; f32x4 h;
#pragma unroll
                for (int i = 0; i < 4; i += 2) { const f32x2 g2 = (f32x2){g[i], g[i + 1]}, hh = (g2 * (f32x2){up[i], up[i + 1]}) * (sigmoid2k(g2, -1.4426950408889634f * W8_INV) * (W8_INV * W8_INV)); h[i] = hh.x; h[i + 1] = hh.y; }
                int w = 0; w = __builtin_amdgcn_cvt_pk_fp8_f32(h[0], h[1], w, false); w = __builtin_amdgcn_cvt_pk_fp8_f32(h[2], h[3], w, true);
                if (bj == 0) wv.x = (unsigned)w; else wv.y = (unsigned)w; }
            *(u32x2*)(HID + row * 2048 + cb) = wv; }
    }
};
struct ProbDown {
    static constexpr int KB = 2048; static constexpr bool FP8 = true, GATHER = false, FUSED2 = false;
    unsigned char* ws; int G, c, Me, l;
    __device__ __forceinline__ bool next(int i, Unit& u) const { return grouped_next(i, G, c, Me / 256, 4, u); }
    __device__ __forceinline__ const char* aptr(const Unit& u) const { return (const char*)(ws + WS_HID) + ((size_t)u.e * Me + (size_t)u.pm * 256) * KB; }
    __device__ __forceinline__ const char* bptr(const Unit& u) const { return (const char*)(ws + ws_wdn(l)) + ((size_t)u.e * 1024 + (size_t)u.pn * 256) * KB; }
    __device__ __forceinline__ void epi(const f32x4 (&acc)[2][2][4][2], const Unit& u, int wr, int wc, int fr, int fq) const {
        const size_t row0 = (size_t)u.e * Me + u.pm * 256 + wr * 64 + fr; const int cb = u.pn * 256 + wc * 64 + 16 * fq; unsigned char* YE = ws + WS_YE; const float* GV = (const float*)(ws + WS_GVAL);
        float gv[8];
#pragma unroll
        for (int g8 = 0; g8 < 8; ++g8) gv[g8] = GV[row0 + (g8 >> 2) * 128 + (g8 & 3) * 16];
        EPI_LOOP_ROWS { const size_t row = row0 + ai * 128 + m * 16; const float g = gv[ai * 4 + m] * (W8_INV * YE_SCALE); u32x4 wv;
#pragma unroll
            for (int bj = 0; bj < 2; ++bj)
#pragma unroll
                for (int n = 0; n < 2; ++n) { const f32x4 v = acc[ai][bj][m][n] * g; int w = 0; w = __builtin_amdgcn_cvt_pk_fp8_f32(v[0], v[1], w, false); w = __builtin_amdgcn_cvt_pk_fp8_f32(v[2], v[3], w, true); wv[2 * bj + n] = (unsigned)w; }
            *(u32x4*)(YE + row * 1024 + cb) = wv; }
    }
};

template <class ColPtr>
__device__ __forceinline__ void tr_item(const ColPtr& cp, int K, bf16* WT, int item, int nblk, LAS float* scr, int lane) {
    const int kb = item / nblk, nb = item % nblk, k0 = 64 * kb, n0 = 32 * nb;
    size_t stride; const float* src = cp(n0 + (lane & 31), stride) + (size_t)k0 * stride;
    float tv[32];
#pragma unroll
    for (int i = 0; i < 32; ++i) tv[i] = src[(size_t)(2 * i + (lane >> 5)) * stride];
#pragma unroll
    for (int i = 0; i < 32; ++i) scr[(2 * i + (lane >> 5)) * 33 + (lane & 31)] = tv[i];
    asm volatile("s_waitcnt lgkmcnt(0)" ::: "memory");
    const int c = lane & 7;
#pragma unroll
    for (int j = 0; j < 4; ++j) { const int n = (lane >> 3) + 8 * j; const LAS float* s = scr + (8 * c) * 33 + n;
        u32x4 o; o.x = pk2(s[0 * 33], s[1 * 33]); o.y = pk2(s[2 * 33], s[3 * 33]); o.z = pk2(s[4 * 33], s[5 * 33]); o.w = pk2(s[6 * 33], s[7 * 33]);
        *(u32x4*)(WT + (size_t)(n0 + n) * K + k0 + 8 * c) = o; }
    asm volatile("s_waitcnt lgkmcnt(0)" ::: "memory");
}
template <class ColPtr>
__device__ __forceinline__ void tr_item8(const ColPtr& cp, int K, unsigned char* WT, int item, int nblk, LAS float* scr, int lane, float scale) {
    const int kb = item / nblk, nb = item % nblk, k0 = 128 * kb, n0 = 32 * nb;
    size_t stride; const float* src = cp(n0 + (lane & 31), stride) + (size_t)k0 * stride;
    const float* rp = src + (size_t)(lane >> 5) * stride;
#pragma unroll
    for (int hb = 0; hb < 2; ++hb) { float tv[32];
#pragma unroll
        for (int i = 0; i < 32; ++i) { tv[i] = *rp; rp += 2 * stride; }
#pragma unroll
        for (int i = 0; i < 32; ++i) scr[(64 * hb + 2 * i + (lane >> 5)) * 33 + (lane & 31)] = tv[i];
        asm volatile("" ::: "memory"); }
    asm volatile("s_waitcnt lgkmcnt(0)" ::: "memory");
    const int c = lane & 7;
#pragma unroll
    for (int j = 0; j < 4; ++j) { const int n = (lane >> 3) + 8 * j; const LAS float* s = scr + (16 * c) * 33 + n; u32x4 o;
#pragma unroll
        for (int q = 0; q < 4; ++q) { int w = 0; w = __builtin_amdgcn_cvt_pk_fp8_f32(s[(4 * q) * 33] * scale, s[(4 * q + 1) * 33] * scale, w, false); w = __builtin_amdgcn_cvt_pk_fp8_f32(s[(4 * q + 2) * 33] * scale, s[(4 * q + 3) * 33] * scale, w, true); o[q] = (unsigned)w; }
        *(u32x4*)(WT + (size_t)(n0 + n) * K + k0 + 16 * c) = o; asm volatile("" ::: "memory"); }
    asm volatile("s_waitcnt lgkmcnt(0)" ::: "memory");
}
__host__ __device__ __forceinline__ int sig16(int s) { return 64 * ((s >> 5) & 3) + 16 * ((s >> 2) & 3) + 8 * (s >> 7) + 4 * ((s >> 4) & 1) + (s & 3); }
struct ColIn { const float* W; __device__ __forceinline__ const float* operator()(int n, size_t& stride) const { stride = INW; int col = n; if (n < 1280) col = (n & ~127) + ropedim(n & 127); else if (n >= 1536) col = (n & ~255) + sig16(n & 255); return W + col; } };
struct ColIn8 { const float* W; __device__ __forceinline__ const float* operator()(int n, size_t& stride) const { stride = INW; return W + 3584 + (n & ~255) + sig16(n & 255); } };
struct ColPlain { const float* W; int N; __device__ __forceinline__ const float* operator()(int n, size_t& stride) const { stride = (size_t)N; return W + n; } };
struct ColP16 { const float* W; int N; __device__ __forceinline__ const float* operator()(int n, size_t& stride) const { stride = (size_t)N; return W + (n & ~255) + sig16(n & 255); } };
struct ColGU { const float* Wg; const float* Wu; __device__ __forceinline__ const float* operator()(int n, size_t& stride) const { stride = DE;
    const int hc = 128 * (n >> 8) + 32 * ((n >> 5) & 3) + 8 * ((n >> 2) & 3) + 4 * ((n >> 7) & 1) + (n & 3);
    const unsigned long long d = (unsigned long long)Wu - (unsigned long long)Wg; return (const float*)((unsigned long long)Wg + (((n >> 4) & 1) ? d : 0ull)) + hc; } };

constexpr int CT_P = 257;
__device__ __forceinline__ void convert_moe_tiles(const Ctx& c, int l, int wg_first = 0, int wg_count = 0) {
    LAS float* T = (LAS float*)c.lds;
    constexpr int T_GU = NE * 8 * 16, T_DN = NE * 16 * 4;
    const int nwg_ = wg_count ? wg_count : c.G;
    for (int tile = c.bid - wg_first; tile < T_GU + T_DN; tile += nwg_) {
        const bool gu = tile < T_GU; const int tt = gu ? tile : tile - T_GU;
        const int e = gu ? tt >> 7 : tt >> 6, kt = gu ? (tt >> 4) & 7 : (tt >> 2) & 15, pn = gu ? tt & 15 : tt & 3;
        const int K = gu ? D : DE, N = gu ? DE : D, k0 = 128 * kt;
        const float* W0 = gu ? c.in[I_WGATE] + ((size_t)l * NE + e) * D * DE : c.in[I_WDOWN] + ((size_t)l * NE + e) * DE * D;
        const float* W1 = gu ? c.in[I_WUP] + ((size_t)l * NE + e) * D * DE : W0;
        f32x4 ld[16];
#pragma unroll
        for (int i = 0; i < 16; ++i) { const int g = c.tid + 512 * i, k = g >> 6, c4 = g & 63;
            const float* src = gu ? ((c4 < 32 ? W0 : W1) + (size_t)(k0 + k) * N + 128 * pn + 4 * (c4 & 31)) : (W0 + (size_t)(k0 + k) * N + 256 * pn + 4 * c4);
            ld[i] = *(const f32x4*)src; }
#pragma unroll
        for (int i = 0; i < 16; ++i) { const int g = c.tid + 512 * i, k = g >> 6, c4 = g & 63; LAS float* t = T + k * CT_P + 4 * c4; t[0] = ld[i][0]; t[1] = ld[i][1]; t[2] = ld[i][2]; t[3] = ld[i][3]; }
        __syncthreads();
        unsigned char* WT = gu ? c.ws + ws_wgu(l) + ((size_t)e * 4096 + 256 * pn) * D : c.ws + ws_wdn(l) + ((size_t)e * 1024 + 256 * pn) * DE;
#pragma unroll
        for (int j = 0; j < 4; ++j) { const int q = c.tid + 512 * j, n = q >> 3, ch = q & 7;
            const int sc = gu ? 128 * ((n >> 4) & 1) + 32 * ((n >> 5) & 3) + 8 * ((n >> 2) & 3) + 4 * (n >> 7) + (n & 3) : sig16(n);
            const LAS float* t = T + (16 * ch) * CT_P + sc; u32x4 o;
#pragma unroll
            for (int w4 = 0; w4 < 4; ++w4) { int w = 0; w = __builtin_amdgcn_cvt_pk_fp8_f32(t[(4 * w4) * CT_P] * W8_SCALE, t[(4 * w4 + 1) * CT_P] * W8_SCALE, w, false); w = __builtin_amdgcn_cvt_pk_fp8_f32(t[(4 * w4 + 2) * CT_P] * W8_SCALE, t[(4 * w4 + 3) * CT_P] * W8_SCALE, w, true); o[w4] = (unsigned)w; }
            *(u32x4*)(WT + (size_t)n * K + k0 + 16 * ch) = o; }
        __syncthreads();
    }
}
__device__ __forceinline__ void phase_convert_weights(const Ctx& c0, int l, int wg_first = 0, int wg_count = 0) {
    const Ctx c = fresh(c0);
    LAS float* scr = (LAS float*)(c.lds + c.wave * 17408);
    const int gw = (c.bid - wg_first) * NWAVES + c.wave, NGW = (wg_count ? wg_count : c.G) * NWAVES;
    constexpr int I_IN = 16 * 112, I_IN8 = 8 * 64, I_SQ = 16 * 32;
    constexpr int I_LW = 32 * 8;
    constexpr int NITEMS = I_IN + I_IN8 + 3 * I_SQ + I_LW;
    for (int it = gw; it < NITEMS; it += NGW) {
        int r = it;
        if (r < I_IN) { ColIn cp{c.in[I_WIN] + (size_t)l * D * INW}; tr_item(cp, D, (bf16*)(c.ws + WS_WIN), r, 112, scr, c.lane); continue; } r -= I_IN;
        if (r < I_IN8) { ColIn8 cp{c.in[I_WIN] + (size_t)l * D * INW}; tr_item8(cp, D, c.ws + WS_WIN8, r, 64, scr, c.lane, W8_SCALE); continue; } r -= I_IN8;
        if (r < I_SQ) { ColP16 cp{c.in[I_WABR] + (size_t)l * D * D, D}; tr_item(cp, D, (bf16*)(c.ws + WS_WA), r, 32, scr, c.lane); continue; } r -= I_SQ;
        if (r < I_SQ) { ColP16 cp{c.in[I_WRBR] + (size_t)l * D * D, D}; tr_item(cp, D, (bf16*)(c.ws + WS_WR), r, 32, scr, c.lane); continue; } r -= I_SQ;
        if (r < I_SQ) { ColP16 cp{c.in[I_WOUT] + (size_t)l * D * D, D}; tr_item(cp, D, (bf16*)(c.ws + WS_WO), r, 32, scr, c.lane); continue; } r -= I_SQ;
        { const int mat = r >> 3, g = mat & 1, dn = mat >> 1;
          ColPlain cp{c.in[g ? I_LWX : I_LWA] + ((size_t)l * 16 + dn) * 16384, 128}; tr_item(cp, 128, (bf16*)(c.ws + WS_LW) + (size_t)mat * 16384, r & 7, 4, scr, c.lane); }
    }
}
__device__ __forceinline__ void phase_convert_moe(const Ctx& c0, int l, int wg_first = 0, int wg_count = 0) { const Ctx c = fresh(c0); __syncthreads(); convert_moe_tiles(c, l, wg_first, wg_count); __syncthreads(); }
__device__ __forceinline__ void phase_mod(const Ctx& c0) {
    const Ctx c = fresh(c0);
    LAS float* sc = (LAS float*)c.lds; LAS float* red = (LAS float*)(c.lds + 17 * 1024 * 4);
    for (int i = c.tid; i < 17 * 1024; i += NTHR) { const int r = i >> 10, k = i & 1023; const float v = r < 16 ? c.in[I_C][r * 1024 + k] : c.in[I_CCTX][k]; sc[i] = v / (1.0f + expf(-v)); }
    __syncthreads();
    float* MOD = (float*)(c.ws + WS_MOD);
    for (int item = c.bid; item < 2 * 96; item += c.G) {
        const int l = item / 96, n0 = (item % 96) * 64;
        const float* w = c.in[I_ADAW] + (size_t)l * D * 6144 + n0 + c.lane;
        float acc[17];
#pragma unroll
        for (int r = 0; r < 17; ++r) acc[r] = 0.f;
        const int k0 = c.wave * 128;
        for (int kb = 0; kb < 128; kb += 32) {
            float wv[32];
#pragma unroll
            for (int k = 0; k < 32; ++k) wv[k] = w[(size_t)(k0 + kb + k) * 6144];
#pragma unroll
            for (int k = 0; k < 32; ++k) {
#pragma unroll
                for (int r = 0; r < 17; ++r) acc[r] += sc[r * 1024 + k0 + kb + k] * wv[k]; }
        }
#pragma unroll
        for (int r = 0; r < 17; ++r) red[(c.wave * 17 + r) * 64 + c.lane] = acc[r];
        __syncthreads();
        for (int i = c.tid; i < 17 * 64; i += NTHR) { const int r = i >> 6, ln = i & 63; float s = 0.f;
#pragma unroll
            for (int w8 = 0; w8 < 8; ++w8) s += red[(w8 * 17 + r) * 64 + ln];
            MOD[(size_t)(l * 17 + r) * 6144 + n0 + ln] = s + c.in[I_ADAB][l * 6144 + n0 + ln]; }
        __syncthreads();
    }
    float* COS = (float*)(c.ws + WS_COS); float* SIN = (float*)(c.ws + WS_SIN);
    for (int i = c.bid * NTHR + c.tid; i < 64 * 32; i += c.G * NTHR) { const int pos = i >> 5, k = i & 31; const float fr = powf(10000.0f, -(float)k / 32.0f), ang = (float)pos * fr; COS[i] = cosf(ang); SIN[i] = sinf(ang); }
}

__device__ __forceinline__ void phase_norm1(const Ctx& c0, int l) {
    const Ctx c = fresh(c0);
    const bool fin = (l == DEPTH);
    const int gw = c.bid * NWAVES + c.wave, NGW = c.G * NWAVES, nrows = fin ? NLAT : NROW;
    const float* MOD = (const float*)(c.ws + WS_MOD); bf16* X = (bf16*)(c.ws + WS_X); bf16* H = (bf16*)(c.ws + WS_H);
    const short* SLOT = (const short*)(c.ws + WS_SLOT); const unsigned char* YE = c.ws + WS_YE;
    int cur_r = -1; f32x4 al[4], be[4];
    if (l == 0) {
        const f32x4* g = (const f32x4*)(c.in[I_NMG]);
        const int npair = NROW / 2, ppw = (npair + NGW - 1) / NGW, pbeg = gw * ppw, pend = (pbeg + ppw < npair) ? pbeg + ppw : npair;
        for (int rp = pbeg; rp < pend; ++rp) {
            f32x4 v[2][4];
#pragma unroll
            for (int k = 0; k < 2; ++k) { const int row = 2 * rp + k; const f32x4* src = (const f32x4*)(row < NLAT ? c.in[I_X] + (size_t)row * D : c.in[I_CTX] + (size_t)(row - NLAT) * D);
#pragma unroll
                for (int j = 0; j < 4; ++j) v[k][j] = src[c.lane + 64 * j]; }
            { const int row = 2 * rp, r = row < NLAT ? (row >> 11) : 16;
              if (r != cur_r) { cur_r = r; const float* mp = MOD + (size_t)r * 6144; const f32x4* sh = (const f32x4*)mp; const f32x4* scl = (const f32x4*)(mp + 1024);
#pragma unroll
                  for (int j = 0; j < 4; ++j) { const int q = c.lane + 64 * j; al[j] = g[q] * (scl[q] + 1.0f); be[j] = sh[q]; } } }
#pragma unroll
            for (int k = 0; k < 2; ++k) { const int row = 2 * rp + k; float ss = 0.f;
#pragma unroll
                for (int j = 0; j < 4; ++j) ss += (v[k][j][0] * v[k][j][0] + v[k][j][1] * v[k][j][1]) + (v[k][j][2] * v[k][j][2] + v[k][j][3] * v[k][j][3]);
                const float rstd = 1.0f / sqrtf(wave_sum(ss) * (1.0f / D) + EPS);
                u32x2* o = (u32x2*)(H + (size_t)row * D); unsigned* o8 = (unsigned*)(c.ws + WS_H8 + (size_t)row * D);
#pragma unroll
                for (int j = 0; j < 4; ++j) { const f32x4 hv = v[k][j] * rstd * al[j] + be[j]; o[c.lane + 64 * j] = pk4(hv); o8[c.lane + 64 * j] = f8x4(hv); } }
        }
        return;
    }
    const int MeP = (l - 1 == DEPTH - 1) ? 4096 : 4608;
    const int rpw = (nrows + NGW - 1) / NGW, rbeg = gw * rpw, rend = (rbeg + rpw < nrows) ? rbeg + rpw : nrows;
    f32x4 vn[4], g2v[4]; int slotn = -1;
    if (rbeg < rend) { const u32x2* src = (const u32x2*)(X + (size_t)rbeg * D);
#pragma unroll
        for (int j = 0; j < 4; ++j) vn[j] = unpk4(src[c.lane + 64 * j]);
        slotn = (int)SLOT[(size_t)rbeg * 16 + (c.lane & 15)]; }
    for (int row = rbeg; row < rend; ++row) {
        const int r = row < NLAT ? (row >> 11) : 16;
        f32x4 v[4];
#pragma unroll
        for (int j = 0; j < 4; ++j) v[j] = vn[j];
        const int myslot = slotn;
        { const int nr = row + 1; if (nr < rend) { const u32x2* src = (const u32x2*)(X + (size_t)nr * D);
#pragma unroll
            for (int j = 0; j < 4; ++j) vn[j] = unpk4(src[c.lane + 64 * j]);
            slotn = (int)SLOT[(size_t)nr * 16 + (c.lane & 15)]; } }
        if (r != cur_r) { cur_r = r; const f32x4* g2 = (const f32x4*)(MOD + (size_t)((l - 1) * 17 + r) * 6144 + 5120);
#pragma unroll
            for (int j = 0; j < 4; ++j) g2v[j] = g2[c.lane + 64 * j] * YE_INV;
            if (!fin) { const f32x4* g = (const f32x4*)(c.in[I_NMG] + l * D); const float* mp = MOD + (size_t)(l * 17 + r) * 6144; const f32x4* sh = (const f32x4*)mp; const f32x4* scl = (const f32x4*)(mp + 1024);
#pragma unroll
                for (int j = 0; j < 4; ++j) { const int q = c.lane + 64 * j; al[j] = g[q] * (scl[q] + 1.0f); be[j] = sh[q]; } }
            else { const f32x4* g = (const f32x4*)c.in[I_FNG];
#pragma unroll
                for (int j = 0; j < 4; ++j) al[j] = g[c.lane + 64 * j]; } }
        f32x4 a[4];
#pragma unroll
        for (int j = 0; j < 4; ++j) a[j] = (f32x4){0.f, 0.f, 0.f, 0.f};
        const int ybase = row < NLAT ? (row >> 11) * CAPL : 4096 + ((row - NLAT) >> 8) * CAPC;
        unsigned long long sel = __builtin_amdgcn_ballot_w64(myslot >= 0) & 0xFFFFull;
        while (sel) {
            const int e0 = __builtin_ctzll(sel); sel &= sel - 1; const bool two = sel != 0; const int e1 = two ? __builtin_ctzll(sel) : e0; if (two) sel &= sel - 1;
            const int s0 = __builtin_amdgcn_readlane(myslot, e0), s1 = __builtin_amdgcn_readlane(myslot, e1);
            const int* y0 = (const int*)(YE + ((size_t)e0 * MeP + ybase + s0) * D); const int* y1 = (const int*)(YE + ((size_t)e1 * MeP + ybase + s1) * D);
            int w0[4], w1[4];
#pragma unroll
            for (int j = 0; j < 4; ++j) { w0[j] = y0[c.lane + 64 * j]; w1[j] = y1[c.lane + 64 * j]; }
            const float k1 = two ? 1.0f : 0.0f;
#pragma unroll
            for (int j = 0; j < 4; ++j) { const f32x2 lo0 = __builtin_amdgcn_cvt_pk_f32_fp8(w0[j], false), hi0 = __builtin_amdgcn_cvt_pk_f32_fp8(w0[j], true), lo1 = __builtin_amdgcn_cvt_pk_f32_fp8(w1[j], false), hi1 = __builtin_amdgcn_cvt_pk_f32_fp8(w1[j], true);
                a[j] += (f32x4){lo0.x, lo0.y, hi0.x, hi0.y} + (f32x4){lo1.x, lo1.y, hi1.x, hi1.y} * k1; }
        }
#pragma unroll
        for (int j = 0; j < 4; ++j) v[j] += g2v[j] * a[j];
        if (!fin) { u32x2* dst = (u32x2*)(X + (size_t)row * D);
#pragma unroll
            for (int j = 0; j < 4; ++j) dst[c.lane + 64 * j] = pk4(v[j]); }
        float ss = 0.f;
#pragma unroll
        for (int j = 0; j < 4; ++j) ss += (v[j][0] * v[j][0] + v[j][1] * v[j][1]) + (v[j][2] * v[j][2] + v[j][3] * v[j][3]);
        const float rstd = 1.0f / sqrtf(wave_sum(ss) * (1.0f / D) + EPS);
        if (fin) { f32x4* o = (f32x4*)(c.out + (size_t)row * D);
#pragma unroll
            for (int j = 0; j < 4; ++j) o[c.lane + 64 * j] = v[j] * rstd * al[j];
        } else { u32x2* o = (u32x2*)(H + (size_t)row * D); unsigned* o8 = (unsigned*)(c.ws + WS_H8 + (size_t)row * D);
#pragma unroll
            for (int j = 0; j < 4; ++j) { const f32x4 hv = v[j] * rstd * al[j] + be[j]; o[c.lane + 64 * j] = pk4(hv); o8[c.lane + 64 * j] = f8x4(hv); } }
    }
}
constexpr int F1_P = 1028;
__device__ __forceinline__ void phase_norm2(const Ctx& c0, int l) {
    const Ctx c = fresh(c0);
    LAS float* T = (LAS float*)c.lds;
    LAS float* PART = T + 16 * F1_P;
    LAS float* RS = PART + 8 * 256;
    LAS float* CP = RS + 16;
    const int nrows = (l == DEPTH - 1) ? NLAT : NROW, ntile = nrows / 16;
    const int tpw = (ntile + c.G - 1) / c.G, tbeg = c.bid * tpw, tend = (tbeg + tpw < ntile) ? tbeg + tpw : ntile;
    const float* MOD = (const float*)(c.ws + WS_MOD); const bf16* X = (const bf16*)(c.ws + WS_X); unsigned char* H = c.ws + WS_H; float* AFF = (float*)(c.ws + WS_AFF);
    const float* WR = c.in[I_WROUTER] + (size_t)l * 16384; const float* GF = c.in[I_NFG] + l * D;
    const int tid = c.tid, lane = c.lane, w = c.wave, e16 = lane & 15, kk = lane >> 4;
    u32x4 ld[4];
#define F1_LOAD(t_, tq_) do { const u32x4* src_ = (const u32x4*)(X + (size_t)(t_) * 16 * D) + (tq_); _Pragma("unroll") for (int i_ = 0; i_ < 4; ++i_) ld[i_] = src_[512 * i_]; } while (0)
    if (tbeg < tend) F1_LOAD(tbeg, tid);
    float Breg[32]; float creg = 0.f; int cur_r = -1;
    f32x4 al4 = (f32x4){0.f, 0.f, 0.f, 0.f}, be4 = al4;
    for (int t = tbeg; t < tend; ++t) {
        int tq = tid; asm volatile("" : "+v"(tq));
        const int row0 = t * 16, r = row0 < NLAT ? (row0 >> 11) : 16;
#pragma unroll
        for (int i = 0; i < 4; ++i) { const int g = tq + 512 * i; LAS f32x4* tp = (LAS f32x4*)(T + (g >> 7) * F1_P + 8 * (g & 127)); tp[0] = unpk4((u32x2){ld[i].x, ld[i].y}); tp[1] = unpk4((u32x2){ld[i].z, ld[i].w}); }
        if (t + 1 < tend) F1_LOAD(t + 1, tq);
        const float* mp = MOD + (size_t)(l * 17 + r) * 6144;
        const bool newr = (r != cur_r);
        if (newr) { cur_r = r;
            float cpart = 0.f;
#pragma unroll
            for (int s4 = 0; s4 < 32; ++s4) { const int k = 128 * w + 4 * s4 + kk; const float wv = WR[k * 16 + e16]; Breg[s4] = GF[k] * (mp[4096 + k] + 1.0f) * wv; cpart += mp[3072 + k] * wv; if ((s4 & 3) == 3) asm volatile("" ::: "memory"); }
            CP[(w * 4 + kk) * 16 + e16] = cpart;
            { const int c4 = tq & 255; const f32x4 gf = *(const f32x4*)(GF + 4 * c4), sc = *(const f32x4*)(mp + 4096 + 4 * c4), sh = *(const f32x4*)(mp + 3072 + 4 * c4); al4 = gf * (sc + 1.0f); be4 = sh; } }
        __syncthreads();
#pragma unroll
        for (int k2 = 0; k2 < 2; ++k2) { const int row = 2 * w + k2; float ss = 0.f;
#pragma unroll
            for (int j = 0; j < 4; ++j) { const f32x4 x = *(const LAS f32x4*)(T + row * F1_P + 4 * (lane + 64 * j)); ss += (x[0] * x[0] + x[1] * x[1]) + (x[2] * x[2] + x[3] * x[3]); }
            ss = wave_sum(ss); if (lane == 0) RS[row] = 1.0f / sqrtf(ss * (1.0f / D) + EPS); }
        f32x4 acc = (f32x4){0.f, 0.f, 0.f, 0.f};
#pragma unroll
        for (int s4 = 0; s4 < 32; ++s4) { acc = __builtin_amdgcn_mfma_f32_16x16x4f32(T[e16 * F1_P + 128 * w + 4 * s4 + kk], Breg[s4], acc, 0, 0, 0);
            if ((s4 & 7) == 7) asm volatile("" ::: "memory"); }
#pragma unroll
        for (int i = 0; i < 4; ++i) PART[w * 256 + (4 * kk + i) * 16 + e16] = acc[i];
        __syncthreads();
        if (tq < 256) { const int row = tq >> 4, e = tq & 15; float sum = 0.f, cc = 0.f;
#pragma unroll
            for (int w8 = 0; w8 < 8; ++w8) sum += PART[w8 * 256 + row * 16 + e];
            if (newr) {
#pragma unroll
                for (int q = 0; q < 32; ++q) cc += CP[q * 16 + e];
                creg = cc; }
            const float lg = RS[row] * sum + creg;
            float mx = lg; mx = fmaxf(mx, __shfl_xor(mx, 1)); mx = fmaxf(mx, __shfl_xor(mx, 2)); mx = fmaxf(mx, __shfl_xor(mx, 4)); mx = fmaxf(mx, __shfl_xor(mx, 8));
            const float ex = expf(lg - mx); float sm = ex; sm += __shfl_xor(sm, 1); sm += __shfl_xor(sm, 2); sm += __shfl_xor(sm, 4); sm += __shfl_xor(sm, 8);
            AFF[(size_t)(row0 + row) * 16 + e] = ex / sm; }
#pragma unroll
        for (int i = 0; i < 8; ++i) { const int g = tq + 512 * i, row = g >> 8, c4 = g & 255; const f32x4 x = *(const LAS f32x4*)(T + row * F1_P + 4 * c4);
            const f32x4 hv = x * RS[row] * al4 + be4;
            int wv = 0; wv = __builtin_amdgcn_cvt_pk_fp8_f32(hv[0], hv[1], wv, false); wv = __builtin_amdgcn_cvt_pk_fp8_f32(hv[2], hv[3], wv, true);
            *(int*)(H + (size_t)(row0 + row) * D + 4 * c4) = wv; if (i & 1) asm volatile("" ::: "memory"); }
        __syncthreads();
    }
#undef F1_LOAD
}
__device__ __forceinline__ void phase_topk(const Ctx& c0, int l) {
    const Ctx c = fresh(c0);
    LAS unsigned long long* keys = (LAS unsigned long long*)c.lds;
    const float* AFF = (const float*)(c.ws + WS_AFF); int* ROWIDX = (int*)(c.ws + WS_ROWIDX); float* GVAL = (float*)(c.ws + WS_GVAL); short* SLOT = (short*)(c.ws + WS_SLOT);
    const bool last = (l == DEPTH - 1); const int Me = last ? 4096 : 4608; const int nitems = last ? 256 : 512;
    for (int item = c.bid; item < nitems; item += c.G) {
        const bool isctx = item >= 256; const int b = (item & 255) >> 4, e = item & 15;
        const int n = isctx ? CTXL : SEQ, cap = isctx ? CAPC : CAPL, rbase = isctx ? NLAT + b * CTXL : b * SEQ;
        for (int t = c.tid; t < n; t += NTHR) { const unsigned a = __builtin_bit_cast(unsigned, AFF[(size_t)(rbase + t) * 16 + e]); keys[t] = ((unsigned long long)a << 32) | (unsigned long long)(0xFFFFFFFFu - (unsigned)t); }
        __syncthreads();
        for (int k = 2; k <= n; k <<= 1) {
            if ((k >> 1) > 32) __syncthreads();
            for (int lj = 31 - __builtin_clz(k >> 1); lj >= 0; --lj) { const int j = 1 << lj;
                for (int i = c.tid; i < n / 2; i += NTHR) { const int ix = ((i >> lj) << (lj + 1)) | (i & (j - 1)), iy = ix + j; const unsigned long long a = keys[ix], bb = keys[iy]; const bool up = (ix & k) == 0;
                    if (up ? (a < bb) : (a > bb)) { keys[ix] = bb; keys[iy] = a; } }
                if (j > 32) __syncthreads(); else asm volatile("s_waitcnt lgkmcnt(0)" ::: "memory");
            } }
        __syncthreads();
        const int ybase = e * Me + (isctx ? 4096 + b * CAPC : b * CAPL);
        for (int p = c.tid; p < n; p += NTHR) { const unsigned long long kv = keys[p]; const int t = (int)(0xFFFFFFFFu - (unsigned)(kv & 0xFFFFFFFFull));
            SLOT[(size_t)(rbase + t) * 16 + e] = (short)(p < cap ? p : -1);
            if (p < cap) { ROWIDX[ybase + p] = rbase + t; GVAL[ybase + p] = __builtin_bit_cast(float, (unsigned)(kv >> 32)); } }
        __syncthreads();
    }
}
typedef float f32x16 __attribute__((ext_vector_type(16)));
constexpr int AT_KP = 272, AT_VP = 144, AT_KB = 64 * AT_KP, AT_VB = 128 * AT_VP;
__device__ __forceinline__ void phase_attn(const Ctx& c0, int l, int r_lo, int r_hi) {
    const Ctx c = fresh(c0);
    const bool lastl = (l == DEPTH - 1); const int nitems = lastl ? 1024 : 1152;
    const bf16* Q = (const bf16*)(c.ws + WS_Q); const bf16* Kb = (const bf16*)(c.ws + WS_K); const bf16* Vt = (const bf16*)(c.ws + WS_VT); bf16* ATT = (bf16*)(c.ws + WS_H);
    const int w = c.wave, lane = c.lane, lq = lane & 31, h = lane >> 5, tid = c.tid;
    const float scale2 = 0.08838834764831845f * 1.4426950408889634f;
    for (int item = c.bid + c.G * r_lo; item < nitems && item < c.bid + c.G * r_hi; item += c.G) {
        int b, n, kvh, hp; bool isctx;
        if (item < 1024) { int it = item;
            if (c.G == 256) { const int x = item & 7, j = ((item & 255) >> 3) + 32 * (item >> 8); it = (2 * x + (j >> 6)) * 64 + (j & 63); }
            b = it >> 6; n = (it >> 2) & 15; kvh = (it >> 1) & 1; hp = it & 1; isctx = false; }
        else { const int it = item - 1024; b = it >> 3; kvh = (it >> 2) & 1; hp = (it >> 1) & 1; n = it & 1; isctx = true; }
        const int qw = (w & 3) ^ ((w >> 2) << 1);
        const int head = kvh * 4 + hp * 2 + (w >> 2), qi = qw * 32 + lq;
        const int qrow = (isctx ? NLAT + b * CTXL : b * SEQ) + n * 128 + qi;
        const int tlo = isctx ? 0 : (n == 0 ? 2 : 0), nband = isctx ? 0 : ((n == 15 ? 4 : 6) - tlo), ntile = nband + 4;
        bf16x8 qf[8];
        { const u32x4* qp = (const u32x4*)(Q + (size_t)qrow * 1024 + head * 128 + 8 * h);
#pragma unroll
            for (int ks = 0; ks < 8; ++ks) qf[ks] = __builtin_bit_cast(bf16x8, qp[2 * ks]); }
        f32x16 O[4];
#pragma unroll
        for (int dt = 0; dt < 4; ++dt)
#pragma unroll
            for (int r = 0; r < 16; ++r) O[dt][r] = 0.f;
        float mrun = c.in[I_SINK][l * 8 + head] * (1.4426950408889634f / scale2), lsum = (h == 0) ? 1.0f : 0.0f;
        u32x4 kreg[2], vreg[2];
        auto tile_row0 = [&](int i) -> int { return i < nband ? b * SEQ + (n - 1) * 128 + (tlo + i) * 64 : NLAT + b * CTXL + (i - nband) * 64; };
#define AT_LOAD(i_) do { const int r0_ = tile_row0(i_); _Pragma("unroll") for (int i2 = 0; i2 < 2; ++i2) { const int cidx = tid + 512 * i2; \
            kreg[i2] = *(const u32x4*)(Kb + (size_t)(r0_ + (cidx >> 4)) * 256 + kvh * 128 + (cidx & 15) * 8); \
            vreg[i2] = *(const u32x4*)(Vt + (size_t)(kvh * 128 + (cidx >> 3)) * NROW + r0_ + (cidx & 7) * 8); } } while (0)
#define AT_STORE(buf_) do { _Pragma("unroll") for (int i2 = 0; i2 < 2; ++i2) { const int cidx = tid + 512 * i2; \
            *(LAS u32x4*)(c.lds + (buf_) * AT_KB + (cidx >> 4) * AT_KP + (cidx & 15) * 16) = kreg[i2]; \
            LAS u32x2* vp_ = (LAS u32x2*)(c.lds + 2 * AT_KB + (buf_) * AT_VB + (cidx >> 3) * AT_VP + ((cidx & 7) >> 1) * 32 + (cidx & 1) * 8); \
            vp_[0] = (u32x2){vreg[i2].x, vreg[i2].y}; vp_[2] = (u32x2){vreg[i2].z, vreg[i2].w}; } } while (0)
        AT_LOAD(0); AT_STORE(0);
        __syncthreads();
        for (int i = 0; i < ntile; ++i) {
            const int buf = i & 1;
            if (i + 1 < ntile) AT_LOAD(i + 1);
            const int tau = i < nband ? tlo + i : 2;
            const int mtype = tau >> 1, kbase = (tau & 1) * 64;
            const LAS unsigned char* Kl = c.lds + buf * AT_KB; const LAS unsigned char* Vl = c.lds + 2 * AT_KB + buf * AT_VB;
            const int ks0 = (tau & 1) * 2;
            const bool d0 = (mtype == 0 && ks0 < qw) || (mtype == 2 && ks0 > qw), d1 = (mtype == 0 && ks0 + 1 < qw) || (mtype == 2 && ks0 + 1 > qw);
            if (!(d0 && d1)) {
            f32x16 S[2];
#pragma unroll
            for (int sub = 0; sub < 2; ++sub) { if (sub ? d1 : d0) continue;
#pragma unroll
                for (int r = 0; r < 16; ++r) S[sub][r] = 0.f;
#pragma unroll
                for (int ks = 0; ks < 8; ++ks) { const bf16x8 kf = *(const LAS bf16x8*)(Kl + (sub * 32 + lq) * AT_KP + ks * 32 + h * 16);
                    S[sub] = __builtin_amdgcn_mfma_f32_32x32x16_bf16(kf, qf[ks], S[sub], 0, 0, 0); }
            }
            float mx = -INFINITY;
            if (mtype != 1) {
#pragma unroll
                for (int sub = 0; sub < 2; ++sub) if (ks0 + sub == qw)
#pragma unroll
                    for (int r = 0; r < 16; ++r) { const int kj = kbase + sub * 32 + (r & 3) + 8 * (r >> 2) + 4 * h; const bool valid = (mtype == 0) ? (kj >= qi) : (kj <= qi); S[sub][r] = valid ? S[sub][r] : -INFINITY; } }
#pragma unroll
            for (int sub = 0; sub < 2; ++sub) if (!(sub ? d1 : d0))
#pragma unroll
                for (int r = 0; r < 16; r += 2) mx = fmaxf(mx, fmaxf(S[sub][r], S[sub][r + 1]));
            mx = fmaxf(mx, __shfl_xor(mx, 32));
            const float mnew = fmaxf(mrun, mx), alpha = __builtin_amdgcn_exp2f((mrun - mnew) * scale2); mrun = mnew;
            const f32x2 nms = (f32x2){-mnew * scale2, -mnew * scale2};
            f32x2 ps2 = (f32x2){0.f, 0.f};
#pragma unroll
            for (int sub = 0; sub < 2; ++sub) if (!(sub ? d1 : d0))
#pragma unroll
                for (int r = 0; r < 16; r += 2) { const f32x2 a2 = (f32x2){S[sub][r], S[sub][r + 1]} * scale2 + nms; const f32x2 p2 = (f32x2){__builtin_amdgcn_exp2f(a2.x), __builtin_amdgcn_exp2f(a2.y)}; S[sub][r] = p2.x; S[sub][r + 1] = p2.y; ps2 += p2; }
            const float psum = ps2.x + ps2.y;
            lsum = lsum * alpha + psum;
#pragma unroll
            for (int dt = 0; dt < 4; ++dt) O[dt] = O[dt] * alpha;
#pragma unroll
            for (int sub = 0; sub < 2; ++sub) if (!(sub ? d1 : d0))
#pragma unroll
                for (int s2 = 0; s2 < 2; ++s2) {
                    u32x4 pw; pw.x = pk2(S[sub][8 * s2 + 0], S[sub][8 * s2 + 1]); pw.y = pk2(S[sub][8 * s2 + 2], S[sub][8 * s2 + 3]); pw.z = pk2(S[sub][8 * s2 + 4], S[sub][8 * s2 + 5]); pw.w = pk2(S[sub][8 * s2 + 6], S[sub][8 * s2 + 7]);
                    const bf16x8 pf = __builtin_bit_cast(bf16x8, pw);
                    const int kb2 = (sub * 2 + s2) * 32 + h * 16;
#pragma unroll
                    for (int dt = 0; dt < 4; ++dt) { const bf16x8 vf = *(const LAS bf16x8*)(Vl + (32 * dt + lq) * AT_VP + kb2);
                        O[dt] = __builtin_amdgcn_mfma_f32_32x32x16_bf16(vf, pf, O[dt], 0, 0, 0); }
                }
            }
            if (i + 1 < ntile) AT_STORE(buf ^ 1);
            __syncthreads();
        }
#undef AT_LOAD
#undef AT_STORE
        const float inv = 1.0f / (lsum + __shfl_xor(lsum, 32));
        bf16* op = ATT + (size_t)qrow * 1024 + head * 128 + 4 * h;
#pragma unroll
        for (int dt = 0; dt < 4; ++dt)
#pragma unroll
            for (int g = 0; g < 4; ++g) { u32x2 wv; wv.x = pk2(O[dt][4 * g] * inv, O[dt][4 * g + 1] * inv); wv.y = pk2(O[dt][4 * g + 2] * inv, O[dt][4 * g + 3] * inv); *(u32x2*)(op + 32 * dt + 8 * g) = wv; }
    }
}

constexpr int RG_UP = 272;
template <bool REV> __device__ __forceinline__ void rg_scan(const float (&a)[4][4], float (&bc)[4][4], float& H, int q, const int (&baddr)[4]) {
    float A4[4], B4[4];
#pragma unroll
    for (int tt = 0; tt < 4; ++tt) { float A = 1.f, B = 0.f;
#pragma unroll
        for (int ri = 0; ri < 4; ++ri) { const int r = REV ? 3 - ri : ri; B = a[tt][r] * B + bc[tt][r]; A *= a[tt][r]; }
        A4[tt] = A; B4[tt] = B; }
    float Ag[4][4], Bg[4][4];
#pragma unroll
    for (int tt = 0; tt < 4; ++tt)
#pragma unroll
        for (int qq = 0; qq < 4; ++qq) { Ag[tt][qq] = __builtin_bit_cast(float, __builtin_amdgcn_ds_bpermute(baddr[qq], __builtin_bit_cast(int, A4[tt]))); Bg[tt][qq] = __builtin_bit_cast(float, __builtin_amdgcn_ds_bpermute(baddr[qq], __builtin_bit_cast(int, B4[tt]))); }
    const int g0 = REV ? 3 : 0, g1 = REV ? 2 : 1, g2 = REV ? 1 : 2, g3 = REV ? 0 : 3;
    const int rank = REV ? 3 - q : q;
#pragma unroll
    for (int tti = 0; tti < 4; ++tti) { const int tt = REV ? 3 - tti : tti;
        const float A1 = Ag[tt][g1] * Ag[tt][g0], B1 = Ag[tt][g1] * Bg[tt][g0] + Bg[tt][g1];
        const float A2 = Ag[tt][g2] * A1, B2 = Ag[tt][g2] * B1 + Bg[tt][g2];
        const float A3 = Ag[tt][g3] * A2, B3 = Ag[tt][g3] * B2 + Bg[tt][g3];
        float myA = rank == 1 ? Ag[tt][g0] : 1.f, myB = rank == 1 ? Bg[tt][g0] : 0.f;
        myA = rank == 2 ? A1 : myA; myB = rank == 2 ? B1 : myB; myA = rank == 3 ? A2 : myA; myB = rank == 3 ? B2 : myB;
        float hc = myA * H + myB;
#pragma unroll
        for (int ri = 0; ri < 4; ++ri) { const int r = REV ? 3 - ri : ri; hc = a[tt][r] * hc + bc[tt][r]; bc[tt][r] = hc; }
        H = A3 * H + B3;
    }
}
__device__ __forceinline__ void phase_rglru(const Ctx& c0, int l) {
    const Ctx c = fresh(c0);
    const bool lastl = (l == DEPTH - 1);
    LAS unsigned char* UC = c.lds; LAS unsigned char* HS = c.lds + 2 * 64 * RG_UP;
    const bf16* U = (const bf16*)(c.ws + WS_U); const bf16* GZ = (const bf16*)(c.ws + WS_GZ); bf16* REC = (bf16*)(c.ws + WS_REC); const bf16* LW = (const bf16*)(c.ws + WS_LW);
    const int tid = c.tid, lane = c.lane, w = c.wave, dir = w >> 2, cg = w & 3, chl = lane & 15, q = lane >> 4;
    for (int item0 = c.bid; item0 < 256; item0 += c.G) {
        const int item = (c.G == 256) ? (item0 & 7) * 32 + (item0 >> 3) : item0;
        const int b = item >> 4, nb = (item >> 1) & 7, half = item & 1, cbase = nb * 128, oc = 16 * cg + chl, och = half * 64 + oc, col = cbase + och;
        bf16x8 wf[2][4];
#pragma unroll
        for (int g = 0; g < 2; ++g)
#pragma unroll
            for (int ks = 0; ks < 4; ++ks) wf[g][ks] = *(const bf16x8*)(LW + (size_t)(((dir * 8 + nb) * 2 + g) * 128 + och) * 128 + 32 * ks + 8 * q);
        const float ba = c.in[I_LBA][(l * 2 + dir) * D + col], bx = c.in[I_LBX][(l * 2 + dir) * D + col];
        const float Kc = -8.0f * log1pf(expf(-c.in[I_LAM][(l * 2 + dir) * D + col])) * 1.4426950408889634f;
        f32x2 cw[4][4], cbias[4];
        const int c8 = tid & 15, tg = (tid >> 4) & 15, dcv = tid >> 8;
        {
#pragma unroll
            for (int p = 0; p < 4; ++p) { cbias[p] = (f32x2){c.in[I_CONVB][l * D + cbase + 8 * c8 + 2 * p], c.in[I_CONVB][l * D + cbase + 8 * c8 + 2 * p + 1]};
#pragma unroll
                for (int k = 0; k < 4; ++k) cw[k][p] = (f32x2){c.in[I_CONVW][(l * 4 + k) * D + cbase + 8 * c8 + 2 * p], c.in[I_CONVW][(l * 4 + k) * D + cbase + 8 * c8 + 2 * p + 1]}; } }
        float H = 0.f;
        int baddr[4];
#pragma unroll
        for (int qq = 0; qq < 4; ++qq) baddr[qq] = (chl + 16 * qq) * 4;
        u32x4 uraw[7];
#define RG_ULOAD(s_) do { const int tau_ = dcv == 0 ? (s_) : ((s_) < 4 ? 3 - (s_) : 39 - (s_)); const bool isc_ = tau_ < 4; const int T_ = isc_ ? CTXL : SEQ, ts0_ = (isc_ ? tau_ : tau_ - 4) * 64 + 4 * tg - 2; \
            const bf16* up_ = U + (size_t)((isc_ ? NLAT + b * CTXL : b * SEQ) + ts0_) * D + cbase + 8 * c8; \
            _Pragma("unroll") for (int i_ = 0; i_ < 7; ++i_) uraw[i_] = (ts0_ + i_ >= 0 && ts0_ + i_ < T_) ? *(const u32x4*)(up_ + (size_t)i_ * D) : (u32x4){0u, 0u, 0u, 0u}; } while (0)
        RG_ULOAD(0);
        for (int s = 0; s < 36; ++s) {
#pragma unroll
            for (int tk = 0; tk < 4; ++tk) {
                u32x4 pw;
#pragma unroll
                for (int p = 0; p < 4; ++p) {
                    f32x2 o = cbias[p];
#pragma unroll
                    for (int k = 0; k < 4; ++k) o = cw[k][p] * (f32x2){bf_lo(uraw[tk + k][p]), bf_hi(uraw[tk + k][p])} + o;
                    pw[p] = pk2(o.x, o.y); }
                *(LAS u32x4*)(UC + (dcv * 64 + 4 * tg + tk) * RG_UP + c8 * 16) = pw;
            }
            __syncthreads();
            if (s + 1 < 36) RG_ULOAD(s + 1);
            u32x4 rvp[2], zvp[2];
#pragma unroll
            for (int dc = 0; dc < 2; ++dc) {
                const int t = tid >> 3, o8 = tid & 7;
                const int tau = dc == 0 ? s : (s < 4 ? 3 - s : 39 - s);
                const int other = dc == 0 ? (tau < 4 ? 3 - tau : 39 - tau) : tau;
                rvp[dc] = (u32x4){0u, 0u, 0u, 0u}; zvp[dc] = (u32x4){0u, 0u, 0u, 0u};
                if (other < s && !(lastl && tau < 4)) { const int row = (tau < 4 ? NLAT + b * CTXL + tau * 64 : b * SEQ + (tau - 4) * 64) + t; const size_t o = (size_t)row * D + cbase + half * 64 + o8 * 8;
                    rvp[dc] = *(const u32x4*)(REC + o); zvp[dc] = *(const u32x4*)(GZ + o); }
            }
            f32x4 gr[4], gi[4];
#pragma unroll
            for (int tt = 0; tt < 4; ++tt) { gr[tt] = (f32x4){0.f, 0.f, 0.f, 0.f}; gi[tt] = (f32x4){0.f, 0.f, 0.f, 0.f}; }
#pragma unroll
            for (int tt = 0; tt < 4; ++tt)
#pragma unroll
                for (int ks = 0; ks < 4; ++ks) { const bf16x8 af = *(const LAS bf16x8*)(UC + (dir * 64 + 16 * tt + chl) * RG_UP + (32 * ks + 8 * q) * 2);
                    gr[tt] = __builtin_amdgcn_mfma_f32_16x16x32_bf16(af, wf[0][ks], gr[tt], 0, 0, 0); gi[tt] = __builtin_amdgcn_mfma_f32_16x16x32_bf16(af, wf[1][ks], gi[tt], 0, 0, 0); }
            float av[4][4], bv[4][4];
            { const float L2E = 1.4426950408889634f; const f32x2 nba = (f32x2){-L2E * ba, -L2E * ba}, nbx = (f32x2){-L2E * bx, -L2E * bx};
#pragma unroll
              for (int tt = 0; tt < 4; ++tt)
#pragma unroll
                for (int rp = 0; rp < 2; ++rp) { const int tok = 16 * tt + 4 * q + 2 * rp;
                    const LAS unsigned char* up = UC + (dir * 64 + tok) * RG_UP + och * 2;
                    const f32x2 ucv = (f32x2){bf2f(*(const LAS bf16*)up), bf2f(*(const LAS bf16*)(up + RG_UP))};
                    const f32x2 xr = (f32x2){gr[tt][2 * rp], gr[tt][2 * rp + 1]} * (-L2E) + nba, xi = (f32x2){gi[tt][2 * rp], gi[tt][2 * rp + 1]} * (-L2E) + nbx;
                    f32x2 er = (f32x2){__builtin_amdgcn_exp2f(xr.x), __builtin_amdgcn_exp2f(xr.y)} + 1.0f, ei = (f32x2){__builtin_amdgcn_exp2f(xi.x), __builtin_amdgcn_exp2f(xi.y)} + 1.0f;
                    const f32x2 rr = (f32x2){__builtin_amdgcn_rcpf(er.x), __builtin_amdgcn_rcpf(er.y)}, ii = (f32x2){__builtin_amdgcn_rcpf(ei.x), __builtin_amdgcn_rcpf(ei.y)};
                    const f32x2 la = rr * Kc; const f32x2 a2 = (f32x2){__builtin_amdgcn_exp2f(la.x), __builtin_amdgcn_exp2f(la.y)};
                    f32x2 om = 1.0f - a2 * a2; om.x = fmaxf(om.x, 0.f); om.y = fmaxf(om.y, 0.f);
                    const f32x2 b2 = (f32x2){__builtin_amdgcn_sqrtf(om.x), __builtin_amdgcn_sqrtf(om.y)} * (ii * ucv);
                    av[tt][2 * rp] = a2.x; av[tt][2 * rp + 1] = a2.y; bv[tt][2 * rp] = b2.x; bv[tt][2 * rp + 1] = b2.y; } }
            if (dir) rg_scan<true>(av, bv, H, q, baddr); else rg_scan<false>(av, bv, H, q, baddr);
#pragma unroll
            for (int tt = 0; tt < 4; ++tt)
#pragma unroll
                for (int rp = 0; rp < 2; ++rp) { const unsigned w2 = pk2(bv[tt][2 * rp], bv[tt][2 * rp + 1]); LAS unsigned char* hp = HS + (dir * 64 + 16 * tt + 4 * q + 2 * rp) * 128 + oc * 2;
                    *(LAS bf16*)hp = (bf16)(w2 & 0xffffu); *(LAS bf16*)(hp + 128) = (bf16)(w2 >> 16); }
            __syncthreads();
#pragma unroll
            for (int dc = 0; dc < 2; ++dc) {
                const int t = tid >> 3, o8 = tid & 7;
                const int tau = dc == 0 ? s : (s < 4 ? 3 - s : 39 - s);
                const int other = dc == 0 ? (tau < 4 ? 3 - tau : 39 - tau) : tau; const bool second = other < s;
                if (lastl && tau < 4) continue;
                const int row = (tau < 4 ? NLAT + b * CTXL + tau * 64 : b * SEQ + (tau - 4) * 64) + t;
                const u32x4 hv = *(const LAS u32x4*)(HS + (dc * 64 + t) * 128 + o8 * 16);
                const size_t o = (size_t)row * D + cbase + half * 64 + o8 * 8;
                if (!second) *(u32x4*)(REC + o) = hv;
                else { const u32x4 rv = rvp[dc], zv = zvp[dc]; u32x4 ov;
#pragma unroll
                    for (int p = 0; p < 4; ++p) { const f32x2 y = ((f32x2){bf_lo(rv[p]), bf_hi(rv[p])} + (f32x2){bf_lo(hv[p]), bf_hi(hv[p])}) * (f32x2){bf_lo(zv[p]), bf_hi(zv[p])}; ov[p] = pk2(y.x, y.y); }
                    *(u32x4*)(REC + o) = ov; }
            }
        }
#undef RG_ULOAD
        __syncthreads();
    }
}

constexpr int PH_PER_LAYER = 10, NPH = 1 + DEPTH * PH_PER_LAYER + 1;
#ifndef PHASE_MASK
#define PHASE_MASK 0xFFFFu
#endif
#define PM(j) ((PHASE_MASK >> (j)) & 1u)
#ifndef PROBE_DOUBLE
#define PROBE_DOUBLE (-1)
#endif
#define REP(k) for (int rep_ = 0; rep_ < ((PROBE_DOUBLE == (k)) ? 2 : 1); ++rep_)
#define IN(k) (lo <= (k) && (k) < hi)
#define SEAM(k) do { if (IN(k) && IN((k) + 1)) xcd_barrier(bar); } while (0)
template <int l> __device__ __forceinline__ void run_layer(const Ctx& c, const XcdBarrier& bar, int lo, int hi) {
    LAS unsigned char* ring = c.lds;
        const int pb = 1 + l * PH_PER_LAYER; const bool last = (l == DEPTH - 1);
        const int nMrows = last ? 128 : 144, Me = last ? 4096 : 4608;
        const bool ovl = (l == 0 && c.G == 256 && lo <= pb + 3 && pb + 4 < hi);
        if (PM(1) && IN(pb + 0)) { if (l > 0 && !(c.G == 256 && IN(pb - 1))) { REP(1) phase_convert_weights(c, l); } phase_norm1(c, l); }
        SEAM(pb + 0);
        if (PM(2) && IN(pb + 1)) {
            REP(2) { ProbIn P; P.ws = c.ws; P.G = c.G; P.c = c.bid; P.nM = nMrows; P.nLat = nMrows * 13; P.nCtx = last ? 80 : 0; pg8::gemm_phase<ProbIn, true>(ring, P); }
            { ProbIn8 P; P.ws = c.ws; P.G = c.G; P.c = c.bid; P.nM = nMrows; P.bal = last && c.G == 256; pg8::gemm_phase<ProbIn8, true>(ring, P); }
            { ProbVt P; P.ws = c.ws; P.G = c.G; P.c = c.bid; P.bal = last && c.G == 256; pg8::gemm_phase<ProbVt, true>(ring, P); }
        }
        SEAM(pb + 1);
        if (PM(3) && IN(pb + 2)) {
            const int cgrp = c.bid % 6;
            const bool swp = (c.G == 256) && (c.bid & 1);
            if (swp) { REP(4) {
                phase_attn(c, l, 0, 1); if (cgrp == 2) phase_convert_moe(c, l);
                phase_attn(c, l, 1, 2); if (cgrp == 3) phase_convert_moe(c, l);
                phase_attn(c, l, 2, 3); if (cgrp == 4) phase_convert_moe(c, l);
                phase_attn(c, l, 3, 8); if (cgrp == 5) phase_convert_moe(c, l);
                } __syncthreads(); }
            if (cgrp == 0) phase_convert_moe(c, l);
            REP(3) phase_rglru(c, l); __syncthreads();
            if (cgrp == 1) phase_convert_moe(c, l);
            if (!swp) { REP(4) {
                phase_attn(c, l, 0, 1); if (cgrp == 2) phase_convert_moe(c, l);
                phase_attn(c, l, 1, 2); if (cgrp == 3) phase_convert_moe(c, l);
                phase_attn(c, l, 2, 3); if (cgrp == 4) phase_convert_moe(c, l);
                phase_attn(c, l, 3, 8); if (cgrp == 5) phase_convert_moe(c, l);
                } __syncthreads(); }
        }
        SEAM(pb + 2);
        if (PM(4) && IN(pb + 3)) REP(5) {
            if (ovl) {
                unsigned* hw = (unsigned*)(c.ws + WS_CTL) + 8192;
                { ProbMerge01 P; P.ws = c.ws; P.G = c.G; P.c = c.bid; P.nM = nMrows; P.pbeg = 0; P.pend = 2; pg8::gemm_phase<ProbMerge01, true>(ring, P); }
                pg8::handoff_signal(bar, hw);
                if (c.bid < 64) { ProbMerge01 P; P.ws = c.ws; P.G = c.G; P.c = c.bid; P.nM = nMrows; P.pbeg = 2; P.pend = 3; pg8::gemm_phase<ProbMerge01, true>(ring, P); }
                else { pg8::handoff_wait(bar, hw);
                    ProbMerge<2> P; P.ws = c.ws; P.G = c.G; P.c = c.bid; P.nM = nMrows; P.l = l; P.xin = c.in[I_X]; P.cin = c.in[I_CTX]; P.ubeg = c.bid - 64; P.ustride = 192; P.ucnt = 2; pg8::gemm_phase<ProbMerge<2>, true>(ring, P); }
            } else { ProbMerge01 P; P.ws = c.ws; P.G = c.G; P.c = c.bid; P.nM = nMrows; P.pbeg = 0; P.pend = 1 << 20; pg8::gemm_phase<ProbMerge01, true>(ring, P); }
        }
        SEAM(pb + 3);
        if (PM(5) && IN(pb + 4)) { ProbMerge<2> P; P.ws = c.ws; P.G = c.G; P.c = c.bid; P.nM = nMrows; P.l = l; P.xin = c.in[I_X]; P.cin = c.in[I_CTX]; P.ubeg = c.bid; P.ustride = c.G; P.ucnt = 1 << 20;
            if (ovl) { P.ustride = 0; P.ucnt = c.bid < 192 ? 1 : 0; P.ubeg = c.bid < 128 ? 384 + c.bid : 512 + (c.bid - 128); }
            pg8::gemm_phase<ProbMerge<2>, true>(ring, P); }
        SEAM(pb + 4);
        if (PM(6) && IN(pb + 5)) REP(6) phase_norm2(c, l);
        SEAM(pb + 5);
        if (PM(7) && IN(pb + 6)) REP(7) { phase_topk(c, l); __syncthreads(); }
        SEAM(pb + 6);
        if (PM(9) && IN(pb + 8)) REP(9) { ProbUp P; P.ws = c.ws; P.G = c.G; P.c = c.bid; P.Me = Me; P.l = l; pg8::gemm_phase<ProbUp, true>(ring, P); }
        SEAM(pb + 8);
        if (PM(10) && IN(pb + 9)) { REP(10) { ProbDown P; P.ws = c.ws; P.G = c.G; P.c = c.bid; P.Me = Me; P.l = l; pg8::gemm_phase<ProbDown, true>(ring, P); }
            if (!last && c.G == 256 && IN(pb + 10) && c.bid >= 128) { __syncthreads(); phase_convert_weights(c, l + 1, 128, 128); __syncthreads(); } }
        SEAM(pb + 9);
}
__global__ void __launch_bounds__(NTHR, 2) fwd(Args args) {
    extern __shared__ __attribute__((aligned(16))) unsigned char lds_raw[];
    Ctx c;
    c.in = args.in;
    c.out = args.out; c.ws = args.ws; c.lds = (LAS unsigned char*)lds_raw;
    c.tid = threadIdx.x; c.lane = c.tid & 63; c.wave = __builtin_amdgcn_readfirstlane(c.tid >> 6); c.G = gridDim.x; c.bid = blockIdx.x;
    volatile LAS unsigned* MISC = (volatile LAS unsigned*)(c.lds + MISC_OFF);
    if (c.tid < 4) MISC[c.tid] = 0u;
    __syncthreads();
    const int lo = args.ph_lo, hi = args.ph_hi;
    XcdBarrier bar; bar.bar = (unsigned*)(c.ws + WS_CTL) + 1024; bar.x = 0; bar.st = MISC;
    if (hi - lo > 1) bar = xcd_barrier_post((unsigned*)(c.ws + WS_CTL) + 1024, MISC);
    if (PM(0) && IN(0)) { REP(0) { phase_mod(c); __syncthreads(); phase_convert_weights(c, 0); } }
    SEAM(0);
    run_layer<0>(c, bar, lo, hi);
    run_layer<1>(c, bar, lo, hi);
    if (PM(11) && IN(NPH - 1)) phase_norm1(c, DEPTH);
#undef IN
#undef SEAM
}

extern "C" void kernel_launch(void* const* d_in, const int* in_sizes, int n_in, void* d_out, int out_size, void* d_ws, size_t ws_size, hipStream_t stream) {
    static int grid = 0;
    if (grid == 0) {
        if (n_in != 25 || in_sizes[0] != NLAT * D || out_size != NLAT * D || ws_size < WS_END) { fprintf(stderr, "kernel_launch: unexpected problem (n_in %d, in0 %d, out %d, ws %zu < %zu)\n", n_in, n_in > 0 ? in_sizes[0] : -1, out_size, ws_size, (size_t)WS_END); grid = -1; return; }
        int dev = 0, cus = 0, per_cu = 0;
        if (hipGetDevice(&dev) != hipSuccess || hipDeviceGetAttribute(&cus, hipDeviceAttributeMultiprocessorCount, dev) != hipSuccess) { grid = -1; return; }
        if (hipFuncSetAttribute((const void*)fwd, hipFuncAttributeMaxDynamicSharedMemorySize, LDS_BYTES) != hipSuccess) { fprintf(stderr, "kernel_launch: hipFuncSetAttribute failed\n"); grid = -1; return; }
        if (hipOccupancyMaxActiveBlocksPerMultiprocessor(&per_cu, (const void*)fwd, NTHR, LDS_BYTES) != hipSuccess || per_cu < 1) fprintf(stderr, "kernel_launch: occupancy query says %d\n", per_cu);
        (void)hipGetLastError();
        grid = cus;
        if (grid % 8 != 0) grid -= grid % 8;
    }
    if (grid < 0) return;
    (void)hipMemsetAsync((char*)d_ws + WS_CTL, 0, CTL_ZERO_BYTES, stream);
    Args a{};
    for (int i = 0; i < 25; ++i) a.in[i] = (const float*)d_in[i];
    a.out = (float*)d_out; a.ws = (unsigned char*)d_ws;
#if MK_PER_PHASE
    for (int p = 0; p < NPH; ++p) { a.ph_lo = p; a.ph_hi = p + 1; hipLaunchKernelGGL(fwd, dim3(grid), dim3(NTHR), LDS_BYTES, stream, a); }
#else
    a.ph_lo = 0; a.ph_hi = NPH; hipLaunchKernelGGL(fwd, dim3(grid), dim3(NTHR), LDS_BYTES, stream, a);
#endif
    const hipError_t le = hipPeekAtLastError();
    if (le != hipSuccess) fprintf(stderr, "kernel_launch: launch failed: %s\n", hipGetErrorName(le));
}
```
